# Optimizing an MI355X kernel written in HIP

```python
import jax, jax.numpy as jnp
from jax import lax
import numpy as np

D_MODEL = 1024
BATCH = 16
SEQ = 4096
DEPTH = 1

ATTN_GROUPS = ((128, 1), (512, 4), (2048, 16))
N_ATTN_GROUPS = len(ATTN_GROUPS)
ATTN_HEADS_PER_GROUP = 4
ATTN_HEADS = N_ATTN_GROUPS * ATTN_HEADS_PER_GROUP
ATTN_HEAD_DIM = 128
ATTN_OUT_WIDTH = ATTN_HEADS_PER_GROUP * ATTN_HEAD_DIM
ROPE_THETA = 500000.0
ROPE_DIM = ATTN_HEAD_DIM // 4
GLA_HEADS = 4
GLA_KEY_DIM = (D_MODEL // 2) // GLA_HEADS
GLA_VAL_DIM = D_MODEL // GLA_HEADS
GLA_GATE_RANK = 16
GLA_GATE_NORMALIZER = 16.0
GLA_CHUNK = 64
FFN_HIDDEN = -(-8 * D_MODEL // (3 * 256)) * 256
NORM_EPS = 1e-6

IN_SIZES = (ATTN_HEADS * ATTN_HEAD_DIM,
            ATTN_HEADS * ATTN_HEAD_DIM,
            ATTN_HEADS * ATTN_HEAD_DIM,
            GLA_HEADS * GLA_KEY_DIM,
            GLA_HEADS * GLA_KEY_DIM,
            GLA_HEADS * GLA_VAL_DIM,
            GLA_HEADS * GLA_VAL_DIM,
            GLA_GATE_RANK,
            D_MODEL,
            D_MODEL)
IN_WIDTH = int(sum(IN_SIZES))
IN_SPLIT_POINTS = tuple(int(v) for v in np.cumsum(IN_SIZES)[:-1])

kernel_name = "hybrid_dilated_swa_gla_block"


def rmsnorm(x, g):
    xf = x.astype(jnp.float32)
    y = xf * lax.rsqrt(jnp.mean(xf * xf, axis=-1, keepdims=True) + NORM_EPS)
    return (y * g.astype(jnp.float32)).astype(x.dtype)


def rope_tables(seq_len):
    inv_freq = ROPE_THETA ** (-jnp.arange(0, ROPE_DIM, 2, dtype=jnp.float32) / ROPE_DIM)
    ang = jnp.arange(seq_len, dtype=jnp.float32)[:, None] * inv_freq[None, :]
    ang = jnp.concatenate([ang, ang], axis=-1)[None, :, None, :]
    return jnp.cos(ang), jnp.sin(ang)


def partial_rope(t, cos, sin):
    rot = t[..., :ROPE_DIM].astype(jnp.float32)
    half = ROPE_DIM // 2
    rotated = jnp.concatenate([-rot[..., half:], rot[..., :half]], axis=-1)
    rot = rot * cos + rotated * sin
    return jnp.concatenate([rot.astype(t.dtype), t[..., ROPE_DIM:]], axis=-1)


def dilated_window_attention(q, k, v, dilation, keys_back):
    B, S, H, Dh = q.shape
    r, blk = dilation, keys_back
    L = S // r
    nb = -(-L // blk)
    Lp = nb * blk

    def to_sub(t):
        t = t.reshape(B, L, r, H, Dh).transpose(0, 2, 3, 1, 4)
        t = jnp.pad(t, ((0, 0), (0, 0), (0, 0), (0, Lp - L), (0, 0)))
        return t.reshape(B, r, H, nb, blk, Dh)

    def with_prev(t):
        prev = jnp.pad(t, ((0, 0), (0, 0), (0, 0), (1, 0), (0, 0), (0, 0)))[:, :, :, :-1]
        return jnp.concatenate([prev, t], axis=4)

    qb = to_sub(q)
    kk = with_prev(to_sub(k))
    vv = with_prev(to_sub(v))
    scores = jnp.einsum('brhnqd,brhnkd->brhnqk', qb, kk).astype(jnp.float32) * (Dh ** -0.5)
    qi = jnp.arange(blk)[:, None]
    kj = jnp.arange(2 * blk)[None, :] - blk
    dist = qi - kj
    blk_idx = jnp.arange(nb)[:, None, None]
    valid = (dist >= 0)[None] & (dist <= keys_back)[None] & ((blk_idx > 0) | (kj >= 0)[None])
    scores = jnp.where(valid, scores, -jnp.inf)
    m = jnp.max(scores, axis=-1)
    p = jnp.exp(scores - m[..., None])
    l = jnp.sum(p, axis=-1)
    o = jnp.einsum('brhnqk,brhnkd->brhnqd', p, vv.astype(jnp.float32)) / l[..., None]

    def from_sub(t):
        rest = t.shape[5:]
        t = t.reshape((B, r, H, Lp) + rest)[:, :, :, :L]
        t = t.transpose((0, 3, 1, 2) + tuple(range(4, 4 + len(rest))))
        return t.reshape((B, S, H) + rest)

    return from_sub(o), from_sub(m), from_sub(l)


def dilated_attention_mixer(q, k, v):
    B, S = q.shape[:2]
    outs, maxes, dens = [], [], []
    for g, (window, dilation) in enumerate(ATTN_GROUPS):
        sl = slice(g * ATTN_HEADS_PER_GROUP, (g + 1) * ATTN_HEADS_PER_GROUP)
        o, m, l = dilated_window_attention(q[:, :, sl], k[:, :, sl], v[:, :, sl],
                                           dilation, window // dilation)
        outs.append(o); maxes.append(m); dens.append(l)
    o = jnp.stack(outs, 0)
    m = jnp.stack(maxes, 0)
    l = jnp.stack(dens, 0)
    w = l * jnp.exp(m - jnp.max(m, axis=0, keepdims=True))
    out = jnp.sum(w[..., None] * o, axis=0) / jnp.sum(w, axis=0)[..., None]
    return out.reshape(B, S, ATTN_OUT_WIDTH)


def gla_chunked(q, k, v, log_a):
    B, S, H, dk = q.shape
    dv = v.shape[-1]
    C = GLA_CHUNK
    N = S // C
    q = q.reshape(B, N, C, H, dk) * (dk ** -0.5)
    k = k.reshape(B, N, C, H, dk)
    v = v.reshape(B, N, C, H, dv)
    b = jnp.cumsum(log_a.reshape(B, N, C, H, dk), axis=2)
    b_last = b[:, :, -1]
    b_ref = b[:, :, C // 2:C // 2 + 1]
    A = jnp.einsum('bnihd,bnjhd->bnhij', q * jnp.exp(b - b_ref), k * jnp.exp(b_ref - b))
    causal = jnp.tril(jnp.ones((C, C), dtype=bool))
    o_intra = jnp.einsum('bnhij,bnjhv->bnihv', jnp.where(causal, A, 0.0), v)
    q_inter = q * jnp.exp(b)
    k_state = k * jnp.exp(b_last[:, :, None] - b)
    decay = jnp.exp(b_last)

    def step(state, inp):
        qc, kc, vc, dc = inp
        o = jnp.einsum('bihd,bhdv->bihv', qc, state)
        state = dc[..., None] * state + jnp.einsum('bjhd,bjhv->bhdv', kc, vc)
        return state, o

    xs = (jnp.moveaxis(q_inter, 1, 0), jnp.moveaxis(k_state, 1, 0),
          jnp.moveaxis(v, 1, 0), jnp.moveaxis(decay, 1, 0))
    state0 = jnp.zeros((B, H, dk, dv), jnp.float32)
    _, o_inter = lax.scan(step, state0, xs)
    o = o_intra + jnp.moveaxis(o_inter, 0, 1)
    return o.reshape(B, S, H, dv)


def setup_inputs(seed: int = 0) -> dict:
    key = jax.random.key(seed)
    ks = jax.random.split(key, 16)
    f32 = jnp.float32
    nrm = lambda k, shape, fan_in: jax.random.normal(k, shape, f32) * (fan_in ** -0.5)
    gain = lambda k, shape: 1.0 + 0.01 * jax.random.normal(k, shape, f32)
    return {
        "x": jax.random.normal(ks[0], (BATCH, SEQ, D_MODEL), f32),
        "norm1_g": gain(ks[1], (DEPTH, D_MODEL)),
        "w_in": nrm(ks[2], (DEPTH, D_MODEL, IN_WIDTH), D_MODEL),
        "w_gate_lr": nrm(ks[3], (DEPTH, GLA_GATE_RANK, GLA_HEADS * GLA_KEY_DIM), GLA_GATE_RANK),
        "b_gate": 0.01 * jax.random.normal(ks[4], (DEPTH, GLA_HEADS * GLA_KEY_DIM), f32),
        "gla_norm_g": gain(ks[5], (DEPTH, GLA_VAL_DIM)),
        "w_branch_a": nrm(ks[6], (DEPTH, ATTN_OUT_WIDTH, D_MODEL), ATTN_OUT_WIDTH),
        "w_branch_b": nrm(ks[7], (DEPTH, GLA_HEADS * GLA_VAL_DIM, D_MODEL), GLA_HEADS * GLA_VAL_DIM),
        "w_out": nrm(ks[8], (DEPTH, D_MODEL, D_MODEL), D_MODEL),
        "norm2_g": gain(ks[9], (DEPTH, D_MODEL)),
        "w_ffn_in": nrm(ks[10], (DEPTH, D_MODEL, 2 * FFN_HIDDEN), D_MODEL),
        "w_ffn_down": nrm(ks[11], (DEPTH, FFN_HIDDEN, D_MODEL), FFN_HIDDEN),
        "norm_f_g": gain(ks[12], (D_MODEL,)),
    }


def reference(x, norm1_g, w_in, w_gate_lr, b_gate, gla_norm_g, w_branch_a, w_branch_b,
              w_out, norm2_g, w_ffn_in, w_ffn_down, norm_f_g):
    B, S, D = x.shape
    cos, sin = rope_tables(S)
    for layer in range(DEPTH):
        h = rmsnorm(x, norm1_g[layer])
        proj = h @ w_in[layer]
        aq, ak, av, gq, gk, gv, gr, glr, ga, gb = jnp.split(proj, IN_SPLIT_POINTS, axis=-1)

        aq = partial_rope(aq.reshape(B, S, ATTN_HEADS, ATTN_HEAD_DIM), cos, sin)
        ak = partial_rope(ak.reshape(B, S, ATTN_HEADS, ATTN_HEAD_DIM), cos, sin)
        av = av.reshape(B, S, ATTN_HEADS, ATTN_HEAD_DIM)
        attn_out = dilated_attention_mixer(aq, ak, av).astype(x.dtype)

        log_a = jax.nn.log_sigmoid((glr @ w_gate_lr[layer] + b_gate[layer]).astype(jnp.float32))
        log_a = (log_a / GLA_GATE_NORMALIZER).reshape(B, S, GLA_HEADS, GLA_KEY_DIM)
        o_gla = gla_chunked(gq.reshape(B, S, GLA_HEADS, GLA_KEY_DIM).astype(jnp.float32),
                            gk.reshape(B, S, GLA_HEADS, GLA_KEY_DIM).astype(jnp.float32),
                            gv.reshape(B, S, GLA_HEADS, GLA_VAL_DIM).astype(jnp.float32),
                            log_a)
        o_gla = rmsnorm(o_gla, gla_norm_g[layer])
        o_gla = o_gla * jax.nn.silu(gr.reshape(B, S, GLA_HEADS, GLA_VAL_DIM).astype(jnp.float32))
        gla_out = o_gla.reshape(B, S, GLA_HEADS * GLA_VAL_DIM).astype(x.dtype)

        mix = (jax.nn.sigmoid(ga) * (attn_out @ w_branch_a[layer])
               + jax.nn.sigmoid(gb) * (gla_out @ w_branch_b[layer]))
        x = x + mix @ w_out[layer]

        h2 = rmsnorm(x, norm2_g[layer])
        g, u = jnp.split(h2 @ w_ffn_in[layer], 2, axis=-1)
        x = x + (jax.nn.silu(g) * u) @ w_ffn_down[layer]
    return rmsnorm(x, norm_f_g)
```

```cpp
#include <hip/hip_runtime.h>
#include <cstdio>
#include <cstdint>
namespace pg8 {
#define PG8_LAS __attribute__((address_space(3)))
typedef unsigned short bf16_t;
typedef short bf16x8 __attribute__((ext_vector_type(8)));
typedef float f32x4 __attribute__((ext_vector_type(4)));
typedef unsigned u32x4 __attribute__((ext_vector_type(4)));
constexpr int BM = 256, BK = 64, HALF = 128, HTB = HALF * BK * 2  , STAGE_BYTES = 8 * HTB, NXCD = 8, WGM = 8;

__host__ __device__ __forceinline__ int lds_byte(int r, int c) { const int st = (r >> 4) * 2 + (c >> 5), rr = r & 15, cc = c & 31, ob = rr * 64 + cc * 2; return st * 1024 + (ob ^ (((ob >> 9) & 1) << 5)); }
__host__ __device__ __forceinline__ void stage_rc(int b, int& R, int& C) { const int st = b / 1024, sb = b % 1024, swz = sb ^ (((sb >> 9) & 1) << 5); R = (st >> 1) * 16 + swz / 64; C = (st & 1) * 32 + (swz % 64) / 2; }
__host__ __device__ __forceinline__ int perm32(int rho) { const int n = rho >> 4, i = rho & 15; return 8 * (i >> 2) + 4 * n + (i & 3); }

struct Unit { int pm, pn; };
struct Gemm { const bf16_t* A; const bf16_t* Bt; int M, N, K; };

struct StaticOrder {
    int nM, nN, nwg, G, c;
    __host__ __device__ void init(int M, int N, int G_, int c_) { nM = M / BM; nN = N / BM; nwg = nM * nN; G = G_; c = c_; }
    __host__ __device__ bool next(int i, Unit& u) const {
        const long L = (long)i * G + c; if (L >= nwg) return false;
        int wgid = (int)L; { const int q = nwg / NXCD, r = nwg % NXCD, xcd = wgid % NXCD, off = wgid / NXCD; wgid = (xcd < r ? xcd * (q + 1) : r * (q + 1) + (xcd - r) * q) + off; }
        const int nig = WGM * nN, gid = wgid / nig, fm = gid * WGM, gsz = (nM - fm) < WGM ? (nM - fm) : WGM;
        u.pm = fm + ((wgid % nig) % gsz); u.pn = (wgid % nig) / gsz; return true;
    }
    __device__ __forceinline__ void a_ready(const Unit&) const {}
    __device__ __forceinline__ void done(const Unit&) const {}
};

__device__ __forceinline__ unsigned cvt_pk_bf16(float lo, float hi) { unsigned r; asm volatile("v_cvt_pk_bf16_f32 %0, %1, %2" : "=v"(r) : "v"(lo), "v"(hi)); return r; }
typedef float f32x2 __attribute__((ext_vector_type(2)));
__device__ __forceinline__ f32x2 gelu_pk(f32x2 v) {
    const f32x2 av = __builtin_elementwise_abs(v), d = av * 0.2316418882f + 1.0f;
    f32x2 t; t.x = __builtin_amdgcn_rcpf(d.x); t.y = __builtin_amdgcn_rcpf(d.y);
    f32x2 q = t * 0.5307027145f + (-0.7265760135f); q = q * t + 0.7107068705f; q = q * t + (-0.142248368f); q = q * t + 0.127414796f; q = q * t;
    const f32x2 s = (v * v) * (-0.72134752044f);
    f32x2 e; e.x = __builtin_amdgcn_exp2f(s.x); e.y = __builtin_amdgcn_exp2f(s.y);
    const f32x2 m = v * (q * e), r = v - m;
    f32x2 o; o.x = v.x < 0.f ? m.x : r.x; o.y = v.y < 0.f ? m.y : r.y; return o;
}

template <int ACT  > struct EpiBf16 {
    static constexpr bool PERM = true, AFTER_DRAIN = false; static_assert(ACT == 0 || ACT == 1, "EpiBf16: ACT is 0 (none) or 1 (gelu_pk)");
    bf16_t* O; int ldc; const float* bias; int split_cols; size_t split_stride; float scale0;
    __device__ __forceinline__ void operator()(const f32x4 (&acc)[2][2][4][2], const Unit& u, int wr, int wc, int fr, int fq) const {
        const int row0 = u.pm * BM + wr * 64 + fr; int colt = u.pn * BM; bf16_t* base = O;
        float sc = 1.f; if (split_cols) { const int t = colt / split_cols; base += (size_t)t * split_stride; colt -= t * split_cols; if (t == 0) sc = scale0; }
        const int col0 = colt + wc * 32 + 8 * fq, bcol0 = u.pn * BM + wc * 32 + 8 * fq;
        f32x4 bv[2][2];
#pragma unroll
        for (int bj = 0; bj < 2; ++bj)
#pragma unroll
            for (int n = 0; n < 2; ++n) bv[bj][n] = bias ? *(const f32x4*)(bias + bcol0 + bj * HALF + 4 * n) : (f32x4){0.f, 0.f, 0.f, 0.f};
#pragma unroll
        for (int ai = 0; ai < 2; ++ai)
#pragma unroll
            for (int m = 0; m < 4; ++m) { bf16_t* rowp = base + (size_t)(row0 + ai * HALF + m * 16) * ldc + col0;
#pragma unroll
                for (int bj = 0; bj < 2; ++bj) { f32x4 v0 = acc[ai][bj][m][0] + bv[bj][0], v1 = acc[ai][bj][m][1] + bv[bj][1];
                    if (ACT == 1) { f32x2 a = gelu_pk((f32x2){v0[0], v0[1]}), b = gelu_pk((f32x2){v0[2], v0[3]}), c = gelu_pk((f32x2){v1[0], v1[1]}), d = gelu_pk((f32x2){v1[2], v1[3]});
                        v0 = (f32x4){a.x, a.y, b.x, b.y}; v1 = (f32x4){c.x, c.y, d.x, d.y}; }
                    v0 = v0 * sc; v1 = v1 * sc; u32x4 w; w.x = cvt_pk_bf16(v0[0], v0[1]); w.y = cvt_pk_bf16(v0[2], v0[3]); w.z = cvt_pk_bf16(v1[0], v1[1]); w.w = cvt_pk_bf16(v1[2], v1[3]);
                    *(u32x4*)(rowp + bj * HALF) = w; } }
    }
};

struct PanelStats {
    unsigned* xbuf;
    unsigned* cnt;
    unsigned* tmo;
    int ntn; float eps;
    unsigned code;
    __device__ __forceinline__ bool run(const f32x4 (&v)[2][2][4][2], const Unit& u, int wr, int wc, int fr, int fq, PG8_LAS unsigned char* lds, int wid, int lane) const {
        typedef float f32x2v __attribute__((ext_vector_type(2)));
        PG8_LAS f32x2v* P = (PG8_LAS f32x2v*)lds;
        PG8_LAS f32x2v* S = (PG8_LAS f32x2v*)(lds + 8192);
        PG8_LAS unsigned* flag = (PG8_LAS unsigned*)(lds + 8192 + 2048);
#pragma unroll
        for (int ai = 0; ai < 2; ++ai)
#pragma unroll
            for (int m = 0; m < 4; ++m) {
                float s = 0.f;
#pragma unroll
                for (int bj = 0; bj < 2; ++bj)
#pragma unroll
                    for (int n = 0; n < 2; ++n) { const f32x4 x = v[ai][bj][m][n]; s += (x[0] + x[1]) + (x[2] + x[3]); }
                s += __shfl_xor(s, 16); s += __shfl_xor(s, 32);
                const float mw = s * (1.0f / 64.0f); float q = 0.f;
#pragma unroll
                for (int bj = 0; bj < 2; ++bj)
#pragma unroll
                    for (int n = 0; n < 2; ++n) { const f32x4 d = v[ai][bj][m][n] - mw; q += (d[0] * d[0] + d[1] * d[1]) + (d[2] * d[2] + d[3] * d[3]); }
                q += __shfl_xor(q, 16); q += __shfl_xor(q, 32);
                if (fq == 0) P[(ai * HALF + wr * 64 + m * 16 + fr) * 4 + wc] = (f32x2v){mw, q};
            }
        asm volatile("s_waitcnt lgkmcnt(0)" ::: "memory"); __builtin_amdgcn_s_barrier(); asm volatile("" ::: "memory");
#if defined(BROKEN_EXCHANGE_NO_WAIT)
#warning BROKEN CONTROL BUILD: the row-statistics exchange does not wait; results are wrong by design
        if (blockIdx.x >= 64) { const long long t0_ = clock64(); while (clock64() - t0_ < 60000) __builtin_amdgcn_s_sleep(8); }
#endif
        const int row = wid * 32 + (lane & 31);
        if (lane < 32) {
            const f32x2v a = P[row * 4 + 0], b = P[row * 4 + 1], c = P[row * 4 + 2], d = P[row * 4 + 3];
            const float mt = (a.x + b.x + c.x + d.x) * 0.25f;
            const float da = a.x - mt, db = b.x - mt, dc = c.x - mt, dd = d.x - mt;
            const float m2 = (a.y + b.y) + (c.y + d.y) + 64.0f * ((da * da + db * db) + (dc * dc + dd * dd));
            unsigned long long* slot = (unsigned long long*)xbuf + ((size_t)(u.pm * BM + row) * 4 + u.pn);
            __hip_atomic_store(slot, ((unsigned long long)__float_as_uint(m2) << 32) | __float_as_uint(mt), __ATOMIC_RELAXED, __HIP_MEMORY_SCOPE_AGENT);
        }
        asm volatile("s_waitcnt vmcnt(0)" ::: "memory");
        if (lane == 0) __hip_atomic_fetch_add(cnt + 64 * u.pm, 1u, __ATOMIC_RELAXED, __HIP_MEMORY_SCOPE_AGENT);
        if (wid == 0) {
            bool dead = false; const unsigned long long t0 = __builtin_amdgcn_s_memrealtime(); const unsigned want = 8u * (unsigned)ntn;
            for (;;) {
#if defined(BROKEN_EXCHANGE_NO_WAIT)
                break;
#endif
                if ((unsigned)__builtin_amdgcn_readfirstlane(__hip_atomic_load(cnt + 64 * u.pm, __ATOMIC_RELAXED, __HIP_MEMORY_SCOPE_AGENT)) >= want) break;
                if (__builtin_amdgcn_s_memrealtime() - t0 > 2000000ull) {
                    if (lane == 0) { unsigned expect = 0u; __hip_atomic_compare_exchange_strong(tmo + 1, &expect, code | (unsigned)(u.pm & 0xff), __ATOMIC_RELAXED, __ATOMIC_RELAXED, __HIP_MEMORY_SCOPE_AGENT);
                                     __hip_atomic_store(tmo, 1u, __ATOMIC_RELAXED, __HIP_MEMORY_SCOPE_AGENT); }
                    dead = true; break; }
                __builtin_amdgcn_s_sleep(2);
            }
            __builtin_amdgcn_fence(__ATOMIC_ACQUIRE, "agent");
            if (lane == 0) flag[0] = dead ? 1u : 0u;
        }
        asm volatile("s_waitcnt vmcnt(0) lgkmcnt(0)" ::: "memory"); __builtin_amdgcn_s_barrier(); asm volatile("" ::: "memory");
        const bool bad = flag[0] != 0u;
        if (lane < 32) {
            const unsigned long long* slot = (const unsigned long long*)xbuf + (size_t)(u.pm * BM + row) * 4; float mt[4], m2[4]; float ms = 0.f;
#pragma unroll
            for (int t = 0; t < 4; ++t) { if (t < ntn) { const unsigned long long w = __hip_atomic_load(slot + t, __ATOMIC_RELAXED, __HIP_MEMORY_SCOPE_AGENT); mt[t] = __uint_as_float((unsigned)w); m2[t] = __uint_as_float((unsigned)(w >> 32)); } else { mt[t] = 0.f; m2[t] = 0.f; } ms += mt[t]; }
            const float mean = ms / (float)ntn; float q = 0.f;
#pragma unroll
            for (int t = 0; t < 4; ++t) if (t < ntn) { const float dm = mt[t] - mean; q += m2[t] + 256.0f * dm * dm; }
            S[row] = (f32x2v){mean, 1.0f / sqrtf(q / (256.0f * (float)ntn) + eps)};
        }
        asm volatile("s_waitcnt lgkmcnt(0)" ::: "memory"); __builtin_amdgcn_s_barrier(); asm volatile("" ::: "memory");
        return bad;
    }
};
struct EpiLnRes {
    static constexpr bool PERM = false, AFTER_DRAIN = true;
    const float* base; float* out; int ldc; const float* bias; PanelStats st; unsigned poison;
    __device__ __forceinline__ void fused(f32x4 (&acc)[2][2][4][2], const Unit& u, int wr, int wc, int fr, int fq, PG8_LAS unsigned char* lds, int wid, int lane) const {
        typedef float f32x2v __attribute__((ext_vector_type(2)));
        const PG8_LAS f32x2v* S = (const PG8_LAS f32x2v*)(lds + 8192);
        const int col0 = u.pn * BM + wc * 32 + 4 * fq;
#pragma unroll
        for (int bj = 0; bj < 2; ++bj)
#pragma unroll
            for (int n = 0; n < 2; ++n) { const f32x4 bv = bias ? *(const f32x4*)(bias + col0 + bj * HALF + n * 16) : (f32x4){0.f, 0.f, 0.f, 0.f};
#pragma unroll
                for (int ai = 0; ai < 2; ++ai)
#pragma unroll
                    for (int m = 0; m < 4; ++m) acc[ai][bj][m][n] += bv; }
        f32x4 pre[4][2][2];
#pragma unroll
        for (int m = 0; m < 4; ++m) { const size_t off = (size_t)(u.pm * BM + wr * 64 + m * 16 + fr) * ldc + col0;
#pragma unroll
            for (int bj = 0; bj < 2; ++bj)
#pragma unroll
                for (int n = 0; n < 2; ++n) pre[m][bj][n] = *(const f32x4*)(base + off + bj * HALF + n * 16); }
        const bool bad = st.run(acc, u, wr, wc, fr, fq, lds, wid, lane) || poison != 0u;
        const float qnan = __builtin_nanf("");
#pragma unroll
        for (int ai = 0; ai < 2; ++ai)
#pragma unroll
            for (int m = 0; m < 4; ++m) { const int r = ai * HALF + wr * 64 + m * 16 + fr; const f32x2v sr = S[r]; const size_t off = (size_t)(u.pm * BM + r) * ldc + col0;
#pragma unroll
                for (int bj = 0; bj < 2; ++bj)
#pragma unroll
                    for (int n = 0; n < 2; ++n) { const f32x4 bs = ai == 0 ? pre[m][bj][n] : *(const f32x4*)(base + off + bj * HALF + n * 16); f32x4 o = bs + (acc[ai][bj][m][n] - sr.x) * sr.y;
                        if (bad) o = (f32x4){qnan, qnan, qnan, qnan}; *(f32x4*)(out + off + bj * HALF + n * 16) = o; }
                if (m & 1) asm volatile("" ::: "memory"); }
    }
};
struct EpiLnResLn {
    static constexpr bool PERM = false, AFTER_DRAIN = true;
    const float* base; float* out; bf16_t* xn; int ldc; const float* bias; PanelStats st1, st2; unsigned poison;
    __device__ __forceinline__ void fused(f32x4 (&acc)[2][2][4][2], const Unit& u, int wr, int wc, int fr, int fq, PG8_LAS unsigned char* lds, int wid, int lane) const {
        typedef float f32x2v __attribute__((ext_vector_type(2))); typedef unsigned u32x2v __attribute__((ext_vector_type(2)));
        const PG8_LAS f32x2v* S = (const PG8_LAS f32x2v*)(lds + 8192);
        const int col0 = u.pn * BM + wc * 32 + 4 * fq;
#pragma unroll
        for (int bj = 0; bj < 2; ++bj)
#pragma unroll
            for (int n = 0; n < 2; ++n) { const f32x4 bv = bias ? *(const f32x4*)(bias + col0 + bj * HALF + n * 16) : (f32x4){0.f, 0.f, 0.f, 0.f};
#pragma unroll
                for (int ai = 0; ai < 2; ++ai)
#pragma unroll
                    for (int m = 0; m < 4; ++m) acc[ai][bj][m][n] += bv; }
        bool bad = st1.run(acc, u, wr, wc, fr, fq, lds, wid, lane) || poison != 0u;
        const float qnan = __builtin_nanf("");
#pragma unroll
        for (int ai = 0; ai < 2; ++ai)
#pragma unroll
            for (int m = 0; m < 4; ++m) { const int r = ai * HALF + wr * 64 + m * 16 + fr; const f32x2v sr = S[r]; const size_t off = (size_t)(u.pm * BM + r) * ldc + col0;
#pragma unroll
                for (int bj = 0; bj < 2; ++bj)
#pragma unroll
                    for (int n = 0; n < 2; ++n) { const f32x4 bs = *(const f32x4*)(base + off + bj * HALF + n * 16); acc[ai][bj][m][n] = bs + (acc[ai][bj][m][n] - sr.x) * sr.y; }
                asm volatile("" : "+v"(acc[ai][0][m][0]), "+v"(acc[ai][0][m][1]), "+v"(acc[ai][1][m][0]), "+v"(acc[ai][1][m][1]));
                if (m & 1) asm volatile("" ::: "memory"); }
        const bool bad1 = bad;
        bad = st2.run(acc, u, wr, wc, fr, fq, lds, wid, lane) || bad;
#pragma unroll
        for (int ai = 0; ai < 2; ++ai)
#pragma unroll
            for (int m = 0; m < 4; ++m) { const int r = ai * HALF + wr * 64 + m * 16 + fr; const f32x2v sr = S[r]; const size_t off = (size_t)(u.pm * BM + r) * ldc + col0;
#pragma unroll
                for (int bj = 0; bj < 2; ++bj)
#pragma unroll
                    for (int n = 0; n < 2; ++n) { const f32x4 x1 = acc[ai][bj][m][n]; *(f32x4*)(out + off + bj * HALF + n * 16) = bad1 ? (f32x4){qnan, qnan, qnan, qnan} : x1;
                        const f32x4 o = (x1 - sr.x) * sr.y; u32x2v w; w.x = cvt_pk_bf16(o[0], o[1]); w.y = cvt_pk_bf16(o[2], o[3]);
                        if (bad) { w.x = 0x7fc07fc0u; w.y = 0x7fc07fc0u; } *(u32x2v*)(xn + off + bj * HALF + n * 16) = w; }
                asm volatile("" ::: "memory"); }
    }
};

template <class Epi, class Sched, bool ALIGN_EPI = false, bool SP2 = false>
__device__ __forceinline__ void gemm_phase(PG8_LAS unsigned char* lds, const Gemm g, const Sched& S, const Epi& E) {
    const int tid = threadIdx.x, wid = __builtin_amdgcn_readfirstlane(tid >> 6), lane = tid & 63, wr = wid >> 2, wc = wid & 3, fr = lane & 15, fq = lane >> 4;
    const int K = g.K, nt = K / BK;
    unsigned voffA[2], voffB[2];
#pragma unroll
    for (int i = 0; i < 2; ++i) { int R, C; stage_rc(tid * 16 + i * 8192, R, C); const int Rb = Epi::PERM ? ((R & ~31) + perm32(R & 31)) : R;
        voffA[i] = (unsigned)(R * K + C) * 2u; voffB[i] = (unsigned)(Rb * K + C) * 2u; }
    const size_t kstep = (size_t)(BK * 2);
    const size_t hstep = (size_t)HALF * K * 2;
    const size_t tstep = 2 * hstep;
    const unsigned ldsw = (unsigned)wid * 1024u;
    const int aoff = lds_byte(wr * 64 + fr, fq * 8), boff = lds_byte(wc * 32 + fr, fq * 8);
#define PG8_SA(b, h) (((b) * 2 + (h)) * HTB)
#define PG8_SB(b, h) ((4 + (b) * 2 + (h)) * HTB)
#define PG8_STAGE(bufoff, gbase, voff) do { _Pragma("unroll") for (int _i = 0; _i < 2; ++_i) \
        __builtin_amdgcn_global_load_lds((const unsigned*)((const char*)(gbase) + (voff)[_i]), (PG8_LAS unsigned*)(lds + (bufoff) + ldsw + _i * 8192), 16, 0, 0); } while (0)
#define PG8_LDA(dst, b, h) do { _Pragma("unroll") for (int m = 0; m < 4; ++m) _Pragma("unroll") for (int k = 0; k < 2; ++k) dst[m][k] = *(const PG8_LAS bf16x8*)(lds + PG8_SA(b, h) + aoff + m * 2048 + k * 1024); } while (0)
#define PG8_LDB(dst, b, h) do { _Pragma("unroll") for (int n = 0; n < 2; ++n) _Pragma("unroll") for (int k = 0; k < 2; ++k) dst[n][k] = *(const PG8_LAS bf16x8*)(lds + PG8_SB(b, h) + boff + n * 2048 + k * 1024); } while (0)
#define PG8_MMA(ai, bj, At, Bt) do { __builtin_amdgcn_s_setprio(1); _Pragma("unroll") for (int m = 0; m < 4; ++m) _Pragma("unroll") for (int n = 0; n < 2; ++n) _Pragma("unroll") for (int k = 0; k < 2; ++k) \
        acc[ai][bj][m][n] = __builtin_amdgcn_mfma_f32_16x16x32_bf16(Bt[n][k], At[m][k], acc[ai][bj][m][n], 0, 0, 0); __builtin_amdgcn_s_setprio(0); } while (0)
#define PG8_WAIT_V(n) asm volatile("s_waitcnt vmcnt(" #n ")" ::: "memory")
#define PG8_WAIT_L(n) asm volatile("s_waitcnt lgkmcnt(" #n ")" ::: "memory")
#define PG8_BAR __builtin_amdgcn_s_barrier()
#define PG8_SCHED __builtin_amdgcn_sched_barrier(0)
    Unit cur, nxt; int ui = 0;
    if (!S.next(0, cur)) return;
    f32x4 acc[2][2][4][2];
#pragma unroll
    for (int a = 0; a < 2; ++a)
#pragma unroll
        for (int b = 0; b < 2; ++b)
#pragma unroll
            for (int m = 0; m < 4; ++m)
#pragma unroll
                for (int n = 0; n < 2; ++n) acc[a][b][m][n] = (f32x4){0.f, 0.f, 0.f, 0.f};
    bf16x8 At[4][2], B0[2][2], B1[2][2];
    const char* cA = (const char*)g.A + (size_t)cur.pm * tstep; const char* cB = (const char*)g.Bt + (size_t)cur.pn * tstep;
    S.a_ready(cur);
    if constexpr (SP2) {
        PG8_STAGE(PG8_SB(0, 0), cB, voffB); PG8_STAGE(PG8_SB(0, 1), cB + hstep, voffB); PG8_STAGE(PG8_SA(0, 0), cA, voffA); PG8_STAGE(PG8_SA(0, 1), cA + hstep, voffA);
        if (wr == 1) PG8_BAR;
        PG8_WAIT_V(2); PG8_BAR;
        PG8_STAGE(PG8_SB(1, 0), cB + kstep, voffB); PG8_STAGE(PG8_SA(1, 0), cA + kstep, voffA); PG8_STAGE(PG8_SB(1, 1), cB + hstep + kstep, voffB);
        PG8_WAIT_V(6); PG8_BAR;
    } else {
        PG8_STAGE(PG8_SB(0, 0), cB, voffB); PG8_STAGE(PG8_SA(0, 0), cA, voffA); PG8_STAGE(PG8_SB(0, 1), cB + hstep, voffB); PG8_STAGE(PG8_SA(0, 1), cA + hstep, voffA);
        if (wr == 1) PG8_BAR;
        PG8_WAIT_V(4); PG8_BAR;
        PG8_STAGE(PG8_SB(1, 0), cB + kstep, voffB); PG8_STAGE(PG8_SA(1, 0), cA + kstep, voffA); PG8_STAGE(PG8_SB(1, 1), cB + hstep + kstep, voffB);
        PG8_WAIT_V(6); PG8_BAR;
    }
    for (;;) {
        const bool has_next = S.next(ui + 1, nxt);
        const char* nA = has_next ? (const char*)g.A + (size_t)nxt.pm * tstep : cA; const char* nB = has_next ? (const char*)g.Bt + (size_t)nxt.pn * tstep : cB;
        for (int t = 0; t < nt; t += 2) {
            const bool last = (t == nt - 2);
            const char* a1 = cA + (size_t)(t + 1) * kstep;
            const char* a2 = last ? nA : cA + (size_t)(t + 2) * kstep; const char* b2 = last ? nB : cB + (size_t)(t + 2) * kstep;
            const char* a3 = a2 + kstep; const char* b3 = b2 + kstep;
            if (last && has_next) S.a_ready(nxt);
            if constexpr (SP2) {
            PG8_LDB(B0, 0, 0); PG8_LDB(B1, 0, 1); PG8_SCHED; PG8_LDA(At, 0, 0); PG8_STAGE(PG8_SA(1, 1), a1 + hstep, voffA);
            PG8_WAIT_V(8); PG8_WAIT_L(0); PG8_BAR; PG8_MMA(0, 0, At, B0); PG8_MMA(0, 1, At, B1); PG8_BAR; PG8_SCHED;
            PG8_LDA(At, 0, 1); PG8_STAGE(PG8_SB(0, 0), b2, voffB); PG8_STAGE(PG8_SB(0, 1), b2 + hstep, voffB); PG8_STAGE(PG8_SA(0, 0), a2, voffA);
            PG8_WAIT_V(8); PG8_WAIT_L(0); PG8_BAR; PG8_MMA(1, 0, At, B0); PG8_MMA(1, 1, At, B1); PG8_BAR; PG8_SCHED;
            PG8_LDB(B0, 1, 0); PG8_LDB(B1, 1, 1); PG8_SCHED; PG8_LDA(At, 1, 0); PG8_STAGE(PG8_SA(0, 1), a2 + hstep, voffA);
            PG8_WAIT_V(8); PG8_WAIT_L(0); PG8_BAR; PG8_MMA(0, 0, At, B0); PG8_MMA(0, 1, At, B1); PG8_BAR; PG8_SCHED;
            PG8_LDA(At, 1, 1); PG8_STAGE(PG8_SB(1, 0), b3, voffB); PG8_STAGE(PG8_SB(1, 1), b3 + hstep, voffB); PG8_STAGE(PG8_SA(1, 0), a3, voffA);
            PG8_WAIT_V(8); PG8_WAIT_L(0); PG8_BAR; PG8_MMA(1, 0, At, B0); PG8_MMA(1, 1, At, B1); PG8_BAR; PG8_SCHED;
            } else {
            PG8_LDB(B0, 0, 0); PG8_SCHED; PG8_LDA(At, 0, 0); PG8_STAGE(PG8_SA(1, 1), a1 + hstep, voffA);
            PG8_WAIT_L(8); PG8_BAR; PG8_WAIT_L(0); PG8_MMA(0, 0, At, B0); PG8_BAR; PG8_SCHED;
            PG8_LDB(B1, 0, 1); PG8_STAGE(PG8_SB(0, 0), b2, voffB);
            PG8_BAR; PG8_WAIT_L(0); PG8_MMA(0, 1, At, B1); PG8_BAR;
            PG8_LDA(At, 0, 1); PG8_STAGE(PG8_SA(0, 0), a2, voffA);
            PG8_BAR; PG8_WAIT_L(0); PG8_MMA(1, 0, At, B0); PG8_BAR; PG8_SCHED;
            PG8_STAGE(PG8_SB(0, 1), b2 + hstep, voffB);
            PG8_WAIT_V(6); PG8_BAR; PG8_MMA(1, 1, At, B1); PG8_BAR;
            PG8_LDB(B0, 1, 0); PG8_SCHED; PG8_LDA(At, 1, 0); PG8_STAGE(PG8_SA(0, 1), a2 + hstep, voffA);
            PG8_WAIT_L(8); PG8_BAR; PG8_WAIT_L(0); PG8_MMA(0, 0, At, B0); PG8_BAR; PG8_SCHED;
            PG8_LDB(B1, 1, 1); PG8_STAGE(PG8_SB(1, 0), b3, voffB);
            PG8_BAR; PG8_WAIT_L(0); PG8_MMA(0, 1, At, B1); PG8_BAR;
            PG8_LDA(At, 1, 1); PG8_STAGE(PG8_SA(1, 0), a3, voffA);
            PG8_BAR; PG8_WAIT_L(0); PG8_MMA(1, 0, At, B0); PG8_BAR; PG8_SCHED;
            PG8_STAGE(PG8_SB(1, 1), b3 + hstep, voffB);
            PG8_WAIT_V(6); PG8_BAR; PG8_MMA(1, 1, At, B1); PG8_BAR;
            }
        }
        if constexpr (ALIGN_EPI) { if (wr == 0) PG8_BAR; }
        if constexpr (!Epi::AFTER_DRAIN) { E(acc, cur, wr, wc, fr, fq); S.done(cur); }
        if (!has_next) break;
#pragma unroll
        for (int a = 0; a < 2; ++a)
#pragma unroll
            for (int b = 0; b < 2; ++b)
#pragma unroll
                for (int m = 0; m < 4; ++m)
#pragma unroll
                    for (int n = 0; n < 2; ++n) acc[a][b][m][n] = (f32x4){0.f, 0.f, 0.f, 0.f};
        cur = nxt; cA = nA; cB = nB; ++ui;
        if constexpr (ALIGN_EPI) { if (wr == 1) PG8_BAR; }
    }
    PG8_WAIT_V(0);
    if constexpr (!ALIGN_EPI) { if (wr == 0) PG8_BAR; }
    PG8_BAR;
    if constexpr (Epi::AFTER_DRAIN) { E.fused(acc, cur, wr, wc, fr, fq, lds, wid, lane); S.done(cur); }
#undef PG8_SA
#undef PG8_SB
#undef PG8_STAGE
#undef PG8_LDA
#undef PG8_LDB
#undef PG8_MMA
#undef PG8_WAIT_V
#undef PG8_WAIT_L
#undef PG8_BAR
#undef PG8_SCHED
}
}
#define GAS __attribute__((address_space(1)))
#define LAS __attribute__((address_space(3)))
typedef unsigned short bf16;
typedef unsigned v4u __attribute__((ext_vector_type(4)));
typedef float f32x4 __attribute__((ext_vector_type(4)));
typedef short bf16x8 __attribute__((ext_vector_type(8)));
typedef GAS unsigned gu32;
typedef GAS unsigned long long gu64;
#define RLX_AGENT __ATOMIC_RELAXED, __HIP_MEMORY_SCOPE_AGENT
#define LDS_WAIT() asm volatile("s_waitcnt lgkmcnt(0)" ::: "memory")
#define VM_WAIT() asm volatile("s_waitcnt vmcnt(0)" ::: "memory")
__device__ __forceinline__ unsigned long long rt() { return __builtin_amdgcn_s_memrealtime(); }
__device__ __forceinline__ unsigned f2bf(float f) { unsigned u = __builtin_bit_cast(unsigned, f); return (u + 0x7fffu + ((u >> 16) & 1u)) >> 16; }
__device__ __forceinline__ unsigned pk2(float lo, float hi) { return f2bf(lo) | (f2bf(hi) << 16); }

#define XB_TMO      128
#define XB_XCNT(j)  (256  + 64 * (j))
#define XB_XSUB(j)  (1280 + 64 * (j))
#define XB_XGEN(j)  (2304 + 64 * (j))
#define XB_TOP      3328
#define XB_TOPGEN   3392
#define XCD_BAR_WORDS 3456
#define XB_SPIN_CAP (1u << 18)

__device__ __forceinline__ unsigned xb_ld(unsigned* p)              { return __hip_atomic_load(p, __ATOMIC_RELAXED, __HIP_MEMORY_SCOPE_AGENT); }
__device__ __forceinline__ unsigned xb_add(unsigned* p, unsigned v) { return __hip_atomic_fetch_add(p, v, __ATOMIC_RELAXED, __HIP_MEMORY_SCOPE_AGENT); }
__device__ __forceinline__ unsigned xb_xcc_id() { return (unsigned)__builtin_amdgcn_s_getreg((3 << 11) | 20) & 0xFu; }
#define XB_SPIN(cond, bar) do { unsigned _sp = 0; while (cond) { __builtin_amdgcn_s_sleep(1); \
    if ((++_sp & 255u) == 0u) { if (xb_ld(&(bar)[XB_TMO])) break; if (_sp > XB_SPIN_CAP) { atomicAdd(&(bar)[XB_TMO], 1u); break; } } } } while (0)

struct XcdBarrier {
    unsigned* bar; unsigned x;
    volatile LAS unsigned* st;
};

__device__ __forceinline__ XcdBarrier xcd_barrier_post(unsigned* bar, volatile LAS unsigned* st) {
    XcdBarrier b; b.bar = bar; b.x = xb_xcc_id(); b.st = st;
    if (threadIdx.x == 0) (void)xb_add(&bar[XB_XCNT(b.x)], 1u);
    return b;
}
__device__ __forceinline__ void xcd_barrier_complete(unsigned* bar, unsigned x, unsigned& nloc, unsigned& nx) {
    const unsigned G = gridDim.x * gridDim.y * gridDim.z;
    unsigned sum, cnt, mine, sp = 0u;
    for (;;) {
        sum = 0u; cnt = 0u; mine = 0u;
#pragma unroll
        for (unsigned j = 0; j < 16; ++j) { const unsigned c = xb_ld(&bar[XB_XCNT(j)]); sum += c; cnt += (c > 0u) ? 1u : 0u; mine = (j == x) ? c : mine; }
        if (sum == G) break;
        __builtin_amdgcn_s_sleep(1);
        if ((++sp & 255u) == 0u) { if (xb_ld(&bar[XB_TMO])) break; if (sp > XB_SPIN_CAP) { atomicAdd(&bar[XB_TMO], 1u); break; } }
    }
    nloc = mine > 0u ? mine : 1u; nx = cnt > 0u ? cnt : 1u;
}

__device__ __forceinline__ void xcd_barrier(const XcdBarrier& b) {
    asm volatile("s_waitcnt vmcnt(0)" ::: "memory");
    __syncthreads();
    if (threadIdx.x == 0) {
        unsigned* bar = b.bar;
        __builtin_amdgcn_s_waitcnt(0);
        unsigned nloc = b.st[0], nx = b.st[1];
        if (nloc == 0u) { xcd_barrier_complete(bar, b.x, nloc, nx); b.st[0] = nloc; b.st[1] = nx; }
        const unsigned old = xb_add(&bar[XB_XSUB(b.x)], 1u);
        const unsigned gen = old / nloc;
        if (old + 1u == (gen + 1u) * nloc) {
            __builtin_amdgcn_fence(__ATOMIC_RELEASE, "agent");
            asm volatile("s_waitcnt vmcnt(0)" ::: "memory");
            const unsigned og = xb_add(&bar[XB_TOP], 1u);
            const unsigned tg = og / nx;
            if (og + 1u == (tg + 1u) * nx) xb_add(&bar[XB_TOPGEN], 1u);
            else XB_SPIN(xb_ld(&bar[XB_TOPGEN]) == tg, bar);
            __builtin_amdgcn_fence(__ATOMIC_ACQUIRE, "agent");
            xb_add(&bar[XB_XGEN(b.x)], 1u);
            asm volatile("s_waitcnt vmcnt(0)" ::: "memory");
        } else {
            XB_SPIN(xb_ld(&bar[XB_XGEN(b.x)]) == gen, bar);
            __builtin_amdgcn_fence(__ATOMIC_ACQUIRE, "agent");
            asm volatile("s_waitcnt vmcnt(0)" ::: "memory");
        }
    }
    __syncthreads();
}

#ifndef PH_MASK
#define PH_MASK 0x3ff
#endif
#define PH(n) ((PH_MASK >> (n)) & 1)
#ifndef P0SUB
#define P0SUB 7
#endif
constexpr int NWAVES = 8;
constexpr int BATCH = 16, SEQ = 4096, DM = 1024, M = BATCH * SEQ;
constexpr int INW = 9744;
constexpr int C_GQ = 4608, C_GLR = 7680, C_GA = 7696;
constexpr int NA = 4608, NB = 5120, NGLA = 3072, NGATE = 2048, FFH = 2816, NFF = 5632, AOW = 512;
constexpr float EPS = 1e-6f;
constexpr float QSCALE = 0.08838834764831845f * 1.4426950408889634f;
constexpr float GLA_QS = 0.08838834764831845f;

constexpr size_t MiB = 1u << 20;
constexpr size_t WS_CTL = 0, CTL_ZERO_BYTES = 1 * MiB;
constexpr int CW_TMO = 0, CW_BAR = 4096;
constexpr size_t WS_SSQ1 = 256 * 1024, WS_SSQ2 = 512 * 1024;
constexpr size_t WS_ROPE = 1 * MiB;
constexpr size_t WS_GLR = 2 * MiB;
constexpr size_t WS_WB = 6 * MiB, WS_WA = 16 * MiB, WS_WBA = 25 * MiB, WS_WBB = 26 * MiB, WS_WOUT = 28 * MiB, WS_WFF = 30 * MiB, WS_WDN = 41 * MiB;
constexpr size_t WS_H = 48 * MiB;
constexpr size_t WS_GLAOUT = 176 * MiB;
constexpr size_t WS_BIG = 304 * MiB;
constexpr size_t WS_MIX = 304 * MiB, WS_X1B = 432 * MiB, WS_ACT = 560 * MiB;
constexpr size_t WS_ATT = 880 * MiB;
constexpr size_t WS_END = 1024 * MiB;
static_assert(WS_BIG + (size_t)M * NA * 2 <= WS_ATT && WS_ATT + (size_t)M * AOW * 2 <= WS_END && WS_ACT + (size_t)M * FFH * 2 <= WS_END, "ws map");

constexpr int RING_OFF = 0, RING_BYTES = 131072;
constexpr int LDSCTL_OFF = RING_BYTES, MISC_OFF = LDSCTL_OFF + 320;
constexpr int LDS_BYTES = 147456;

__device__ __forceinline__ float bf2f(unsigned short b) { return __builtin_bit_cast(float, (unsigned)b << 16); }
__device__ __forceinline__ float bflo(unsigned w) { return __builtin_bit_cast(float, w << 16); }
__device__ __forceinline__ float bfhi(unsigned w) { return __builtin_bit_cast(float, w & 0xffff0000u); }
__device__ __forceinline__ float wave_sum(float v) {
#pragma unroll
    for (int o = 1; o < 64; o <<= 1) v += __shfl_xor(v, o);
    return v;
}
__device__ __forceinline__ float wave_max(float v) {
#pragma unroll
    for (int o = 1; o < 64; o <<= 1) v = fmaxf(v, __shfl_xor(v, o));
    return v;
}
__device__ __forceinline__ float sigmoidf_(float v) { return 1.0f / (1.0f + __expf(-v)); }

namespace pg8 {
struct EpiB {
    static constexpr bool PERM = true, AFTER_DRAIN = false;
    bf16_t* G; bf16_t* GT;
    __device__ __forceinline__ void operator()(const f32x4 (&acc)[2][2][4][2], const Unit& u, int wr, int wc, int fr, int fq) const {
        const int row0 = u.pm * BM + wr * 64 + fr; const int colt = u.pn * BM; const bool gate = colt >= 3072;
        bf16_t* base = gate ? GT + (colt - 3072) : G + colt; const int ldc = gate ? 2048 : 3072;
        const int col0 = wc * 32 + 8 * fq;
#pragma unroll
        for (int ai = 0; ai < 2; ++ai)
#pragma unroll
            for (int m = 0; m < 4; ++m) { bf16_t* rowp = base + (size_t)(row0 + ai * HALF + m * 16) * ldc + col0;
#pragma unroll
                for (int bj = 0; bj < 2; ++bj) { f32x4 v0 = acc[ai][bj][m][0], v1 = acc[ai][bj][m][1];
                    if (gate) {
#pragma unroll
                        for (int e = 0; e < 4; ++e) { v0[e] = 1.0f / (1.0f + __expf(-v0[e])); v1[e] = 1.0f / (1.0f + __expf(-v1[e])); } }
                    u32x4 w; w.x = cvt_pk_bf16(v0[0], v0[1]); w.y = cvt_pk_bf16(v0[2], v0[3]); w.z = cvt_pk_bf16(v1[0], v1[1]); w.w = cvt_pk_bf16(v1[2], v1[3]);
                    *(u32x4*)(rowp + bj * HALF) = w; } }
    }
};
struct EpiA {
    static constexpr bool PERM = true, AFTER_DRAIN = false;
    bf16_t* O; const float* rope; float qsc;
    __device__ __forceinline__ void operator()(const f32x4 (&acc)[2][2][4][2], const Unit& u, int wr, int wc, int fr, int fq) const {
        const int row0 = u.pm * BM + wr * 64 + fr; const int colt = u.pn * BM;
        const int col0 = colt + wc * 32 + 8 * fq;
        const bool dorope = (colt < 3072) && (wc == 0);
        const float sc = (colt < 1536) ? qsc : 1.0f;
#pragma unroll
        for (int ai = 0; ai < 2; ++ai)
#pragma unroll
            for (int m = 0; m < 4; ++m) { const int row = row0 + ai * HALF + m * 16; bf16_t* rowp = O + (size_t)row * 4608 + col0;
                f32x4 cs = {1.f, 1.f, 1.f, 1.f}, sn = {0.f, 0.f, 0.f, 0.f};
                if (dorope) { const float* tp = rope + (size_t)(row & (SEQ_MASK)) * 32 + 4 * fq; cs = *(const f32x4*)tp; sn = *(const f32x4*)(tp + 16); }
#pragma unroll
                for (int bj = 0; bj < 2; ++bj) { f32x4 v0 = acc[ai][bj][m][0], v1 = acc[ai][bj][m][1];
                    if (dorope) {
                        f32x4 a, b;
                        a[0] = v0[0] * cs[0] - v0[1] * sn[0]; a[1] = v0[1] * cs[0] + v0[0] * sn[0];
                        a[2] = v0[2] * cs[1] - v0[3] * sn[1]; a[3] = v0[3] * cs[1] + v0[2] * sn[1];
                        b[0] = v1[0] * cs[2] - v1[1] * sn[2]; b[1] = v1[1] * cs[2] + v1[0] * sn[2];
                        b[2] = v1[2] * cs[3] - v1[3] * sn[3]; b[3] = v1[3] * cs[3] + v1[2] * sn[3];
                        v0 = a; v1 = b; }
                    v0 = v0 * sc; v1 = v1 * sc;
                    u32x4 w; w.x = cvt_pk_bf16(v0[0], v0[1]); w.y = cvt_pk_bf16(v0[2], v0[3]); w.z = cvt_pk_bf16(v1[0], v1[1]); w.w = cvt_pk_bf16(v1[2], v1[3]);
                    *(u32x4*)(rowp + bj * HALF) = w; } }
    }
    static constexpr int SEQ_MASK = 4095;
};
template <int MODE> struct EpiMix {
    static constexpr bool PERM = true, AFTER_DRAIN = false;
    const bf16_t* GT; const bf16_t* T1in; bf16_t* O;
    __device__ __forceinline__ void operator()(const f32x4 (&acc)[2][2][4][2], const Unit& u, int wr, int wc, int fr, int fq) const {
        const int row0 = u.pm * BM + wr * 64 + fr; const int col0 = u.pn * BM + wc * 32 + 8 * fq;
#pragma unroll
        for (int ai = 0; ai < 2; ++ai)
#pragma unroll
            for (int m = 0; m < 4; ++m) { const size_t row = (size_t)(row0 + ai * HALF + m * 16);
#pragma unroll
                for (int bj = 0; bj < 2; ++bj) { const int c = col0 + bj * HALF;
                    const u32x4 g = *(const u32x4*)(GT + row * 2048 + MODE * 1024 + c);
                    f32x4 v0 = acc[ai][bj][m][0], v1 = acc[ai][bj][m][1];
                    v0[0] *= __builtin_bit_cast(float, g.x << 16); v0[1] *= __builtin_bit_cast(float, g.x & 0xffff0000u);
                    v0[2] *= __builtin_bit_cast(float, g.y << 16); v0[3] *= __builtin_bit_cast(float, g.y & 0xffff0000u);
                    v1[0] *= __builtin_bit_cast(float, g.z << 16); v1[1] *= __builtin_bit_cast(float, g.z & 0xffff0000u);
                    v1[2] *= __builtin_bit_cast(float, g.w << 16); v1[3] *= __builtin_bit_cast(float, g.w & 0xffff0000u);
                    if (MODE == 1) { const u32x4 t = *(const u32x4*)(T1in + row * 1024 + c);
                        v0[0] += __builtin_bit_cast(float, t.x << 16); v0[1] += __builtin_bit_cast(float, t.x & 0xffff0000u);
                        v0[2] += __builtin_bit_cast(float, t.y << 16); v0[3] += __builtin_bit_cast(float, t.y & 0xffff0000u);
                        v1[0] += __builtin_bit_cast(float, t.z << 16); v1[1] += __builtin_bit_cast(float, t.z & 0xffff0000u);
                        v1[2] += __builtin_bit_cast(float, t.w << 16); v1[3] += __builtin_bit_cast(float, t.w & 0xffff0000u); }
                    u32x4 w; w.x = cvt_pk_bf16(v0[0], v0[1]); w.y = cvt_pk_bf16(v0[2], v0[3]); w.z = cvt_pk_bf16(v1[0], v1[1]); w.w = cvt_pk_bf16(v1[2], v1[3]);
                    *(u32x4*)(O + row * 1024 + c) = w; } }
    }
};
template <bool WB> struct EpiRes {
    static constexpr bool PERM = false, AFTER_DRAIN = false;
    const float* base; float* out; bf16_t* ob; float* ssq;
    __device__ __forceinline__ void operator()(const f32x4 (&acc)[2][2][4][2], const Unit& u, int wr, int wc, int fr, int fq) const {
        typedef unsigned u32x2v __attribute__((ext_vector_type(2)));
        const int row0 = u.pm * BM + wr * 64 + fr, col0 = u.pn * BM + wc * 32 + 4 * fq;
#pragma unroll
        for (int ai = 0; ai < 2; ++ai)
#pragma unroll
            for (int m = 0; m < 4; ++m) { const int row = row0 + ai * HALF + m * 16; const size_t off = (size_t)row * 1024 + col0; float s = 0.f;
#pragma unroll
                for (int bj = 0; bj < 2; ++bj)
#pragma unroll
                    for (int n = 0; n < 2; ++n) { const f32x4 bs = *(const f32x4*)(base + off + bj * HALF + n * 16); const f32x4 o = bs + acc[ai][bj][m][n];
                        *(f32x4*)(out + off + bj * HALF + n * 16) = o; s += (o[0] * o[0] + o[1] * o[1]) + (o[2] * o[2] + o[3] * o[3]);
                        if (WB) { u32x2v w; w.x = cvt_pk_bf16(o[0], o[1]); w.y = cvt_pk_bf16(o[2], o[3]); *(u32x2v*)(ob + off + bj * HALF + n * 16) = w; } }
                s += __shfl_xor(s, 16); s += __shfl_xor(s, 32);
                if (fq == 0) __hip_atomic_fetch_add(ssq + row, s, __ATOMIC_RELAXED, __HIP_MEMORY_SCOPE_AGENT); }
    }
};
struct EpiSwi {
    static constexpr bool PERM = true, AFTER_DRAIN = false;
    bf16_t* O; const float* ssq;
    __device__ __forceinline__ void operator()(const f32x4 (&acc)[2][2][4][2], const Unit& u, int wr, int wc, int fr, int fq) const {
        const int row0 = u.pm * BM + wr * 64 + fr; const int col0 = u.pn * HALF + wc * 32 + 8 * fq;
#pragma unroll
        for (int ai = 0; ai < 2; ++ai)
#pragma unroll
            for (int m = 0; m < 4; ++m) { const int row = row0 + ai * HALF + m * 16; const float r = 1.0f / sqrtf(ssq[row] * (1.0f / 1024.0f) + EPS);
                f32x4 o[2];
#pragma unroll
                for (int n = 0; n < 2; ++n)
#pragma unroll
                    for (int e = 0; e < 4; ++e) { const float g = acc[ai][0][m][n][e] * r, uu = acc[ai][1][m][n][e] * r; o[n][e] = g / (1.0f + __expf(-g)) * uu; }
                u32x4 w; w.x = cvt_pk_bf16(o[0][0], o[0][1]); w.y = cvt_pk_bf16(o[0][2], o[0][3]); w.z = cvt_pk_bf16(o[1][0], o[1][1]); w.w = cvt_pk_bf16(o[1][2], o[1][3]);
                *(u32x4*)(O + (size_t)row * 2816 + col0) = w; }
    }
};
}

__device__ __forceinline__ void tr_item(const float* W, int ldw, int K, bf16* WT, int n0, int scb, bool rope, const float* kscale, int k0, LAS float* scr, int lane) {
#pragma unroll 8
    for (int i = 0; i < 32; ++i) { const int kk = 2 * i + (lane >> 5); float v = W[(size_t)(k0 + kk) * ldw + scb + (lane & 31)]; if (kscale) v *= kscale[k0 + kk]; scr[kk * 33 + (lane & 31)] = v; }
    LDS_WAIT(); asm volatile("" ::: "memory");
    const int c = lane & 7;
#pragma unroll
    for (int j = 0; j < 4; ++j) { const int n = (lane >> 3) + 8 * j; const int sn = rope ? ((n >> 1) + 16 * (n & 1)) : n; const LAS float* s = scr + (8 * c) * 33 + sn;
        v4u o; o.x = pk2(s[0 * 33], s[1 * 33]); o.y = pk2(s[2 * 33], s[3 * 33]); o.z = pk2(s[4 * 33], s[5 * 33]); o.w = pk2(s[6 * 33], s[7 * 33]);
        *(GAS v4u*)(WT + (size_t)(n0 + n) * K + k0 + 8 * c) = o; }
    LDS_WAIT(); asm volatile("" ::: "memory");
}

struct Args { const float* in[13]; float* out; unsigned char* ws; };

__global__ void __launch_bounds__(NWAVES * 64, 2) hyb_fwd(Args args) {
    extern __shared__ __attribute__((aligned(16))) unsigned char lds[];
    LAS unsigned char* L = (LAS unsigned char*)lds;
    volatile LAS unsigned* MISC = (volatile LAS unsigned*)(L + MISC_OFF);
    const int tid = threadIdx.x, lane = tid & 63, wave = __builtin_amdgcn_readfirstlane(tid >> 6);
    const int G = gridDim.x; const int bx = blockIdx.x; const int vcu = (G % 8 == 0) ? (bx % 8) * (G / 8) + bx / 8 : bx;
    unsigned char* ws = args.ws;
    gu32* ctl = (gu32*)(ws + WS_CTL);
    const float* x = args.in[0]; const float* norm1_g = args.in[1]; const float* w_in = args.in[2]; const float* w_gate_lr = args.in[3]; const float* b_gate = args.in[4];
    const float* gla_norm_g = args.in[5]; const float* w_branch_a = args.in[6]; const float* w_branch_b = args.in[7]; const float* w_out = args.in[8]; const float* norm2_g = args.in[9];
    const float* w_ffn_in = args.in[10]; const float* w_ffn_down = args.in[11]; const float* norm_f_g = args.in[12];
    float* out = args.out;
    bf16* WB_t = (bf16*)(ws + WS_WB); bf16* WA_t = (bf16*)(ws + WS_WA); bf16* WBA_t = (bf16*)(ws + WS_WBA); bf16* WBB_t = (bf16*)(ws + WS_WBB);
    bf16* WOUT_t = (bf16*)(ws + WS_WOUT); bf16* WFF_t = (bf16*)(ws + WS_WFF); bf16* WDN_t = (bf16*)(ws + WS_WDN);
    bf16* H = (bf16*)(ws + WS_H); bf16* T1 = (bf16*)(ws + WS_H); bf16* GLAOUT = (bf16*)(ws + WS_GLAOUT); bf16* GB = (bf16*)(ws + WS_BIG); bf16* PA = (bf16*)(ws + WS_BIG);
    bf16* MIX = (bf16*)(ws + WS_MIX); bf16* X1B = (bf16*)(ws + WS_X1B); bf16* ACT = (bf16*)(ws + WS_ACT); bf16* ATT = (bf16*)(ws + WS_ATT);
    bf16* GATE = (bf16*)out;
    float* ROPE = (float*)(ws + WS_ROPE); float* GLR = (float*)(ws + WS_GLR); float* SSQ1 = (float*)(ws + WS_SSQ1); float* SSQ2 = (float*)(ws + WS_SSQ2);

    for (int u = tid; u < (LDS_BYTES - LDSCTL_OFF) / 4; u += NWAVES * 64) ((LAS unsigned*)(L + LDSCTL_OFF))[u] = 0u;
    __syncthreads();
    XcdBarrier bar = xcd_barrier_post((unsigned*)(ctl + CW_BAR), MISC + 8);
    const int gw = vcu * NWAVES + wave, NGW = G * NWAVES;

#if PH(0)
    {
        LAS float* scr = (LAS float*)(L + RING_OFF + wave * 16384);
        constexpr int I_B = 16 * (NB / 32), I_A = 16 * (NA / 32), I_BA = 8 * 32, I_BB = 16 * 32, I_O = 16 * 32, I_FF = 16 * (NFF / 32), I_DN = 44 * 32;
        constexpr int NITEMS = I_B + I_A + I_BA + I_BB + I_O + I_FF + I_DN;
#if P0SUB & 1
        for (int it = gw; it < NITEMS; it += NGW) {
            int r = it;
            if (r < I_B) { const int nb = r % (NB / 32), kb = r / (NB / 32), n0 = nb * 32; const int scb = (n0 < 3072) ? C_GQ + n0 : C_GA + (n0 - 3072);
                tr_item(w_in, INW, 1024, WB_t, n0, scb, false, nullptr, kb * 64, scr, lane); continue; } r -= I_B;
            if (r < I_A) { const int nb = r % (NA / 32), kb = r / (NA / 32), n0 = nb * 32; const bool rope = (n0 < 3072) && ((n0 & 127) == 0);
                tr_item(w_in, INW, 1024, WA_t, n0, n0, rope, nullptr, kb * 64, scr, lane); continue; } r -= I_A;
            if (r < I_BA) { const int nb = r % 32, kb = r / 32; tr_item(w_branch_a, 1024, 512, WBA_t, nb * 32, nb * 32, false, nullptr, kb * 64, scr, lane); continue; } r -= I_BA;
            if (r < I_BB) { const int nb = r % 32, kb = r / 32; tr_item(w_branch_b, 1024, 1024, WBB_t, nb * 32, nb * 32, false, nullptr, kb * 64, scr, lane); continue; } r -= I_BB;
            if (r < I_O) { const int nb = r % 32, kb = r / 32; tr_item(w_out, 1024, 1024, WOUT_t, nb * 32, nb * 32, false, nullptr, kb * 64, scr, lane); continue; } r -= I_O;
            if (r < I_FF) { const int nb = r % (NFF / 32), kb = r / (NFF / 32), n0 = nb * 32; const int t = n0 >> 8, half = (n0 >> 7) & 1; const int scb = (half ? FFH : 0) + t * 128 + (n0 & 127);
                tr_item(w_ffn_in, NFF, 1024, WFF_t, n0, scb, false, norm2_g, kb * 64, scr, lane); continue; } r -= I_FF;
            { const int nb = r % 32, kb = r / 32; tr_item(w_ffn_down, 1024, FFH, WDN_t, nb * 32, nb * 32, false, nullptr, kb * 64, scr, lane); }
        }
#endif
#if P0SUB & 2
        for (int i = bx * 512 + tid; i < SEQ * 16; i += G * 512) { const int pos = i >> 4, f = i & 15;
            const float inv = exp2f(-(float)f * (18.931568569324174f / 16.0f)); const float ang = (float)pos * inv;
            const double rev = (double)ang * 0.15915494309189535; const float fr = (float)(rev - __builtin_rint(rev));
            ROPE[pos * 32 + f] = __builtin_amdgcn_cosf(fr); ROPE[pos * 32 + 16 + f] = __builtin_amdgcn_sinf(fr); }
#endif
        __syncthreads();
#if P0SUB & 4
        LAS float* WL = (LAS float*)(L + RING_OFF);
        for (int i = tid; i < 16384; i += 512) { const int q = i & 3, ln = (i >> 2) & 63, p = (i >> 8) & 3, e = (i >> 10) & 3, j = i >> 12; const int k = 4 * (ln + 64 * j) + e;
            WL[i] = w_in[(size_t)k * INW + C_GLR + 4 * p + q]; }
        __syncthreads();
        f32x4 g1[4];
#pragma unroll
        for (int j = 0; j < 4; ++j) g1[j] = ((const f32x4*)norm1_g)[lane + 64 * j];
#pragma unroll 1
        for (int m0 = gw; m0 < M; m0 += NGW) {
            asm volatile("" ::: "memory");
            f32x4 hv[4];
            { const GAS f32x4* xr = (const GAS f32x4*)(x + (size_t)m0 * DM) + lane; float s = 0.f;
#pragma unroll
                for (int j = 0; j < 4; ++j) { hv[j] = xr[64 * j]; s += (hv[j].x * hv[j].x + hv[j].y * hv[j].y) + (hv[j].z * hv[j].z + hv[j].w * hv[j].w); }
                const float rs = 1.0f / sqrtf(wave_sum(s) * (1.0f / DM) + EPS);
                GAS unsigned long long* o8 = (GAS unsigned long long*)(H + (size_t)m0 * DM) + lane;
#pragma unroll
                for (int j = 0; j < 4; ++j) { hv[j] = hv[j] * rs * g1[j]; o8[64 * j] = (unsigned long long)pk2(hv[j].x, hv[j].y) | ((unsigned long long)pk2(hv[j].z, hv[j].w) << 32); } }
            float a[16];
#pragma unroll
            for (int i = 0; i < 16; ++i) a[i] = 0.f;
#pragma unroll
            for (int j = 0; j < 4; ++j) {
#pragma unroll
                for (int e = 0; e < 4; ++e) { const float xv = hv[j][e];
#pragma unroll
                    for (int p = 0; p < 4; ++p) { const f32x4 w4 = ((const LAS f32x4*)WL)[((j * 4 + e) * 4 + p) * 64 + lane];
                        a[4 * p] += w4.x * xv; a[4 * p + 1] += w4.y * xv; a[4 * p + 2] += w4.z * xv; a[4 * p + 3] += w4.w * xv; } }
                asm volatile("" ::: "memory"); }
            float b8[8], c4[4], d2[2];
#pragma unroll
            for (int i = 0; i < 8; ++i) { const bool hi = (lane & 32) != 0; const float mine = hi ? a[i + 8] : a[i], oth = hi ? a[i] : a[i + 8]; b8[i] = mine + __shfl_xor(oth, 32); }
#pragma unroll
            for (int i = 0; i < 4; ++i) { const bool hi = (lane & 16) != 0; const float mine = hi ? b8[i + 4] : b8[i], oth = hi ? b8[i] : b8[i + 4]; c4[i] = mine + __shfl_xor(oth, 16); }
#pragma unroll
            for (int i = 0; i < 2; ++i) { const bool hi = (lane & 8) != 0; const float mine = hi ? c4[i + 2] : c4[i], oth = hi ? c4[i] : c4[i + 2]; d2[i] = mine + __shfl_xor(oth, 8); }
            float f1; { const bool hi = (lane & 4) != 0; const float mine = hi ? d2[1] : d2[0], oth = hi ? d2[0] : d2[1]; f1 = mine + __shfl_xor(oth, 4); }
            f1 += __shfl_xor(f1, 2); f1 += __shfl_xor(f1, 1);
            if ((lane & 3) == 0) GLR[(size_t)m0 * 16 + ((lane >> 2) & 15)] = f1;
        }
#endif
    }
#endif
    xcd_barrier(bar);

#if PH(1)
    { pg8::Gemm g{H, WB_t, M, NB, 1024}; pg8::StaticOrder S; S.init(M, NB, G, bx); pg8::EpiB E{GB, GATE};
      pg8::gemm_phase<pg8::EpiB, pg8::StaticOrder, true, true>(L + RING_OFF, g, S, E); }
#endif
    xcd_barrier(bar);

#if PH(2)
    {
        LAS float* a_s = (LAS float*)(L + RING_OFF);
        LAS float* k_s = a_s + 2048; LAS float* q_s = k_s + 2048;
        LAS float* op = q_s + 2048;
        const int v = tid & 255, dh = tid >> 8, dcol = tid & 127;
        for (int unit = vcu; unit < 64; unit += G) {
            const int b = unit >> 2, h = unit & 3;
            float S[64];
#pragma unroll
            for (int i = 0; i < 64; ++i) S[i] = 0.f;
            float wg[16];
#pragma unroll
            for (int r = 0; r < 16; ++r) wg[r] = w_gate_lr[r * 512 + h * 128 + dcol];
            const float bias = b_gate[h * 128 + dcol];
#pragma unroll 1
            for (int t0 = 0; t0 < SEQ; t0 += 16) {
                const size_t rowbase = (size_t)b * SEQ + t0;
#pragma unroll
                for (int i = 0; i < 4; ++i) { const int tt = (tid >> 7) + 4 * i; const size_t row = rowbase + tt;
                    const f32x4* gp = (const f32x4*)(GLR + row * 16); float z = bias;
#pragma unroll
                    for (int r4 = 0; r4 < 4; ++r4) { const f32x4 gv = gp[r4]; z += gv.x * wg[4 * r4] + gv.y * wg[4 * r4 + 1] + gv.z * wg[4 * r4 + 2] + gv.w * wg[4 * r4 + 3]; }
                    const float ls = fminf(z, 0.f) - log1pf(__expf(-fabsf(z)));
                    a_s[tt * 128 + dcol] = __expf(ls * (1.0f / 16.0f));
                    k_s[tt * 128 + dcol] = bf2f(GB[row * 3072 + 512 + h * 128 + dcol]);
                    q_s[tt * 128 + dcol] = bf2f(GB[row * 3072 + h * 128 + dcol]) * GLA_QS; }
                __syncthreads();
#pragma unroll 1
                for (int tt = 0; tt < 16; ++tt) {
                    const float vv = bf2f(GB[(rowbase + tt) * 3072 + 1024 + h * 256 + v]); float o = 0.f;
                    const LAS f32x4* ap = (const LAS f32x4*)(a_s + tt * 128 + dh * 64); const LAS f32x4* kp = (const LAS f32x4*)(k_s + tt * 128 + dh * 64); const LAS f32x4* qp = (const LAS f32x4*)(q_s + tt * 128 + dh * 64);
#pragma unroll
                    for (int d4 = 0; d4 < 16; ++d4) { const f32x4 a4 = ap[d4], k4 = kp[d4], q4 = qp[d4];
#pragma unroll
                        for (int e = 0; e < 4; ++e) { S[4 * d4 + e] = a4[e] * S[4 * d4 + e] + k4[e] * vv; o += q4[e] * S[4 * d4 + e]; } }
                    op[(tt * 2 + dh) * 256 + v] = o;
                }
                __syncthreads();
#pragma unroll
                for (int i = 0; i < 2; ++i) { const int tt = wave * 2 + i; const size_t row = rowbase + tt; float ov[4]; float s = 0.f;
#pragma unroll
                    for (int c = 0; c < 4; ++c) { const int vi = lane + 64 * c; ov[c] = op[(tt * 2) * 256 + vi] + op[(tt * 2 + 1) * 256 + vi]; s += ov[c] * ov[c]; }
                    const float rs = 1.0f / sqrtf(wave_sum(s) * (1.0f / 256.0f) + EPS);
#pragma unroll
                    for (int c = 0; c < 4; ++c) { const int vi = lane + 64 * c; const float gr = bf2f(GB[row * 3072 + 2048 + h * 256 + vi]);
                        const float y = ov[c] * rs * gla_norm_g[vi] * (gr / (1.0f + __expf(-gr)));
                        GLAOUT[row * 1024 + h * 256 + vi] = (bf16)f2bf(y); } }
                __syncthreads();
            }
        }
    }
#endif
    xcd_barrier(bar);

#if PH(3)
    { pg8::Gemm g{H, WA_t, M, NA, 1024}; pg8::StaticOrder S; S.init(M, NA, G, bx); pg8::EpiA E{PA, ROPE, QSCALE};
      pg8::gemm_phase<pg8::EpiA, pg8::StaticOrder, true, true>(L + RING_OFF, g, S, E); }
#endif
    xcd_barrier(bar);

#if PH(4)
    {
        LAS float* qs = (LAS float*)(L + RING_OFF) + wave * 384;
        for (int unit = gw; unit < M * 4; unit += NGW) {
            const int row = unit >> 2, j = unit & 3, t = row & (SEQ - 1);
#pragma unroll
            for (int g = 0; g < 3; ++g) { const unsigned q2 = *(const unsigned*)(PA + (size_t)row * NA + (4 * g + j) * 128 + 2 * lane); qs[g * 128 + 2 * lane] = bflo(q2); qs[g * 128 + 2 * lane + 1] = bfhi(q2); }
            LDS_WAIT(); asm volatile("" ::: "memory");
            float sc[3][3];
#pragma unroll
            for (int g = 0; g < 3; ++g) { const int r = 1 << (2 * g); const int h = 4 * g + j;
#pragma unroll
                for (int rd = 0; rd < 3; ++rd) { const int kk = rd * 64 + lane; const bool valid = (rd < 2 || lane == 0) && (t - kk * r >= 0);
                    float dot = -__builtin_inff();
                    if (valid) { const v4u* kp = (const v4u*)(PA + (size_t)(row - kk * r) * NA + 1536 + h * 128); const LAS f32x4* qp = (const LAS f32x4*)(qs + g * 128); dot = 0.f;
#pragma unroll 4
                        for (int c = 0; c < 16; ++c) { const v4u kv = kp[c]; const f32x4 qa = qp[2 * c], qb = qp[2 * c + 1];
                            dot += bflo(kv.x) * qa.x + bfhi(kv.x) * qa.y + bflo(kv.y) * qa.z + bfhi(kv.y) * qa.w + bflo(kv.z) * qb.x + bfhi(kv.z) * qb.y + bflo(kv.w) * qb.z + bfhi(kv.w) * qb.w; } }
                    sc[g][rd] = dot; } }
            float mx = -__builtin_inff();
#pragma unroll
            for (int g = 0; g < 3; ++g)
#pragma unroll
                for (int rd = 0; rd < 3; ++rd) mx = fmaxf(mx, sc[g][rd]);
            mx = wave_max(mx); float ls = 0.f;
#pragma unroll
            for (int g = 0; g < 3; ++g)
#pragma unroll
                for (int rd = 0; rd < 3; ++rd) { sc[g][rd] = exp2f(sc[g][rd] - mx); ls += sc[g][rd]; }
            ls = wave_sum(ls);
            float o0 = 0.f, o1 = 0.f;
#pragma unroll
            for (int g = 0; g < 3; ++g) { const int r = 1 << (2 * g); const int h = 4 * g + j; const bf16* vbase = PA + 3072 + h * 128 + 2 * lane;
#pragma unroll
                for (int rd = 0; rd < 3; ++rd) { const int cnt = rd < 2 ? 64 : 1;
                    for (int l2 = 0; l2 < cnt; ++l2) { const int kk = rd * 64 + l2; if (t - kk * r < 0) break;
                        const float pv = __shfl(sc[g][rd], l2); const unsigned v2 = *(const unsigned*)(vbase + (size_t)(row - kk * r) * NA);
                        o0 += pv * bflo(v2); o1 += pv * bfhi(v2); } } }
            const float il = 1.0f / ls;
            *(unsigned*)(ATT + (size_t)row * AOW + j * 128 + 2 * lane) = pk2(o0 * il, o1 * il);
            asm volatile("" ::: "memory");
        }
    }
#endif
    xcd_barrier(bar);

#if PH(5)
    { pg8::Gemm g{ATT, WBA_t, M, 1024, 512}; pg8::StaticOrder S; S.init(M, 1024, G, bx); pg8::EpiMix<0> E{GATE, nullptr, T1};
      pg8::gemm_phase<pg8::EpiMix<0>, pg8::StaticOrder, true, true>(L + RING_OFF, g, S, E); }
    __syncthreads();
    { pg8::Gemm g{GLAOUT, WBB_t, M, 1024, 1024}; pg8::StaticOrder S; S.init(M, 1024, G, bx); pg8::EpiMix<1> E{GATE, T1, MIX};
      pg8::gemm_phase<pg8::EpiMix<1>, pg8::StaticOrder, true, true>(L + RING_OFF, g, S, E); }
#endif
    xcd_barrier(bar);

#if PH(6)
    { pg8::Gemm g{MIX, WOUT_t, M, 1024, 1024}; pg8::StaticOrder S; S.init(M, 1024, G, bx); pg8::EpiRes<true> E{x, out, X1B, SSQ1};
      pg8::gemm_phase<pg8::EpiRes<true>, pg8::StaticOrder, true, true>(L + RING_OFF, g, S, E); }
#endif
    xcd_barrier(bar);

#if PH(7)
    { pg8::Gemm g{X1B, WFF_t, M, NFF, 1024}; pg8::StaticOrder S; S.init(M, NFF, G, bx); pg8::EpiSwi E{ACT, SSQ1};
      pg8::gemm_phase<pg8::EpiSwi, pg8::StaticOrder, true, true>(L + RING_OFF, g, S, E); }
#endif
    xcd_barrier(bar);

#if PH(8)
    { pg8::Gemm g{ACT, WDN_t, M, 1024, FFH}; pg8::StaticOrder S; S.init(M, 1024, G, bx); pg8::EpiRes<false> E{out, out, nullptr, SSQ2};
      pg8::gemm_phase<pg8::EpiRes<false>, pg8::StaticOrder, true, true>(L + RING_OFF, g, S, E); }
#endif
    xcd_barrier(bar);

#if PH(9)
    {
        const bool bad = (__hip_atomic_load(ctl + CW_BAR + XB_TMO, RLX_AGENT) != 0u);
        f32x4 gf[4];
#pragma unroll
        for (int j = 0; j < 4; ++j) gf[j] = ((const f32x4*)norm_f_g)[lane + 64 * j];
        for (int m = gw; m < M; m += NGW) { GAS f32x4* xr = (GAS f32x4*)(out + (size_t)m * DM) + lane; float rs = 1.0f / sqrtf(SSQ2[m] * (1.0f / DM) + EPS);
            if (bad) rs = __builtin_nanf("");
#pragma unroll
            for (int j = 0; j < 4; ++j) { const f32x4 v = xr[64 * j]; xr[64 * j] = v * rs * gf[j]; } }
    }
#endif
}

extern "C" void kernel_launch(void* const* d_in, const int* in_sizes, int n_in, void* d_out, int out_size, void* d_ws, size_t ws_size, hipStream_t stream) {
    static int grid = 0;
    if (grid == 0) {
        if (n_in != 13 || in_sizes[0] != M * DM || out_size != M * DM || ws_size < WS_END) { fprintf(stderr, "kernel_launch: unexpected shapes (n_in %d, in0 %d, out %d, ws %zu)\n", n_in, n_in > 0 ? in_sizes[0] : -1, out_size, ws_size); grid = -1; return; }
        int dev = 0, cus = 0, per_cu = 0;
        if (hipGetDevice(&dev) != hipSuccess || hipDeviceGetAttribute(&cus, hipDeviceAttributeMultiprocessorCount, dev) != hipSuccess) { grid = -1; return; }
        if (hipFuncSetAttribute((const void*)hyb_fwd, hipFuncAttributeMaxDynamicSharedMemorySize, LDS_BYTES) != hipSuccess) { grid = -1; return; }
        if (hipOccupancyMaxActiveBlocksPerMultiprocessor(&per_cu, (const void*)hyb_fwd, NWAVES * 64, LDS_BYTES) != hipSuccess || per_cu < 1) { fprintf(stderr, "kernel_launch: occupancy query says %d\n", per_cu); }
        (void)hipGetLastError();
        grid = cus;
    }
    if (grid < 0) return;
    if (hipMemsetAsync((char*)d_ws + WS_CTL, 0, CTL_ZERO_BYTES, stream) != hipSuccess) return;
    Args a{};
    for (int i = 0; i < 13; ++i) a.in[i] = (const float*)d_in[i];
    a.out = (float*)d_out; a.ws = (unsigned char*)d_ws;
    hipLaunchKernelGGL(hyb_fwd, dim3(grid), dim3(NWAVES * 64), LDS_BYTES, stream, a);
}
```

```cpp
#include <hip/hip_runtime.h>
#include <cstdio>
#include <cstdint>
namespace pg8 {
#define PG8_LAS __attribute__((address_space(3)))
typedef unsigned short bf16_t;
typedef short bf16x8 __attribute__((ext_vector_type(8)));
typedef float f32x4 __attribute__((ext_vector_type(4)));
typedef unsigned u32x4 __attribute__((ext_vector_type(4)));
constexpr int BM = 256, BK = 64, HALF = 128, HTB = HALF * BK * 2  , STAGE_BYTES = 8 * HTB, NXCD = 8, WGM = 8;

__host__ __device__ __forceinline__ int lds_byte(int r, int c) { const int st = (r >> 4) * 2 + (c >> 5), rr = r & 15, cc = c & 31, ob = rr * 64 + cc * 2; return st * 1024 + (ob ^ (((ob >> 9) & 1) << 5)); }
__host__ __device__ __forceinline__ void stage_rc(int b, int& R, int& C) { const int st = b / 1024, sb = b % 1024, swz = sb ^ (((sb >> 9) & 1) << 5); R = (st >> 1) * 16 + swz / 64; C = (st & 1) * 32 + (swz % 64) / 2; }
__host__ __device__ __forceinline__ int perm32(int rho) { const int n = rho >> 4, i = rho & 15; return 8 * (i >> 2) + 4 * n + (i & 3); }

struct Unit { int pm, pn; };
struct Gemm { const bf16_t* A; const bf16_t* Bt; int M, N, K; int lda = 0; };

struct StaticOrder {
    int nM, nN, nwg, G, c;
    __host__ __device__ void init(int M, int N, int G_, int c_) { nM = M / BM; nN = N / BM; nwg = nM * nN; G = G_; c = c_; }
    __host__ __device__ bool next(int i, Unit& u) const {
        const long L = (long)i * G + c; if (L >= nwg) return false;
        int wgid = (int)L; { const int q = nwg / NXCD, r = nwg % NXCD, xcd = wgid % NXCD, off = wgid / NXCD; wgid = (xcd < r ? xcd * (q + 1) : r * (q + 1) + (xcd - r) * q) + off; }
        const int nig = WGM * nN, gid = wgid / nig, fm = gid * WGM, gsz = (nM - fm) < WGM ? (nM - fm) : WGM;
        u.pm = fm + ((wgid % nig) % gsz); u.pn = (wgid % nig) / gsz; return true;
    }
    __device__ __forceinline__ void a_ready(const Unit&) const {}
    __device__ __forceinline__ void done(const Unit&) const {}
};

__device__ __forceinline__ unsigned cvt_pk_bf16(float lo, float hi) { unsigned r; asm volatile("v_cvt_pk_bf16_f32 %0, %1, %2" : "=v"(r) : "v"(lo), "v"(hi)); return r; }
typedef float f32x2 __attribute__((ext_vector_type(2)));
__device__ __forceinline__ f32x2 gelu_pk(f32x2 v) {
    const f32x2 av = __builtin_elementwise_abs(v), d = av * 0.2316418882f + 1.0f;
    f32x2 t; t.x = __builtin_amdgcn_rcpf(d.x); t.y = __builtin_amdgcn_rcpf(d.y);
    f32x2 q = t * 0.5307027145f + (-0.7265760135f); q = q * t + 0.7107068705f; q = q * t + (-0.142248368f); q = q * t + 0.127414796f; q = q * t;
    const f32x2 s = (v * v) * (-0.72134752044f);
    f32x2 e; e.x = __builtin_amdgcn_exp2f(s.x); e.y = __builtin_amdgcn_exp2f(s.y);
    const f32x2 m = v * (q * e), r = v - m;
    f32x2 o; o.x = v.x < 0.f ? m.x : r.x; o.y = v.y < 0.f ? m.y : r.y; return o;
}

template <int ACT  > struct EpiBf16 {
    static constexpr bool PERM = true, AFTER_DRAIN = false; static_assert(ACT == 0 || ACT == 1, "EpiBf16: ACT is 0 (none) or 1 (gelu_pk)");
    bf16_t* O; int ldc; const float* bias; int split_cols; size_t split_stride; float scale0;
    __device__ __forceinline__ void operator()(const f32x4 (&acc)[2][2][4][2], const Unit& u, int wr, int wc, int fr, int fq) const {
        const int row0 = u.pm * BM + wr * 64 + fr; int colt = u.pn * BM; bf16_t* base = O;
        float sc = 1.f; if (split_cols) { const int t = colt / split_cols; base += (size_t)t * split_stride; colt -= t * split_cols; if (t == 0) sc = scale0; }
        const int col0 = colt + wc * 32 + 8 * fq, bcol0 = u.pn * BM + wc * 32 + 8 * fq;
        f32x4 bv[2][2];
#pragma unroll
        for (int bj = 0; bj < 2; ++bj)
#pragma unroll
            for (int n = 0; n < 2; ++n) bv[bj][n] = bias ? *(const f32x4*)(bias + bcol0 + bj * HALF + 4 * n) : (f32x4){0.f, 0.f, 0.f, 0.f};
#pragma unroll
        for (int ai = 0; ai < 2; ++ai)
#pragma unroll
            for (int m = 0; m < 4; ++m) { bf16_t* rowp = base + (size_t)(row0 + ai * HALF + m * 16) * ldc + col0;
#pragma unroll
                for (int bj = 0; bj < 2; ++bj) { f32x4 v0 = acc[ai][bj][m][0] + bv[bj][0], v1 = acc[ai][bj][m][1] + bv[bj][1];
                    if (ACT == 1) { f32x2 a = gelu_pk((f32x2){v0[0], v0[1]}), b = gelu_pk((f32x2){v0[2], v0[3]}), c = gelu_pk((f32x2){v1[0], v1[1]}), d = gelu_pk((f32x2){v1[2], v1[3]});
                        v0 = (f32x4){a.x, a.y, b.x, b.y}; v1 = (f32x4){c.x, c.y, d.x, d.y}; }
                    v0 = v0 * sc; v1 = v1 * sc; u32x4 w; w.x = cvt_pk_bf16(v0[0], v0[1]); w.y = cvt_pk_bf16(v0[2], v0[3]); w.z = cvt_pk_bf16(v1[0], v1[1]); w.w = cvt_pk_bf16(v1[2], v1[3]);
                    *(u32x4*)(rowp + bj * HALF) = w; } }
    }
};

struct PanelStats {
    unsigned* xbuf;
    unsigned* cnt;
    unsigned* tmo;
    int ntn; float eps;
    unsigned code;
    __device__ __forceinline__ bool run(const f32x4 (&v)[2][2][4][2], const Unit& u, int wr, int wc, int fr, int fq, PG8_LAS unsigned char* lds, int wid, int lane) const {
        typedef float f32x2v __attribute__((ext_vector_type(2)));
        PG8_LAS f32x2v* P = (PG8_LAS f32x2v*)lds;
        PG8_LAS f32x2v* S = (PG8_LAS f32x2v*)(lds + 8192);
        PG8_LAS unsigned* flag = (PG8_LAS unsigned*)(lds + 8192 + 2048);
#pragma unroll
        for (int ai = 0; ai < 2; ++ai)
#pragma unroll
            for (int m = 0; m < 4; ++m) {
                float s = 0.f;
#pragma unroll
                for (int bj = 0; bj < 2; ++bj)
#pragma unroll
                    for (int n = 0; n < 2; ++n) { const f32x4 x = v[ai][bj][m][n]; s += (x[0] + x[1]) + (x[2] + x[3]); }
                s += __shfl_xor(s, 16); s += __shfl_xor(s, 32);
                const float mw = s * (1.0f / 64.0f); float q = 0.f;
#pragma unroll
                for (int bj = 0; bj < 2; ++bj)
#pragma unroll
                    for (int n = 0; n < 2; ++n) { const f32x4 d = v[ai][bj][m][n] - mw; q += (d[0] * d[0] + d[1] * d[1]) + (d[2] * d[2] + d[3] * d[3]); }
                q += __shfl_xor(q, 16); q += __shfl_xor(q, 32);
                if (fq == 0) P[(ai * HALF + wr * 64 + m * 16 + fr) * 4 + wc] = (f32x2v){mw, q};
            }
        asm volatile("s_waitcnt lgkmcnt(0)" ::: "memory"); __builtin_amdgcn_s_barrier(); asm volatile("" ::: "memory");
#if defined(BROKEN_EXCHANGE_NO_WAIT)
#warning BROKEN CONTROL BUILD: the row-statistics exchange does not wait; results are wrong by design
        if (blockIdx.x >= 64) { const long long t0_ = clock64(); while (clock64() - t0_ < 60000) __builtin_amdgcn_s_sleep(8); }
#endif
        const int row = wid * 32 + (lane & 31);
        if (lane < 32) {
            const f32x2v a = P[row * 4 + 0], b = P[row * 4 + 1], c = P[row * 4 + 2], d = P[row * 4 + 3];
            const float mt = (a.x + b.x + c.x + d.x) * 0.25f;
            const float da = a.x - mt, db = b.x - mt, dc = c.x - mt, dd = d.x - mt;
            const float m2 = (a.y + b.y) + (c.y + d.y) + 64.0f * ((da * da + db * db) + (dc * dc + dd * dd));
            unsigned long long* slot = (unsigned long long*)xbuf + ((size_t)(u.pm * BM + row) * 4 + u.pn);
            __hip_atomic_store(slot, ((unsigned long long)__float_as_uint(m2) << 32) | __float_as_uint(mt), __ATOMIC_RELAXED, __HIP_MEMORY_SCOPE_AGENT);
        }
        asm volatile("s_waitcnt vmcnt(0)" ::: "memory");
        if (lane == 0) __hip_atomic_fetch_add(cnt + 64 * u.pm, 1u, __ATOMIC_RELAXED, __HIP_MEMORY_SCOPE_AGENT);
        if (wid == 0) {
            bool dead = false; const unsigned long long t0 = __builtin_amdgcn_s_memrealtime(); const unsigned want = 8u * (unsigned)ntn;
            for (;;) {
#if defined(BROKEN_EXCHANGE_NO_WAIT)
                break;
#endif
                if ((unsigned)__builtin_amdgcn_readfirstlane(__hip_atomic_load(cnt + 64 * u.pm, __ATOMIC_RELAXED, __HIP_MEMORY_SCOPE_AGENT)) >= want) break;
                if (__builtin_amdgcn_s_memrealtime() - t0 > 2000000ull) {
                    if (lane == 0) { unsigned expect = 0u; __hip_atomic_compare_exchange_strong(tmo + 1, &expect, code | (unsigned)(u.pm & 0xff), __ATOMIC_RELAXED, __ATOMIC_RELAXED, __HIP_MEMORY_SCOPE_AGENT);
                                     __hip_atomic_store(tmo, 1u, __ATOMIC_RELAXED, __HIP_MEMORY_SCOPE_AGENT); }
                    dead = true; break; }
                __builtin_amdgcn_s_sleep(2);
            }
            __builtin_amdgcn_fence(__ATOMIC_ACQUIRE, "agent");
            if (lane == 0) flag[0] = dead ? 1u : 0u;
        }
        asm volatile("s_waitcnt vmcnt(0) lgkmcnt(0)" ::: "memory"); __builtin_amdgcn_s_barrier(); asm volatile("" ::: "memory");
        const bool bad = flag[0] != 0u;
        if (lane < 32) {
            const unsigned long long* slot = (const unsigned long long*)xbuf + (size_t)(u.pm * BM + row) * 4; float mt[4], m2[4]; float ms = 0.f;
#pragma unroll
            for (int t = 0; t < 4; ++t) { if (t < ntn) { const unsigned long long w = __hip_atomic_load(slot + t, __ATOMIC_RELAXED, __HIP_MEMORY_SCOPE_AGENT); mt[t] = __uint_as_float((unsigned)w); m2[t] = __uint_as_float((unsigned)(w >> 32)); } else { mt[t] = 0.f; m2[t] = 0.f; } ms += mt[t]; }
            const float mean = ms / (float)ntn; float q = 0.f;
#pragma unroll
            for (int t = 0; t < 4; ++t) if (t < ntn) { const float dm = mt[t] - mean; q += m2[t] + 256.0f * dm * dm; }
            S[row] = (f32x2v){mean, 1.0f / sqrtf(q / (256.0f * (float)ntn) + eps)};
        }
        asm volatile("s_waitcnt lgkmcnt(0)" ::: "memory"); __builtin_amdgcn_s_barrier(); asm volatile("" ::: "memory");
        return bad;
    }
};
struct EpiLnRes {
    static constexpr bool PERM = false, AFTER_DRAIN = true;
    const float* base; float* out; int ldc; const float* bias; PanelStats st; unsigned poison;
    __device__ __forceinline__ void fused(f32x4 (&acc)[2][2][4][2], const Unit& u, int wr, int wc, int fr, int fq, PG8_LAS unsigned char* lds, int wid, int lane) const {
        typedef float f32x2v __attribute__((ext_vector_type(2)));
        const PG8_LAS f32x2v* S = (const PG8_LAS f32x2v*)(lds + 8192);
        const int col0 = u.pn * BM + wc * 32 + 4 * fq;
#pragma unroll
        for (int bj = 0; bj < 2; ++bj)
#pragma unroll
            for (int n = 0; n < 2; ++n) { const f32x4 bv = bias ? *(const f32x4*)(bias + col0 + bj * HALF + n * 16) : (f32x4){0.f, 0.f, 0.f, 0.f};
#pragma unroll
                for (int ai = 0; ai < 2; ++ai)
#pragma unroll
                    for (int m = 0; m < 4; ++m) acc[ai][bj][m][n] += bv; }
        f32x4 pre[4][2][2];
#pragma unroll
        for (int m = 0; m < 4; ++m) { const size_t off = (size_t)(u.pm * BM + wr * 64 + m * 16 + fr) * ldc + col0;
#pragma unroll
            for (int bj = 0; bj < 2; ++bj)
#pragma unroll
                for (int n = 0; n < 2; ++n) pre[m][bj][n] = *(const f32x4*)(base + off + bj * HALF + n * 16); }
        const bool bad = st.run(acc, u, wr, wc, fr, fq, lds, wid, lane) || poison != 0u;
        const float qnan = __builtin_nanf("");
#pragma unroll
        for (int ai = 0; ai < 2; ++ai)
#pragma unroll
            for (int m = 0; m < 4; ++m) { const int r = ai * HALF + wr * 64 + m * 16 + fr; const f32x2v sr = S[r]; const size_t off = (size_t)(u.pm * BM + r) * ldc + col0;
#pragma unroll
                for (int bj = 0; bj < 2; ++bj)
#pragma unroll
                    for (int n = 0; n < 2; ++n) { const f32x4 bs = ai == 0 ? pre[m][bj][n] : *(const f32x4*)(base + off + bj * HALF + n * 16); f32x4 o = bs + (acc[ai][bj][m][n] - sr.x) * sr.y;
                        if (bad) o = (f32x4){qnan, qnan, qnan, qnan}; *(f32x4*)(out + off + bj * HALF + n * 16) = o; }
                if (m & 1) asm volatile("" ::: "memory"); }
    }
};
struct EpiLnResLn {
    static constexpr bool PERM = false, AFTER_DRAIN = true;
    const float* base; float* out; bf16_t* xn; int ldc; const float* bias; PanelStats st1, st2; unsigned poison;
    __device__ __forceinline__ void fused(f32x4 (&acc)[2][2][4][2], const Unit& u, int wr, int wc, int fr, int fq, PG8_LAS unsigned char* lds, int wid, int lane) const {
        typedef float f32x2v __attribute__((ext_vector_type(2))); typedef unsigned u32x2v __attribute__((ext_vector_type(2)));
        const PG8_LAS f32x2v* S = (const PG8_LAS f32x2v*)(lds + 8192);
        const int col0 = u.pn * BM + wc * 32 + 4 * fq;
#pragma unroll
        for (int bj = 0; bj < 2; ++bj)
#pragma unroll
            for (int n = 0; n < 2; ++n) { const f32x4 bv = bias ? *(const f32x4*)(bias + col0 + bj * HALF + n * 16) : (f32x4){0.f, 0.f, 0.f, 0.f};
#pragma unroll
                for (int ai = 0; ai < 2; ++ai)
#pragma unroll
                    for (int m = 0; m < 4; ++m) acc[ai][bj][m][n] += bv; }
        bool bad = st1.run(acc, u, wr, wc, fr, fq, lds, wid, lane) || poison != 0u;
        const float qnan = __builtin_nanf("");
#pragma unroll
        for (int ai = 0; ai < 2; ++ai)
#pragma unroll
            for (int m = 0; m < 4; ++m) { const int r = ai * HALF + wr * 64 + m * 16 + fr; const f32x2v sr = S[r]; const size_t off = (size_t)(u.pm * BM + r) * ldc + col0;
#pragma unroll
                for (int bj = 0; bj < 2; ++bj)
#pragma unroll
                    for (int n = 0; n < 2; ++n) { const f32x4 bs = *(const f32x4*)(base + off + bj * HALF + n * 16); acc[ai][bj][m][n] = bs + (acc[ai][bj][m][n] - sr.x) * sr.y; }
                asm volatile("" : "+v"(acc[ai][0][m][0]), "+v"(acc[ai][0][m][1]), "+v"(acc[ai][1][m][0]), "+v"(acc[ai][1][m][1]));
                if (m & 1) asm volatile("" ::: "memory"); }
        const bool bad1 = bad;
        bad = st2.run(acc, u, wr, wc, fr, fq, lds, wid, lane) || bad;
#pragma unroll
        for (int ai = 0; ai < 2; ++ai)
#pragma unroll
            for (int m = 0; m < 4; ++m) { const int r = ai * HALF + wr * 64 + m * 16 + fr; const f32x2v sr = S[r]; const size_t off = (size_t)(u.pm * BM + r) * ldc + col0;
#pragma unroll
                for (int bj = 0; bj < 2; ++bj)
#pragma unroll
                    for (int n = 0; n < 2; ++n) { const f32x4 x1 = acc[ai][bj][m][n]; *(f32x4*)(out + off + bj * HALF + n * 16) = bad1 ? (f32x4){qnan, qnan, qnan, qnan} : x1;
                        const f32x4 o = (x1 - sr.x) * sr.y; u32x2v w; w.x = cvt_pk_bf16(o[0], o[1]); w.y = cvt_pk_bf16(o[2], o[3]);
                        if (bad) { w.x = 0x7fc07fc0u; w.y = 0x7fc07fc0u; } *(u32x2v*)(xn + off + bj * HALF + n * 16) = w; }
                asm volatile("" ::: "memory"); }
    }
};

template <class Epi, class Sched, bool ALIGN_EPI = false, bool SP2 = false>
__device__ __forceinline__ void gemm_phase(PG8_LAS unsigned char* lds, const Gemm g, const Sched& S, const Epi& E, const int wave_in  ) {
    int tid_o; asm volatile("v_mbcnt_lo_u32_b32 %0, -1, 0\n\tv_mbcnt_hi_u32_b32 %0, -1, %0" : "=v"(tid_o)); tid_o += wave_in * 64; asm volatile("" : "+v"(tid_o));
    const int tid = tid_o, wid = __builtin_amdgcn_readfirstlane(tid >> 6), lane = tid & 63, wr = wid >> 2, wc = wid & 3, fr = lane & 15, fq = lane >> 4;
    const int K = g.K, nt = K / BK, lda = g.lda ? g.lda : K;
    unsigned voffA[2], voffB[2];
#pragma unroll
    for (int i = 0; i < 2; ++i) { int R, C; stage_rc(tid * 16 + i * 8192, R, C); const int Rb = Epi::PERM ? ((R & ~31) + perm32(R & 31)) : R;
        voffA[i] = (unsigned)(R * lda + C) * 2u; voffB[i] = (unsigned)(Rb * K + C) * 2u; }
    const size_t kstep = (size_t)(BK * 2);
    const size_t hstep = (size_t)HALF * K * 2;
    const size_t hstepA = (size_t)HALF * lda * 2, tstepA = 2 * hstepA;
    const size_t tstep = 2 * hstep;
    const unsigned ldsw = (unsigned)wid * 1024u;
    const int aoff = lds_byte(wr * 64 + fr, fq * 8), boff = lds_byte(wc * 32 + fr, fq * 8);
#define PG8_SA(b, h) (((b) * 2 + (h)) * HTB)
#define PG8_SB(b, h) ((4 + (b) * 2 + (h)) * HTB)
#define PG8_STAGE(bufoff, gbase, voff) do { _Pragma("unroll") for (int _i = 0; _i < 2; ++_i) { const unsigned la_ = (unsigned)(size_t)(lds + (bufoff) + ldsw + _i * 8192); \
        asm volatile("s_mov_b32 m0, %2\n\ts_nop 0\n\tglobal_load_lds_dwordx4 %0, %1" :: "v"((voff)[_i]), "s"((const char*)(gbase)), "s"(la_) : "memory", "m0"); } } while (0)
#define PG8_LDA(dst, b, h) do { _Pragma("unroll") for (int m = 0; m < 4; ++m) _Pragma("unroll") for (int k = 0; k < 2; ++k) dst[m][k] = *(const PG8_LAS bf16x8*)(lds + PG8_SA(b, h) + aoff + m * 2048 + k * 1024); } while (0)
#define PG8_LDB(dst, b, h) do { _Pragma("unroll") for (int n = 0; n < 2; ++n) _Pragma("unroll") for (int k = 0; k < 2; ++k) dst[n][k] = *(const PG8_LAS bf16x8*)(lds + PG8_SB(b, h) + boff + n * 2048 + k * 1024); } while (0)
#define PG8_MMA(ai, bj, At, Bt) do { __builtin_amdgcn_s_setprio(1); _Pragma("unroll") for (int m = 0; m < 4; ++m) _Pragma("unroll") for (int n = 0; n < 2; ++n) _Pragma("unroll") for (int k = 0; k < 2; ++k) \
        acc[ai][bj][m][n] = __builtin_amdgcn_mfma_f32_16x16x32_bf16(Bt[n][k], At[m][k], acc[ai][bj][m][n], 0, 0, 0); __builtin_amdgcn_s_setprio(0); } while (0)
#define PG8_WAIT_V(n) asm volatile("s_waitcnt vmcnt(" #n ")" ::: "memory")
#define PG8_WAIT_REL(st) asm volatile("s_waitcnt vmcnt(%1)\n\ts_cmp_eq_u32 %0, 0\n\ts_cbranch_scc1 .Lpg8rel%=\n\ts_waitcnt vmcnt(8)\n.Lpg8rel%=:" :: "s"(st), "n"(8 + Epi::EPI_VMEM) : "memory", "scc")
#define PG8_WAIT_L(n) asm volatile("s_waitcnt lgkmcnt(" #n ")" ::: "memory")
#define PG8_BAR __builtin_amdgcn_s_barrier()
#define PG8_SCHED __builtin_amdgcn_sched_barrier(0)
    Unit cur, nxt; int ui = 0;
    if (!S.next(0, cur)) return;
    f32x4 acc[2][2][4][2];
#pragma unroll
    for (int a = 0; a < 2; ++a)
#pragma unroll
        for (int b = 0; b < 2; ++b)
#pragma unroll
            for (int m = 0; m < 4; ++m)
#pragma unroll
                for (int n = 0; n < 2; ++n) acc[a][b][m][n] = (f32x4){0.f, 0.f, 0.f, 0.f};
    bf16x8 At[4][2], B0[2][2], B1[2][2];
    const char* cA = (const char*)g.A + (size_t)cur.pm * tstepA; const char* cB = (const char*)g.Bt + (size_t)cur.pn * tstep;
    S.a_ready(cur);
    if constexpr (SP2) {
        PG8_STAGE(PG8_SB(0, 0), cB, voffB); PG8_STAGE(PG8_SB(0, 1), cB + hstep, voffB); PG8_STAGE(PG8_SA(0, 0), cA, voffA); PG8_STAGE(PG8_SA(0, 1), cA + hstepA, voffA);
        if (wr == 1) PG8_BAR;
        PG8_WAIT_V(2); PG8_BAR;
        PG8_STAGE(PG8_SB(1, 0), cB + kstep, voffB); PG8_STAGE(PG8_SA(1, 0), cA + kstep, voffA); PG8_STAGE(PG8_SB(1, 1), cB + hstep + kstep, voffB);
        PG8_WAIT_V(6); PG8_BAR;
    } else {
        PG8_STAGE(PG8_SB(0, 0), cB, voffB); PG8_STAGE(PG8_SA(0, 0), cA, voffA); PG8_STAGE(PG8_SB(0, 1), cB + hstep, voffB); PG8_STAGE(PG8_SA(0, 1), cA + hstepA, voffA);
        if (wr == 1) PG8_BAR;
        PG8_WAIT_V(4); PG8_BAR;
        PG8_STAGE(PG8_SB(1, 0), cB + kstep, voffB); PG8_STAGE(PG8_SA(1, 0), cA + kstep, voffA); PG8_STAGE(PG8_SB(1, 1), cB + hstep + kstep, voffB);
        PG8_WAIT_V(6); PG8_BAR;
    }
    for (;;) {
        const bool has_next = S.next(ui + 1, nxt);
        const char* nA = has_next ? (const char*)g.A + (size_t)nxt.pm * tstepA : cA; const char* nB = has_next ? (const char*)g.Bt + (size_t)nxt.pn * tstep : cB;
        for (int t = 0; t < nt; t += 2) {
            const bool last = (t == nt - 2);
            const char* a1 = cA + (size_t)(t + 1) * kstep;
            const char* a2 = last ? nA : cA + (size_t)(t + 2) * kstep; const char* b2 = last ? nB : cB + (size_t)(t + 2) * kstep;
            const char* a3 = a2 + kstep; const char* b3 = b2 + kstep;
            if (last && has_next) S.a_ready(nxt);
            const int strict = __builtin_amdgcn_readfirstlane(t | (ui == 0 ? 1 : 0));
            if constexpr (SP2) {
            PG8_LDB(B0, 0, 0); PG8_LDB(B1, 0, 1); PG8_SCHED; PG8_LDA(At, 0, 0); PG8_STAGE(PG8_SA(1, 1), a1 + hstepA, voffA);
            PG8_WAIT_REL(strict); PG8_WAIT_L(0); PG8_BAR; PG8_MMA(0, 0, At, B0); PG8_MMA(0, 1, At, B1); PG8_BAR; PG8_SCHED;
            PG8_LDA(At, 0, 1); PG8_STAGE(PG8_SB(0, 0), b2, voffB); PG8_STAGE(PG8_SB(0, 1), b2 + hstep, voffB); PG8_STAGE(PG8_SA(0, 0), a2, voffA);
            PG8_WAIT_REL(strict); PG8_WAIT_L(0); PG8_BAR; PG8_MMA(1, 0, At, B0); PG8_MMA(1, 1, At, B1); PG8_BAR; PG8_SCHED;
            PG8_LDB(B0, 1, 0); PG8_LDB(B1, 1, 1); PG8_SCHED; PG8_LDA(At, 1, 0); PG8_STAGE(PG8_SA(0, 1), a2 + hstepA, voffA);
            PG8_WAIT_V(8); PG8_WAIT_L(0); PG8_BAR; PG8_MMA(0, 0, At, B0); PG8_MMA(0, 1, At, B1); PG8_BAR; PG8_SCHED;
            PG8_LDA(At, 1, 1); PG8_STAGE(PG8_SB(1, 0), b3, voffB); PG8_STAGE(PG8_SB(1, 1), b3 + hstep, voffB); PG8_STAGE(PG8_SA(1, 0), a3, voffA);
            PG8_WAIT_V(8); PG8_WAIT_L(0); PG8_BAR; PG8_MMA(1, 0, At, B0); PG8_MMA(1, 1, At, B1); PG8_BAR; PG8_SCHED;
            if constexpr (Epi::MID_KT > 0) { if (t + 2 == Epi::MID_KT) { E.mid(acc, cur, wr, wc, fr, fq); PG8_SCHED; } }
            } else {
            PG8_LDB(B0, 0, 0); PG8_SCHED; PG8_LDA(At, 0, 0); PG8_STAGE(PG8_SA(1, 1), a1 + hstepA, voffA);
            PG8_WAIT_L(8); PG8_BAR; PG8_WAIT_L(0); PG8_MMA(0, 0, At, B0); PG8_BAR; PG8_SCHED;
            PG8_LDB(B1, 0, 1); PG8_STAGE(PG8_SB(0, 0), b2, voffB);
            PG8_BAR; PG8_WAIT_L(0); PG8_MMA(0, 1, At, B1); PG8_BAR;
            PG8_LDA(At, 0, 1); PG8_STAGE(PG8_SA(0, 0), a2, voffA);
            PG8_BAR; PG8_WAIT_L(0); PG8_MMA(1, 0, At, B0); PG8_BAR; PG8_SCHED;
            PG8_STAGE(PG8_SB(0, 1), b2 + hstep, voffB);
            PG8_WAIT_V(6); PG8_BAR; PG8_MMA(1, 1, At, B1); PG8_BAR;
            PG8_LDB(B0, 1, 0); PG8_SCHED; PG8_LDA(At, 1, 0); PG8_STAGE(PG8_SA(0, 1), a2 + hstepA, voffA);
            PG8_WAIT_L(8); PG8_BAR; PG8_WAIT_L(0); PG8_MMA(0, 0, At, B0); PG8_BAR; PG8_SCHED;
            PG8_LDB(B1, 1, 1); PG8_STAGE(PG8_SB(1, 0), b3, voffB);
            PG8_BAR; PG8_WAIT_L(0); PG8_MMA(0, 1, At, B1); PG8_BAR;
            PG8_LDA(At, 1, 1); PG8_STAGE(PG8_SA(1, 0), a3, voffA);
            PG8_BAR; PG8_WAIT_L(0); PG8_MMA(1, 0, At, B0); PG8_BAR; PG8_SCHED;
            PG8_STAGE(PG8_SB(1, 1), b3 + hstep, voffB);
            PG8_WAIT_V(6); PG8_BAR; PG8_MMA(1, 1, At, B1); PG8_BAR;
            }
        }
        if constexpr (ALIGN_EPI) { if (wr == 0) PG8_BAR; }
        if constexpr (!Epi::AFTER_DRAIN) { E(acc, cur, wr, wc, fr, fq); S.done(cur); }
        if (!has_next) break;
#pragma unroll
        for (int a = 0; a < 2; ++a)
#pragma unroll
            for (int b = 0; b < 2; ++b)
#pragma unroll
                for (int m = 0; m < 4; ++m)
#pragma unroll
                    for (int n = 0; n < 2; ++n) acc[a][b][m][n] = (f32x4){0.f, 0.f, 0.f, 0.f};
        cur = nxt; cA = nA; cB = nB; ++ui;
        if constexpr (ALIGN_EPI) { if (wr == 1) PG8_BAR; }
    }
    PG8_WAIT_V(0);
    if constexpr (!ALIGN_EPI) { if (wr == 0) PG8_BAR; }
    PG8_BAR;
    if constexpr (Epi::AFTER_DRAIN) { E.fused(acc, cur, wr, wc, fr, fq, lds, wid, lane); S.done(cur); }
#undef PG8_SA
#undef PG8_SB
#undef PG8_STAGE
#undef PG8_LDA
#undef PG8_LDB
#undef PG8_MMA
#undef PG8_WAIT_V
#undef PG8_WAIT_REL
#undef PG8_WAIT_L
#undef PG8_BAR
#undef PG8_SCHED
}
}
#define GAS __attribute__((address_space(1)))
#define LAS __attribute__((address_space(3)))
typedef unsigned short bf16;
typedef unsigned v4u __attribute__((ext_vector_type(4)));
typedef float f32x4 __attribute__((ext_vector_type(4)));
typedef short bf16x8 __attribute__((ext_vector_type(8)));
typedef GAS unsigned gu32;
typedef GAS unsigned long long gu64;
#define RLX_AGENT __ATOMIC_RELAXED, __HIP_MEMORY_SCOPE_AGENT
#define LDS_WAIT() asm volatile("s_waitcnt lgkmcnt(0)" ::: "memory")
#define VM_WAIT() asm volatile("s_waitcnt vmcnt(0)" ::: "memory")
__device__ __forceinline__ unsigned long long rt() { return __builtin_amdgcn_s_memrealtime(); }
__device__ __forceinline__ unsigned f2bf(float f) { unsigned u = __builtin_bit_cast(unsigned, f); return (u + 0x7fffu + ((u >> 16) & 1u)) >> 16; }
__device__ __forceinline__ unsigned pk2(float lo, float hi) { return f2bf(lo) | (f2bf(hi) << 16); }

#define XB_TMO      128
#define XB_XCNT(j)  (256  + 64 * (j))
#define XB_XSUB(j)  (1280 + 64 * (j))
#define XB_XGEN(j)  (2304 + 64 * (j))
#define XB_TOP      3328
#define XB_TOPGEN   3392
#define XCD_BAR_WORDS 3456
#define XB_SPIN_CAP (1u << 18)

__device__ __forceinline__ unsigned xb_ld(unsigned* p)              { return __hip_atomic_load(p, __ATOMIC_RELAXED, __HIP_MEMORY_SCOPE_AGENT); }
__device__ __forceinline__ unsigned xb_add(unsigned* p, unsigned v) { return __hip_atomic_fetch_add(p, v, __ATOMIC_RELAXED, __HIP_MEMORY_SCOPE_AGENT); }
__device__ __forceinline__ unsigned xb_xcc_id() { return (unsigned)__builtin_amdgcn_s_getreg((3 << 11) | 20) & 0xFu; }
#define XB_SPIN(cond, bar) do { unsigned _sp = 0; while (cond) { __builtin_amdgcn_s_sleep(1); \
    if ((++_sp & 255u) == 0u) { if (xb_ld(&(bar)[XB_TMO])) break; if (_sp > XB_SPIN_CAP) { atomicAdd(&(bar)[XB_TMO], 1u); break; } } } } while (0)

struct XcdBarrier {
    unsigned* bar; unsigned x;
    volatile LAS unsigned* st;
};

__device__ __forceinline__ XcdBarrier xcd_barrier_post(unsigned* bar, volatile LAS unsigned* st) {
    XcdBarrier b; b.bar = bar; b.x = xb_xcc_id(); b.st = st;
    if (threadIdx.x == 0) (void)xb_add(&bar[XB_XCNT(b.x)], 1u);
    return b;
}
__device__ __forceinline__ void xcd_barrier_complete(unsigned* bar, unsigned x, unsigned& nloc, unsigned& nx) {
    const unsigned G = gridDim.x * gridDim.y * gridDim.z;
    unsigned sum, cnt, mine, sp = 0u;
    for (;;) {
        sum = 0u; cnt = 0u; mine = 0u;
#pragma unroll
        for (unsigned j = 0; j < 16; ++j) { const unsigned c = xb_ld(&bar[XB_XCNT(j)]); sum += c; cnt += (c > 0u) ? 1u : 0u; mine = (j == x) ? c : mine; }
        if (sum == G) break;
        __builtin_amdgcn_s_sleep(1);
        if ((++sp & 255u) == 0u) { if (xb_ld(&bar[XB_TMO])) break; if (sp > XB_SPIN_CAP) { atomicAdd(&bar[XB_TMO], 1u); break; } }
    }
    nloc = mine > 0u ? mine : 1u; nx = cnt > 0u ? cnt : 1u;
}

__device__ __forceinline__ void xcd_barrier(const XcdBarrier& b, const bool thread0  ) {
    asm volatile("s_waitcnt vmcnt(0)" ::: "memory");
    __syncthreads();
    if (thread0) {
        unsigned* bar = b.bar;
        __builtin_amdgcn_s_waitcnt(0);
        unsigned nloc = b.st[0], nx = b.st[1];
        if (nloc == 0u) { xcd_barrier_complete(bar, b.x, nloc, nx); b.st[0] = nloc; b.st[1] = nx; }
        const unsigned old = xb_add(&bar[XB_XSUB(b.x)], 1u);
        const unsigned gen = old / nloc;
        if (old + 1u == (gen + 1u) * nloc) {
            __builtin_amdgcn_fence(__ATOMIC_RELEASE, "agent");
            asm volatile("s_waitcnt vmcnt(0)" ::: "memory");
            const unsigned og = xb_add(&bar[XB_TOP], 1u);
            const unsigned tg = og / nx;
            if (og + 1u == (tg + 1u) * nx) xb_add(&bar[XB_TOPGEN], 1u);
            else XB_SPIN(xb_ld(&bar[XB_TOPGEN]) == tg, bar);
            __builtin_amdgcn_fence(__ATOMIC_ACQUIRE, "agent");
            xb_add(&bar[XB_XGEN(b.x)], 1u);
            asm volatile("s_waitcnt vmcnt(0)" ::: "memory");
        } else {
            XB_SPIN(xb_ld(&bar[XB_XGEN(b.x)]) == gen, bar);
            __builtin_amdgcn_fence(__ATOMIC_ACQUIRE, "agent");
            asm volatile("s_waitcnt vmcnt(0)" ::: "memory");
        }
    }
    __syncthreads();
}

__device__ __forceinline__ void xcd_local_barrier(const XcdBarrier& b, const bool thread0) {
    asm volatile("s_waitcnt vmcnt(0)" ::: "memory");
    __syncthreads();
    if (thread0) {
        unsigned* bar = b.bar;
        __builtin_amdgcn_s_waitcnt(0);
        unsigned nloc = b.st[0]; if (nloc == 0u) nloc = 1u;
        const unsigned old = xb_add(&bar[XB_XSUB(b.x)], 1u);
        const unsigned gen = old / nloc;
        if (old + 1u == (gen + 1u) * nloc) xb_add(&bar[XB_XGEN(b.x)], 1u);
        else XB_SPIN(xb_ld(&bar[XB_XGEN(b.x)]) == gen, bar);
        __builtin_amdgcn_fence(__ATOMIC_ACQUIRE, "agent");
        asm volatile("s_waitcnt vmcnt(0)" ::: "memory");
    }
    __syncthreads();
}

#ifndef PH_MASK
#define PH_MASK 0x3ff
#endif
#define PH(n) ((PH_MASK >> (n)) & 1)
__device__ __forceinline__ int lane_now() { int l; asm volatile("v_mbcnt_lo_u32_b32 %0, -1, 0\n\tv_mbcnt_hi_u32_b32 %0, -1, %0" : "=v"(l)); return l; }
#define TID_NOW() (wave * 64 + lane_now())
#define GRID_BAR() do { XcdBarrier b2_ = bar; asm volatile("" : "+s"(b2_.x)); xcd_barrier(b2_, TID_NOW() == 0); } while (0)
#define LOCAL_BAR() do { XcdBarrier b2_ = bar; asm volatile("" : "+s"(b2_.x)); const unsigned mb_ = __builtin_amdgcn_readfirstlane(__hip_atomic_load(ctl + CW_MAP, RLX_AGENT)); \
    if (mb_ == 0u) xcd_local_barrier(b2_, TID_NOW() == 0); else xcd_barrier(b2_, TID_NOW() == 0); } while (0)
#define PHASE_IDS() int tid__ = TID_NOW(); asm volatile("" : "+v"(tid__)); const int tid = tid__, lane = tid & 63; (void)tid; (void)lane
#ifndef PROBE_DUP
#define PROBE_DUP 0
#endif
#ifndef P0SUB
#define P0SUB 7
#endif
constexpr int NWAVES = 8;
constexpr int BATCH = 16, SEQ = 4096, DM = 1024, M = BATCH * SEQ;
constexpr int INW = 9744;
constexpr int C_GQ = 4608, C_GLR = 7680, C_GA = 7696;
constexpr int NA = 4608, NB = 5120, NGLA = 3072, NGATE = 2048, FFH = 2816, NFF = 5632, AOW = 512;
constexpr float EPS = 1e-6f;
constexpr float QSCALE = 0.08838834764831845f * 1.4426950408889634f;
constexpr float GLA_QS = 0.08838834764831845f;

constexpr size_t MiB = 1u << 20;
constexpr size_t WS_CTL = 0, CTL_ZERO_BYTES = 1 * MiB;
constexpr int CW_TMO = 0, CW_MAP = 64, CW_BAR = 4096;
constexpr size_t WS_SSQ1 = 256 * 1024, WS_SSQ2 = 512 * 1024;
constexpr size_t WS_ROPE = 1 * MiB;
constexpr size_t WS_GLR = 2 * MiB;
constexpr size_t WS_WB = 6 * MiB, WS_WA = 16 * MiB, WS_WBA = 25 * MiB, WS_WBB = 26 * MiB, WS_WOUT = 28 * MiB, WS_WFF = 30 * MiB, WS_WDN = 41 * MiB;
constexpr size_t WS_H = 48 * MiB;
constexpr size_t WS_CAT = 176 * MiB;
constexpr size_t WS_BIG = 368 * MiB;
constexpr size_t WS_MIX = 368 * MiB, WS_X1B = 496 * MiB, WS_ACT = 624 * MiB;
constexpr size_t WS_OG01 = 48 * MiB, WS_OG2 = 944 * MiB, WS_ML = 1008 * MiB;
constexpr size_t WS_SLOC = 752 * MiB, WS_LOGD = 784 * MiB;
constexpr size_t WS_END = 1024 * MiB;
static_assert(WS_CAT + (size_t)M * 1536 * 2 <= WS_BIG && WS_BIG + (size_t)M * NA * 2 <= WS_OG2 && WS_ACT + (size_t)M * FFH * 2 <= WS_END && WS_BIG + (size_t)M * NGLA * 2 <= WS_SLOC, "ws map");

constexpr int RING_OFF = 0, RING_BYTES = 131072;
constexpr int LDSCTL_OFF = RING_BYTES, MISC_OFF = LDSCTL_OFF + 320;
constexpr int LDS_BYTES = 147456;

#define ST16_S(sbase, voff, data, IMM) asm volatile("global_store_dwordx4 %0, %1, %2 offset:" #IMM "\n\ts_nop 4" :: "v"(voff), "v"(data), "s"(sbase) : "memory")
__device__ __forceinline__ float bf2f(unsigned short b) { return __builtin_bit_cast(float, (unsigned)b << 16); }
__device__ __forceinline__ float bflo(unsigned w) { return __builtin_bit_cast(float, w << 16); }
__device__ __forceinline__ float bfhi(unsigned w) { return __builtin_bit_cast(float, w & 0xffff0000u); }
__device__ __forceinline__ float wave_sum(float v) {
#pragma unroll
    for (int o = 1; o < 64; o <<= 1) v += __shfl_xor(v, o);
    return v;
}
__device__ __forceinline__ float wave_max(float v) {
#pragma unroll
    for (int o = 1; o < 64; o <<= 1) v = fmaxf(v, __shfl_xor(v, o));
    return v;
}
#define WG_BAR() do { asm volatile("s_waitcnt lgkmcnt(0)" ::: "memory"); __builtin_amdgcn_s_barrier(); asm volatile("" ::: "memory"); } while (0)
__device__ __forceinline__ float sigmoidf_(float v) { return 1.0f / (1.0f + __expf(-v)); }

namespace pg8 {
struct EpiB {
    static constexpr bool PERM = true, AFTER_DRAIN = false; static constexpr int MID_KT = 0, EPI_VMEM = 16;
    bf16_t* __restrict__ G; bf16_t* __restrict__ GRp; bf16_t* __restrict__ GSp;
    __device__ __forceinline__ void operator()(const f32x4 (&acc)[2][2][4][2], const Unit& u, int wr, int wc, int fr, int fq) const {
        const int row0 = u.pm * BM + wr * 64 + fr; const int colt = u.pn * BM; constexpr float L2E = 1.4426950408889634f;
        if (colt >= 3072) {
            const int j0 = ((colt - 3072) >> 1) + wc * 32 + 8 * fq;
#pragma unroll
            for (int ai = 0; ai < 2; ++ai)
#pragma unroll
                for (int m = 0; m < 4; ++m) { const unsigned off = (unsigned)((row0 + ai * HALF + m * 16) * 1024 + j0) * 2u; float rv[8], sv[8];
#pragma unroll
                    for (int n = 0; n < 2; ++n)
#pragma unroll
                        for (int e = 0; e < 4; ++e) { const float ga = acc[ai][0][m][n][e], gb = fmaxf(acc[ai][1][m][n][e], -30.0f);
                            const float ea = __builtin_amdgcn_exp2f(-L2E * ga), eb = __builtin_amdgcn_exp2f(-L2E * gb);
                            sv[4 * n + e] = __builtin_amdgcn_rcpf(1.0f + eb); rv[4 * n + e] = (1.0f + eb) * __builtin_amdgcn_rcpf(1.0f + ea); }
                    u32x4 w; w.x = cvt_pk_bf16(rv[0], rv[1]); w.y = cvt_pk_bf16(rv[2], rv[3]); w.z = cvt_pk_bf16(rv[4], rv[5]); w.w = cvt_pk_bf16(rv[6], rv[7]); *(u32x4*)((char*)GRp + off) = w;
                    u32x4 w2; w2.x = cvt_pk_bf16(sv[0], sv[1]); w2.y = cvt_pk_bf16(sv[2], sv[3]); w2.z = cvt_pk_bf16(sv[4], sv[5]); w2.w = cvt_pk_bf16(sv[6], sv[7]); *(u32x4*)((char*)GSp + off) = w2; }
            return; }
        bf16_t* base = G + colt; const int col0 = wc * 32 + 8 * fq;
#pragma unroll
        for (int ai = 0; ai < 2; ++ai)
#pragma unroll
            for (int m = 0; m < 4; ++m) { const unsigned rowo = (unsigned)((row0 + ai * HALF + m * 16) * 3072 + col0) * 2u;
#pragma unroll
                for (int bj = 0; bj < 2; ++bj) { f32x4 v0 = acc[ai][bj][m][0], v1 = acc[ai][bj][m][1];
                    if (colt >= 2048) {
#pragma unroll
                        for (int e = 0; e < 4; ++e) { v0[e] = v0[e] * __builtin_amdgcn_rcpf(1.0f + __builtin_amdgcn_exp2f(-L2E * v0[e])); v1[e] = v1[e] * __builtin_amdgcn_rcpf(1.0f + __builtin_amdgcn_exp2f(-L2E * v1[e])); } }
                    else if (colt < 512) { v0 = v0 * GLA_QS; v1 = v1 * GLA_QS; }
                    u32x4 w; w.x = cvt_pk_bf16(v0[0], v0[1]); w.y = cvt_pk_bf16(v0[2], v0[3]); w.z = cvt_pk_bf16(v1[0], v1[1]); w.w = cvt_pk_bf16(v1[2], v1[3]);
                    *(u32x4*)((char*)base + (rowo + (unsigned)(bj * HALF * 2))) = w; } }
    }
};
struct EpiA {
    static constexpr bool PERM = true, AFTER_DRAIN = false; static constexpr int MID_KT = 0, EPI_VMEM = 16;
    bf16_t* __restrict__ O; const float* __restrict__ rope; float qsc;
    __device__ __forceinline__ void operator()(const f32x4 (&acc)[2][2][4][2], const Unit& u, int wr, int wc, int fr, int fq) const {
        const int row0 = u.pm * BM + wr * 64 + fr; const int colt = u.pn * BM;
        const int col0 = colt + wc * 32 + 8 * fq;
        const bool dorope = (colt < 3072) && (wc == 0);
        const float sc = (colt < 1536) ? qsc : 1.0f;
        f32x4 csv[2][4], snv[2][4];
        if (dorope) {
#pragma unroll
            for (int ai = 0; ai < 2; ++ai)
#pragma unroll
                for (int m = 0; m < 4; ++m) { const float* tp = rope + (size_t)((row0 + ai * HALF + m * 16) & (SEQ_MASK)) * 32 + 4 * fq; csv[ai][m] = *(const f32x4*)tp; snv[ai][m] = *(const f32x4*)(tp + 16); } }
#pragma unroll
        for (int ai = 0; ai < 2; ++ai)
#pragma unroll
            for (int m = 0; m < 4; ++m) { const int row = row0 + ai * HALF + m * 16; const unsigned rowo = (unsigned)(row * 4608 + col0) * 2u;
                f32x4 cs = {1.f, 1.f, 1.f, 1.f}, sn = {0.f, 0.f, 0.f, 0.f};
                if (dorope) { cs = csv[ai][m]; sn = snv[ai][m]; }
#pragma unroll
                for (int bj = 0; bj < 2; ++bj) { f32x4 v0 = acc[ai][bj][m][0], v1 = acc[ai][bj][m][1];
                    if (dorope) {
                        f32x4 a, b;
                        a[0] = v0[0] * cs[0] - v0[1] * sn[0]; a[1] = v0[1] * cs[0] + v0[0] * sn[0];
                        a[2] = v0[2] * cs[1] - v0[3] * sn[1]; a[3] = v0[3] * cs[1] + v0[2] * sn[1];
                        b[0] = v1[0] * cs[2] - v1[1] * sn[2]; b[1] = v1[1] * cs[2] + v1[0] * sn[2];
                        b[2] = v1[2] * cs[3] - v1[3] * sn[3]; b[3] = v1[3] * cs[3] + v1[2] * sn[3];
                        v0 = a; v1 = b; }
                    v0 = v0 * sc; v1 = v1 * sc;
                    u32x4 w; w.x = cvt_pk_bf16(v0[0], v0[1]); w.y = cvt_pk_bf16(v0[2], v0[3]); w.z = cvt_pk_bf16(v1[0], v1[1]); w.w = cvt_pk_bf16(v1[2], v1[3]);
                    *(u32x4*)((char*)O + (rowo + (unsigned)(bj * HALF * 2))) = w; } }
    }
    static constexpr int SEQ_MASK = 4095;
};
struct EpiMixF {
    static constexpr bool PERM = true, AFTER_DRAIN = false; static constexpr int MID_KT = 8, EPI_VMEM = 16;
    const bf16_t* __restrict__ GRp; const bf16_t* __restrict__ GSp; bf16_t* __restrict__ O;
    template <bool FINAL> __device__ __forceinline__ void run(f32x4 (&acc)[2][2][4][2], const Unit& u, int wr, int wc, int fr, int fq) const {
        const int row0 = u.pm * BM + wr * 64 + fr; const int col0 = u.pn * BM + wc * 32 + 8 * fq; const bf16_t* gp = FINAL ? GSp : GRp;
        constexpr int MB = FINAL ? 4 : 4;
#pragma unroll
        for (int ai = 0; ai < 2; ++ai)
#pragma unroll
        for (int mb = 0; mb < 4; mb += MB) {
            u32x4 gv[MB][2];
#pragma unroll
            for (int m = 0; m < MB; ++m)
#pragma unroll
                for (int bj = 0; bj < 2; ++bj) gv[m][bj] = __builtin_nontemporal_load((const u32x4*)((const char*)gp + (unsigned)((row0 + ai * HALF + (mb + m) * 16) * 1024 + col0 + bj * HALF) * 2u));
#pragma unroll
            for (int mm = 0; mm < MB; ++mm)
#pragma unroll
                for (int bj = 0; bj < 2; ++bj) { const int m = mb + mm; const u32x4 g = gv[mm][bj]; f32x4 v0 = acc[ai][bj][m][0], v1 = acc[ai][bj][m][1];
                    v0[0] *= __builtin_bit_cast(float, g.x << 16); v0[1] *= __builtin_bit_cast(float, g.x & 0xffff0000u);
                    v0[2] *= __builtin_bit_cast(float, g.y << 16); v0[3] *= __builtin_bit_cast(float, g.y & 0xffff0000u);
                    v1[0] *= __builtin_bit_cast(float, g.z << 16); v1[1] *= __builtin_bit_cast(float, g.z & 0xffff0000u);
                    v1[2] *= __builtin_bit_cast(float, g.w << 16); v1[3] *= __builtin_bit_cast(float, g.w & 0xffff0000u);
                    if (FINAL) { u32x4 w; w.x = cvt_pk_bf16(v0[0], v0[1]); w.y = cvt_pk_bf16(v0[2], v0[3]); w.z = cvt_pk_bf16(v1[0], v1[1]); w.w = cvt_pk_bf16(v1[2], v1[3]);
                        *(u32x4*)((char*)O + (unsigned)((row0 + ai * HALF + m * 16) * 1024 + col0 + bj * HALF) * 2u) = w; }
                    else { acc[ai][bj][m][0] = v0; acc[ai][bj][m][1] = v1; } } }
    }
    __device__ __forceinline__ void mid(f32x4 (&acc)[2][2][4][2], const Unit& u, int wr, int wc, int fr, int fq) const { int fr2 = fr, fq2 = fq; asm volatile("" : "+v"(fr2), "+v"(fq2));
        run<false>(acc, u, wr, wc, fr2, fq2); }
    __device__ __forceinline__ void operator()(const f32x4 (&acc)[2][2][4][2], const Unit& u, int wr, int wc, int fr, int fq) const { run<true>(const_cast<f32x4 (&)[2][2][4][2]>(acc), u, wr, wc, fr, fq); }
};
struct EpiX1 {
    static constexpr bool PERM = true, AFTER_DRAIN = false; static constexpr int MID_KT = 0, EPI_VMEM = 16;
    const float* __restrict__ base; bf16_t* __restrict__ ob; float* __restrict__ ssq;
    __device__ __forceinline__ void operator()(const f32x4 (&acc)[2][2][4][2], const Unit& u, int wr, int wc, int fr, int fq) const {
        const int row0 = u.pm * BM + wr * 64 + fr, col0 = u.pn * BM + wc * 32 + 8 * fq;
#pragma unroll
        for (int ai = 0; ai < 2; ++ai) {
            f32x4 bv[4][2][2];
#pragma unroll
            for (int m = 0; m < 4; ++m)
#pragma unroll
                for (int bj = 0; bj < 2; ++bj) { const unsigned off = (unsigned)((row0 + ai * HALF + m * 16) * 1024 + col0 + bj * HALF) * 4u; bv[m][bj][0] = __builtin_nontemporal_load((const f32x4*)((const char*)base + off)); bv[m][bj][1] = __builtin_nontemporal_load((const f32x4*)((const char*)base + (off + 16u))); }
#pragma unroll
            for (int m = 0; m < 4; ++m) { const int row = row0 + ai * HALF + m * 16; const unsigned off = (unsigned)(row * 4608 + col0) * 2u; float s = 0.f;
#pragma unroll
                for (int bj = 0; bj < 2; ++bj) { const f32x4 o0 = bv[m][bj][0] + acc[ai][bj][m][0], o1 = bv[m][bj][1] + acc[ai][bj][m][1];
                    s += (o0[0] * o0[0] + o0[1] * o0[1]) + (o0[2] * o0[2] + o0[3] * o0[3]) + (o1[0] * o1[0] + o1[1] * o1[1]) + (o1[2] * o1[2] + o1[3] * o1[3]);
                    u32x4 w; w.x = cvt_pk_bf16(o0[0], o0[1]); w.y = cvt_pk_bf16(o0[2], o0[3]); w.z = cvt_pk_bf16(o1[0], o1[1]); w.w = cvt_pk_bf16(o1[2], o1[3]);
                    *(u32x4*)((char*)ob + (off + (unsigned)(bj * HALF * 2))) = w; }
                s += __shfl_xor(s, 16); s += __shfl_xor(s, 32);
                if (fq == 0) __hip_atomic_fetch_add(ssq + row, s, __ATOMIC_RELAXED, __HIP_MEMORY_SCOPE_AGENT); } }
    }
};
struct EpiX2 {
    static constexpr bool PERM = true, AFTER_DRAIN = false; static constexpr int MID_KT = 0, EPI_VMEM = 16;
    const bf16_t* __restrict__ base; bf16_t* __restrict__ ob; float* __restrict__ ssq;
    __device__ __forceinline__ void operator()(const f32x4 (&acc)[2][2][4][2], const Unit& u, int wr, int wc, int fr, int fq) const {
        const int row0 = u.pm * BM + wr * 64 + fr, col0 = u.pn * BM + wc * 32 + 8 * fq;
#pragma unroll
        for (int ai = 0; ai < 2; ++ai) {
            u32x4 tv[4][2];
#pragma unroll
            for (int m = 0; m < 4; ++m)
#pragma unroll
                for (int bj = 0; bj < 2; ++bj) tv[m][bj] = __builtin_nontemporal_load((const u32x4*)((const char*)base + (unsigned)((row0 + ai * HALF + m * 16) * 4608 + col0 + bj * HALF) * 2u));
#pragma unroll
            for (int m = 0; m < 4; ++m) { const int row = row0 + ai * HALF + m * 16; const unsigned off = (unsigned)(row * 1024 + col0) * 2u; float s = 0.f;
#pragma unroll
                for (int bj = 0; bj < 2; ++bj) { const u32x4 t = tv[m][bj];
                    f32x4 o0 = acc[ai][bj][m][0], o1 = acc[ai][bj][m][1];
                    o0[0] += __builtin_bit_cast(float, t.x << 16); o0[1] += __builtin_bit_cast(float, t.x & 0xffff0000u); o0[2] += __builtin_bit_cast(float, t.y << 16); o0[3] += __builtin_bit_cast(float, t.y & 0xffff0000u);
                    o1[0] += __builtin_bit_cast(float, t.z << 16); o1[1] += __builtin_bit_cast(float, t.z & 0xffff0000u); o1[2] += __builtin_bit_cast(float, t.w << 16); o1[3] += __builtin_bit_cast(float, t.w & 0xffff0000u);
                    s += (o0[0] * o0[0] + o0[1] * o0[1]) + (o0[2] * o0[2] + o0[3] * o0[3]) + (o1[0] * o1[0] + o1[1] * o1[1]) + (o1[2] * o1[2] + o1[3] * o1[3]);
                    u32x4 w; w.x = cvt_pk_bf16(o0[0], o0[1]); w.y = cvt_pk_bf16(o0[2], o0[3]); w.z = cvt_pk_bf16(o1[0], o1[1]); w.w = cvt_pk_bf16(o1[2], o1[3]);
                    *(u32x4*)((char*)ob + (off + (unsigned)(bj * HALF * 2))) = w; }
                s += __shfl_xor(s, 16); s += __shfl_xor(s, 32);
                if (fq == 0) __hip_atomic_fetch_add(ssq + row, s, __ATOMIC_RELAXED, __HIP_MEMORY_SCOPE_AGENT); } }
    }
};
struct EpiSwi {
    static constexpr bool PERM = true, AFTER_DRAIN = false; static constexpr int MID_KT = 0, EPI_VMEM = 8;
    bf16_t* __restrict__ O; const float* __restrict__ ssq;
    __device__ __forceinline__ void operator()(const f32x4 (&acc)[2][2][4][2], const Unit& u, int wr, int wc, int fr, int fq) const {
        const int row0 = u.pm * BM + wr * 64 + fr; const int col0 = u.pn * HALF + wc * 32 + 8 * fq;
        float sv[2][4];
#pragma unroll
        for (int ai = 0; ai < 2; ++ai)
#pragma unroll
            for (int m = 0; m < 4; ++m) sv[ai][m] = ssq[row0 + ai * HALF + m * 16];
#pragma unroll
        for (int ai = 0; ai < 2; ++ai)
#pragma unroll
            for (int m = 0; m < 4; ++m) { const int row = row0 + ai * HALF + m * 16; const float r = __builtin_amdgcn_rsqf(sv[ai][m] * (1.0f / 1024.0f) + EPS);
                f32x4 o[2];
#pragma unroll
                for (int n = 0; n < 2; ++n)
#pragma unroll
                    for (int e = 0; e < 4; ++e) { const float g = acc[ai][0][m][n][e] * r, uu = acc[ai][1][m][n][e] * r; o[n][e] = g * __builtin_amdgcn_rcpf(1.0f + __builtin_amdgcn_exp2f(-1.4426950408889634f * g)) * uu; }
                u32x4 w; w.x = cvt_pk_bf16(o[0][0], o[0][1]); w.y = cvt_pk_bf16(o[0][2], o[0][3]); w.z = cvt_pk_bf16(o[1][0], o[1][1]); w.w = cvt_pk_bf16(o[1][2], o[1][3]);
                *(u32x4*)((char*)O + (unsigned)(row * 4608 + col0) * 2u) = w; }
    }
};
struct EpiNull { static constexpr bool PERM = true, AFTER_DRAIN = false; static constexpr int MID_KT = 0, EPI_VMEM = 0;
    __device__ __forceinline__ void operator()(const f32x4 (&acc)[2][2][4][2], const Unit& u, int wr, int wc, int fr, int fq) const {
#pragma unroll
        for (int ai = 0; ai < 2; ++ai)
#pragma unroll
            for (int bj = 0; bj < 2; ++bj)
#pragma unroll
                for (int m = 0; m < 4; ++m) asm volatile("" :: "v"(acc[ai][bj][m][0]), "v"(acc[ai][bj][m][1])); } };
}

__device__ __forceinline__ void tr_item(const float* W, int ldw, int K, bf16* WT, int n0, int scb, bool rope, const float* kscale, int k0, LAS float* scr, int lane, int KD = 0, int koff = 0) {
    if (KD == 0) KD = K;
    float tv[32];
#pragma unroll
    for (int i = 0; i < 32; ++i) { const int kk = 2 * i + (lane >> 5); tv[i] = W[(size_t)(k0 + kk) * ldw + scb + (lane & 31)]; }
    if (kscale) {
#pragma unroll
        for (int i = 0; i < 32; ++i) tv[i] *= kscale[k0 + 2 * i + (lane >> 5)]; }
#pragma unroll
    for (int i = 0; i < 32; ++i) { const int kk = 2 * i + (lane >> 5); scr[kk * 33 + (lane & 31)] = tv[i]; }
    LDS_WAIT(); asm volatile("" ::: "memory");
    const int c = lane & 7;
#pragma unroll
    for (int j = 0; j < 4; ++j) { const int n = (lane >> 3) + 8 * j; const int sn = rope ? ((n >> 1) + 16 * (n & 1)) : n; const LAS float* s = scr + (8 * c) * 33 + sn;
        v4u o; o.x = pk2(s[0 * 33], s[1 * 33]); o.y = pk2(s[2 * 33], s[3 * 33]); o.z = pk2(s[4 * 33], s[5 * 33]); o.w = pk2(s[6 * 33], s[7 * 33]);
        *(GAS v4u*)(WT + (size_t)(n0 + n) * KD + koff + k0 + 8 * c) = o; }
    LDS_WAIT(); asm volatile("" ::: "memory");
}


typedef float f32x16 __attribute__((ext_vector_type(16)));
typedef short s16x4 __attribute__((ext_vector_type(4)));
typedef short v4i16_t __attribute__((ext_vector_type(4)));
__device__ __forceinline__ unsigned img_off(unsigned row, unsigned ch) { return 256u * row + 16u * (ch ^ (((row & 3u) << 2) | ((row >> 2) & 3u))); }
__device__ __forceinline__ unsigned img_tr_off(unsigned lane, unsigned R0, unsigned c) { const unsigned blk = (lane >> 4) & 1u, q = (lane & 15u) >> 2, p = lane & 3u; return img_off(R0 + q, 4u * c + 2u * blk + (p >> 1)) + 8u * (p & 1u); }
__device__ __forceinline__ s16x4 img_tr_read(const LAS unsigned char* p) { return __builtin_bit_cast(s16x4, __builtin_amdgcn_ds_read_tr16_b64_v4i16((LAS v4i16_t*)p)); }
constexpr int ALDS_BUF = 32768, ALDS_BYTES = 3 * ALDS_BUF;
static_assert(ALDS_BYTES <= RING_BYTES, "attention lds");
__device__ __forceinline__ unsigned cvtpk2(float lo, float hi) { unsigned r; asm volatile("v_cvt_pk_bf16_f32 %0, %1, %2" : "=v"(r) : "v"(lo), "v"(hi)); return r; }
typedef unsigned u32x2t __attribute__((ext_vector_type(2)));
__device__ __forceinline__ v4u widen_pair(u32x2t a, u32x2t b) {
    const auto r0 = __builtin_amdgcn_permlane32_swap(a.x, b.x, false, false); const auto r1 = __builtin_amdgcn_permlane32_swap(a.y, b.y, false, false);
    v4u w; w.x = r0[0]; w.y = r1[0]; w.z = r0[1]; w.w = r1[1]; return w; }
__device__ __forceinline__ void unwiden_pair(v4u L, u32x2t& a, u32x2t& b) {
    const auto r0 = __builtin_amdgcn_permlane32_swap(L.x, L.z, false, false); const auto r1 = __builtin_amdgcn_permlane32_swap(L.y, L.w, false, false);
    a.x = r0[0]; a.y = r1[0]; b.x = r0[1]; b.y = r1[1]; }
template <bool MERGE>
__device__ __forceinline__ void attn_stream(LAS unsigned char* lds, const bf16* PA, bf16* OG01, bf16* OG2, float* MLbase, bf16* CATp, int b, int h, int c, int i0, int nq, int tid, int lane, int wave) {
    typedef unsigned u32x2v __attribute__((ext_vector_type(2)));
    const int g = h >> 2, j = h & 3, r = 1 << (2 * g);
    const size_t rowb = (size_t)b * SEQ;
    const int l31 = lane & 31, hi = lane >> 5;
    const int nkb = nq >> 8;
    const int T = (nq >> 6) + 2, tt0 = (i0 == 0) ? 2 : 0;
    bf16* ogb = ((g == 2) ? OG2 : OG01) + j * 128; const int ogs = (g == 2) ? AOW : 2 * AOW;
    float* mlb = MLbase + (size_t)g * M * 8 + j * 2;
    v4u qf[8], qn[8]; f32x16 o[4]; float mrun = -1e30f, lrun = 0.f;
    int iq = i0 + 32 * wave + l31;
#pragma unroll
    for (int s = 0; s < 8; ++s) qf[s] = *(const v4u*)(PA + (rowb + (size_t)iq * r + c) * NA + h * 128 + 16 * s + 8 * hi);
#pragma unroll
    for (int d = 0; d < 4; ++d)
#pragma unroll
        for (int e = 0; e < 16; ++e) o[d][e] = 0.f;
    int koff[2];
    { const int q4 = lane >> 4, slot = lane & 15;
#pragma unroll
      for (int i = 0; i < 2; ++i) { const int row = 8 * wave + 4 * i + q4; const int ch = slot ^ (((row & 3) << 2) | ((row >> 2) & 3)); koff[i] = row * r * NA + ch * 8; } }
#define ATT_DMA(TILE, BUF) do { const bf16* kt_ = PA + (rowb + (size_t)((i0 - 128 + 64 * (TILE)) * r) + c) * NA + 1536 + h * 128; \
        _Pragma("unroll") for (int i_ = 0; i_ < 2; ++i_) { \
            __builtin_amdgcn_global_load_lds((const unsigned*)(kt_ + koff[i_]), (LAS unsigned*)(lds + (BUF) * ALDS_BUF + 256 * (8 * wave + 4 * i_)), 16, 0, 0); \
            __builtin_amdgcn_global_load_lds((const unsigned*)(kt_ + 1536 + koff[i_]), (LAS unsigned*)(lds + (BUF) * ALDS_BUF + 16384 + 256 * (8 * wave + 4 * i_)), 16, 0, 0); } } while (0)
    WG_BAR();
    ATT_DMA(tt0, 0);
    if (tt0 + 1 < T) ATT_DMA(tt0 + 1, 1);
    asm volatile("" :: "v"(qf[0]), "v"(qf[1]), "v"(qf[2]), "v"(qf[3]), "v"(qf[4]), "v"(qf[5]), "v"(qf[6]), "v"(qf[7]) : "memory");
    asm volatile("s_waitcnt vmcnt(0)" ::: "memory");
    WG_BAR();
    int cur = 0; bool pending = false;
#define ATT_FINAL() do { int hi_ = hi; asm volatile("" : "+v"(hi_));     \
        const float ltot_ = lrun + __shfl_xor(lrun, 32); const size_t qrow_ = rowb + (size_t)iq * r + c; \
        if constexpr (!MERGE) { const float il_ = __builtin_amdgcn_rcpf(ltot_); bf16* orow_ = ogb + qrow_ * ogs + 8 * hi_; \
            _Pragma("unroll") for (int d_ = 0; d_ < 4; ++d_) _Pragma("unroll") for (int p_ = 0; p_ < 2; ++p_) { u32x2t a_, b_; \
                a_.x = cvtpk2(o[d_][8 * p_] * il_, o[d_][8 * p_ + 1] * il_); a_.y = cvtpk2(o[d_][8 * p_ + 2] * il_, o[d_][8 * p_ + 3] * il_); \
                b_.x = cvtpk2(o[d_][8 * p_ + 4] * il_, o[d_][8 * p_ + 5] * il_); b_.y = cvtpk2(o[d_][8 * p_ + 6] * il_, o[d_][8 * p_ + 7] * il_); \
                *(v4u*)(orow_ + d_ * 32 + 16 * p_) = widen_pair(a_, b_); } \
            if (hi_ == 0) { typedef float f32x2v_ __attribute__((ext_vector_type(2))); *(f32x2v_*)(mlb + qrow_ * 8) = (f32x2v_){mrun, ltot_}; } } \
        else { typedef float f32x2v_ __attribute__((ext_vector_type(2))); \
            const f32x2v_ ml1_ = *(const f32x2v_*)(MLbase + ((size_t)1 * M + qrow_) * 8 + j * 2), ml2_ = *(const f32x2v_*)(MLbase + ((size_t)2 * M + qrow_) * 8 + j * 2); \
            const bf16* o1p_ = OG01 + qrow_ * (2 * AOW) + j * 128 + 8 * hi_; const bf16* o2p_ = OG2 + qrow_ * AOW + j * 128 + 8 * hi_; \
            v4u g1_[4][2], g2_[4][2]; \
            _Pragma("unroll") for (int d_ = 0; d_ < 4; ++d_) _Pragma("unroll") for (int p_ = 0; p_ < 2; ++p_) { g1_[d_][p_] = *(const v4u*)(o1p_ + d_ * 32 + 16 * p_); g2_[d_][p_] = *(const v4u*)(o2p_ + d_ * 32 + 16 * p_); } \
            const float mm_ = fmaxf(mrun, fmaxf(ml1_.x, ml2_.x)); const float a0_ = __builtin_amdgcn_exp2f(mrun - mm_), w1_ = ml1_.y * __builtin_amdgcn_exp2f(ml1_.x - mm_), w2_ = ml2_.y * __builtin_amdgcn_exp2f(ml2_.x - mm_); \
            const float inv_ = __builtin_amdgcn_rcpf(ltot_ * a0_ + w1_ + w2_); const float s0_ = a0_ * inv_, s1_ = w1_ * inv_, s2_ = w2_ * inv_; \
            bf16* crow_ = CATp + qrow_ * 1536 + j * 128 + 8 * hi_; \
            _Pragma("unroll") for (int d_ = 0; d_ < 4; ++d_) _Pragma("unroll") for (int p_ = 0; p_ < 2; ++p_) { u32x2t a1_, b1_, a2_, b2_; unwiden_pair(g1_[d_][p_], a1_, b1_); unwiden_pair(g2_[d_][p_], a2_, b2_); u32x2t ya_, yb_; \
                ya_.x = cvtpk2(o[d_][8 * p_] * s0_ + bflo(a1_.x) * s1_ + bflo(a2_.x) * s2_, o[d_][8 * p_ + 1] * s0_ + bfhi(a1_.x) * s1_ + bfhi(a2_.x) * s2_); \
                ya_.y = cvtpk2(o[d_][8 * p_ + 2] * s0_ + bflo(a1_.y) * s1_ + bflo(a2_.y) * s2_, o[d_][8 * p_ + 3] * s0_ + bfhi(a1_.y) * s1_ + bfhi(a2_.y) * s2_); \
                yb_.x = cvtpk2(o[d_][8 * p_ + 4] * s0_ + bflo(b1_.x) * s1_ + bflo(b2_.x) * s2_, o[d_][8 * p_ + 5] * s0_ + bfhi(b1_.x) * s1_ + bfhi(b2_.x) * s2_); \
                yb_.y = cvtpk2(o[d_][8 * p_ + 6] * s0_ + bflo(b1_.y) * s1_ + bflo(b2_.y) * s2_, o[d_][8 * p_ + 7] * s0_ + bfhi(b1_.y) * s1_ + bfhi(b2_.y) * s2_); \
                *(v4u*)(crow_ + d_ * 32 + 16 * p_) = widen_pair(ya_, yb_); } } } while (0)
#pragma unroll 1
    for (int tt = tt0; tt < T; ++tt) {
        const LAS unsigned char* Kb = lds + cur * ALDS_BUF; const LAS unsigned char* Vb = Kb + 16384;
        const int rel = tt - (wave >> 1), kb_ = rel >> 2, ph = rel & 3;
        const bool fin = (rel >= 0 && kb_ < nkb && ph == 3 && pending), nxq = fin && (kb_ + 1 < nkb), dma = (tt + 2 < T);
        const bool qpre = (rel >= 0 && kb_ + 1 < nkb && ph == 2);
        if (qpre) {
            int hq_ = hi; asm volatile("" : "+v"(hq_));
#pragma unroll
            for (int s = 0; s < 8; ++s) qn[s] = *(const v4u*)(PA + (rowb + (size_t)(iq + 256) * r + c) * NA + h * 128 + 16 * s + 8 * hq_); }
        if (fin) {
            ATT_FINAL(); pending = false;
            if (nxq) { iq += 256;
#pragma unroll
                for (int s = 0; s < 8; ++s) qf[s] = qn[s];
#pragma unroll
                for (int d = 0; d < 4; ++d)
#pragma unroll
                    for (int e = 0; e < 16; ++e) o[d][e] = 0.f;
                mrun = -1e30f; lrun = 0.f; } }
        asm volatile("" ::: "memory");
        if (dma) ATT_DMA(tt + 2, cur >= 1 ? cur - 1 : 2);
        asm volatile("" ::: "memory");
        if (rel >= 0 && kb_ < nkb && ph < 3) {
            const bool do0 = !((wave & 1) && ph == 0), do1 = !(!(wave & 1) && ph == 2);
            f32x16 s0, s1;
#pragma unroll
            for (int e = 0; e < 16; ++e) { s0[e] = 0.f; s1[e] = 0.f; }
            if (do0) {
#pragma unroll
                for (int s = 0; s < 8; ++s) { const bf16x8 a0 = *(const LAS bf16x8*)(Kb + img_off(l31, 2 * s + hi)); s0 = __builtin_amdgcn_mfma_f32_32x32x16_bf16(a0, __builtin_bit_cast(bf16x8, qf[s]), s0, 0, 0, 0); } }
            if (do1) {
#pragma unroll
                for (int s = 0; s < 8; ++s) { const bf16x8 a1 = *(const LAS bf16x8*)(Kb + img_off(32 + l31, 2 * s + hi)); s1 = __builtin_amdgcn_mfma_f32_32x32x16_bf16(a1, __builtin_bit_cast(bf16x8, qf[s]), s1, 0, 0, 0); } }
            const int dq = iq - (i0 - 128 + 64 * tt) - 4 * hi;
            float mx = -__builtin_inff();
            if (ph != 1) {
#pragma unroll
                for (int e = 0; e < 16; ++e) { const int ko = (e & 3) + 8 * (e >> 2);
                    if ((unsigned)(dq - ko) > 128u) s0[e] = -__builtin_inff();
                    if ((unsigned)(dq - ko - 32) > 128u) s1[e] = -__builtin_inff(); } }
            if (do0) {
#pragma unroll
                for (int e = 0; e < 16; ++e) mx = fmaxf(mx, s0[e]); }
            if (do1) {
#pragma unroll
                for (int e = 0; e < 16; ++e) mx = fmaxf(mx, s1[e]); }
            mx = fmaxf(mx, __shfl_xor(mx, 32));
            const float mnew = fmaxf(mrun, mx), alpha = __builtin_amdgcn_exp2f(mrun - mnew); mrun = mnew;
            float ps = 0.f;
            if (do0) {
#pragma unroll
                for (int e = 0; e < 16; ++e) { s0[e] = __builtin_amdgcn_exp2f(s0[e] - mnew); ps += s0[e]; } }
            if (do1) {
#pragma unroll
                for (int e = 0; e < 16; ++e) { s1[e] = __builtin_amdgcn_exp2f(s1[e] - mnew); ps += s1[e]; } }
            lrun = lrun * alpha + ps;
            if (__any(alpha != 1.0f)) {
#pragma unroll
            for (int d = 0; d < 4; ++d)
#pragma unroll
                for (int e = 0; e < 16; ++e) o[d][e] *= alpha; }
#pragma unroll
            for (int hf = 0; hf < 2; ++hf) { if (hf == 0 ? !do0 : !do1) continue;
                bf16x8 pb[2];
#pragma unroll
                for (int k2 = 0; k2 < 2; ++k2) { v4u w;
                    if (hf == 0) { w.x = cvtpk2(s0[8 * k2], s0[8 * k2 + 1]); w.y = cvtpk2(s0[8 * k2 + 2], s0[8 * k2 + 3]); w.z = cvtpk2(s0[8 * k2 + 4], s0[8 * k2 + 5]); w.w = cvtpk2(s0[8 * k2 + 6], s0[8 * k2 + 7]); }
                    else { w.x = cvtpk2(s1[8 * k2], s1[8 * k2 + 1]); w.y = cvtpk2(s1[8 * k2 + 2], s1[8 * k2 + 3]); w.z = cvtpk2(s1[8 * k2 + 4], s1[8 * k2 + 5]); w.w = cvtpk2(s1[8 * k2 + 6], s1[8 * k2 + 7]); }
                    pb[k2] = __builtin_bit_cast(bf16x8, w); }
#pragma unroll
                for (int dp = 0; dp < 2; ++dp) { s16x4 vlo[2][2], vhh[2][2];
#pragma unroll
                    for (int d2 = 0; d2 < 2; ++d2)
#pragma unroll
                        for (int k2 = 0; k2 < 2; ++k2) { const int ks = 2 * hf + k2, d = 2 * dp + d2;
                            const unsigned a0_ = (unsigned)(size_t)(Vb + img_tr_off(lane, 16 * ks + 4 * hi, d)), a1_ = (unsigned)(size_t)(Vb + img_tr_off(lane, 16 * ks + 4 * hi + 8, d));
                            asm volatile("ds_read_b64_tr_b16 %0, %1" : "=v"(vlo[d2][k2]) : "v"(a0_)); asm volatile("ds_read_b64_tr_b16 %0, %1" : "=v"(vhh[d2][k2]) : "v"(a1_)); }
                    asm volatile("s_waitcnt lgkmcnt(0)" : "+v"(vlo[0][0]), "+v"(vlo[0][1]), "+v"(vlo[1][0]), "+v"(vlo[1][1]), "+v"(vhh[0][0]), "+v"(vhh[0][1]), "+v"(vhh[1][0]), "+v"(vhh[1][1]));
#pragma unroll
                    for (int d2 = 0; d2 < 2; ++d2)
#pragma unroll
                        for (int k2 = 0; k2 < 2; ++k2) { const s16x4 lo = vlo[d2][k2], hh = vhh[d2][k2]; const int d = 2 * dp + d2;
                            const bf16x8 a = (bf16x8){lo[0], lo[1], lo[2], lo[3], hh[0], hh[1], hh[2], hh[3]};
                            o[d] = __builtin_amdgcn_mfma_f32_32x32x16_bf16(a, pb[k2], o[d], 0, 0, 0); } } }
            if (ph == 2) pending = true;
        }
        { const int ny = (fin ? 8 : 0) + (qpre ? 8 : 0) + (dma ? 4 : 0);
          if (ny >= 20) asm volatile("s_waitcnt vmcnt(20)" ::: "memory"); else if (ny >= 16) asm volatile("s_waitcnt vmcnt(16)" ::: "memory"); else if (ny >= 12) asm volatile("s_waitcnt vmcnt(12)" ::: "memory");
          else if (ny >= 8) asm volatile("s_waitcnt vmcnt(8)" ::: "memory"); else if (ny >= 4) asm volatile("s_waitcnt vmcnt(4)" ::: "memory"); else asm volatile("s_waitcnt vmcnt(0)" ::: "memory"); }
        WG_BAR();
        cur = cur == 2 ? 0 : cur + 1;
    }
    if (pending) ATT_FINAL();
#undef ATT_FINAL
#undef ATT_DMA
}

constexpr int GAS_ = 72;
constexpr int G_QRAW = 0, G_Q1P = 16384, G_K1 = 32768, G_V0 = 49152, G_AM = 81920, G_TOT0 = G_AM + 64 * GAS_ * 2, G_F2 = G_TOT0 + 512, G_TOT1 = G_F2 + 512,
              G_EB = G_TOT1 + 512, G_EBL = G_EB + 512, G_LDS = G_EBL + 512, G_SSQ = G_LDS + 512, G_GLR = G_SSQ + 2048, G_GNL = G_GLR + 8192, G_END = G_GNL + 1024;
static_assert(G_END <= RING_BYTES, "gla lds");
__device__ __forceinline__ v4u split_hi4(const float* x, v4u& lo) {
    v4u h; unsigned hw[4], lw[4];
#pragma unroll
    for (int i = 0; i < 4; ++i) { hw[i] = cvtpk2(x[2 * i], x[2 * i + 1]); const float r0 = x[2 * i] - bflo(hw[i]), r1 = x[2 * i + 1] - bfhi(hw[i]); lw[i] = cvtpk2(r0, r1); }
    h.x = hw[0]; h.y = hw[1]; h.z = hw[2]; h.w = hw[3]; lo.x = lw[0]; lo.y = lw[1]; lo.z = lw[2]; lo.w = lw[3]; return h;
}
template <bool FULL>
__device__ __forceinline__ void gla_seg(LAS unsigned char* lds, const bf16* GB, const float* GLR, const float* w_gate_lr, const float* b_gate, const float* gla_norm_g, bf16* GLAOUT,
                                        float* SLOC, float* LOGD, int b, int h, int sg, int tid_in0, int lane_in0, int wave) {
    typedef unsigned u32x2w __attribute__((ext_vector_type(2)));
    int tid_in = tid_in0, lane_in = lane_in0; asm volatile("" : "+v"(tid_in), "+v"(lane_in));
    LAS unsigned char* QRAW = lds + G_QRAW; LAS unsigned char* Q1P = lds + G_Q1P; LAS unsigned char* K1 = lds + G_K1; LAS unsigned char* VI = lds + G_V0; LAS bf16* AM = (LAS bf16*)(lds + G_AM);
    LAS float* TOT0 = (LAS float*)(lds + G_TOT0); LAS float* F2 = (LAS float*)(lds + G_F2); LAS float* TOT1 = (LAS float*)(lds + G_TOT1); LAS float* EB = (LAS float*)(lds + G_EB);
    LAS float* EBL = (LAS float*)(lds + G_EBL); LAS float* LDSUM = (LAS float*)(lds + G_LDS); LAS float* SSQP = (LAS float*)(lds + G_SSQ); LAS float* GLRS = (LAS float*)(lds + G_GLR); LAS float* GNL = (LAS float*)(lds + G_GNL);
    const int it = wave >> 2, dt = wave & 3;
    constexpr float LOG2E = 1.4426950408889634f, LN2 = 0.6931471805599453f;
    f32x16 sacc[4];
#pragma unroll
    for (int db = 0; db < 4; ++db)
#pragma unroll
        for (int e = 0; e < 16; ++e) sacc[db][e] = 0.f;
    const size_t rowb = (size_t)b * SEQ + (size_t)sg * 1024;
    const int bh3 = (b * 4 + h) * 3;
    if constexpr (FULL) {
        for (int sp = 0; sp < sg; ++sp) {
            int ln1 = lane_in, t1 = tid_in; asm volatile("" : "+v"(ln1), "+v"(t1) :: "memory");
            const int hii = ln1 >> 5;
            const f32x4* sl = (const f32x4*)(SLOC + (size_t)(bh3 + sp) * 32768) + (wave * 64 + ln1);
            f32x4 s4[16];
#pragma unroll
            for (int q = 0; q < 16; ++q) s4[q] = sl[q * 512];
            if (t1 < 128) EB[t1] = __builtin_amdgcn_exp2f(LOG2E * LOGD[(bh3 + sp) * 128 + t1]);
            WG_BAR();
#pragma unroll
            for (int db = 0; db < 4; ++db)
#pragma unroll
                for (int gq = 0; gq < 4; ++gq) { const int d0 = db * 32 + 8 * gq + 4 * hii; const f32x4 e4 = *(const LAS f32x4*)(EB + d0); const f32x4 v4 = s4[db * 4 + gq];
#pragma unroll
                    for (int c = 0; c < 4; ++c) sacc[db][4 * gq + c] = sacc[db][4 * gq + c] * e4[c] + v4[c]; }
            WG_BAR(); }
    }
    v4u wgh, wgl; float biasv;
    { int ln0 = lane_in; asm volatile("" : "+v"(ln0));
      const int l31i = ln0 & 31, hii = ln0 >> 5, dd = h * 128 + dt * 32 + l31i; float wv[8];
#pragma unroll
      for (int j = 0; j < 8; ++j) wv[j] = w_gate_lr[(8 * hii + j) * 512 + dd];
      wgh = split_hi4(wv, wgl); biasv = b_gate[dd]; }
    { const float2 g2 = *(const float2*)(GLR + rowb * 16 + tid_in * 2); GLRS[tid_in * 2] = g2.x; GLRS[tid_in * 2 + 1] = g2.y; }
    if (tid_in < 256) GNL[tid_in] = gla_norm_g[tid_in];
    if (tid_in < 128) { EBL[tid_in] = 0.f; LDSUM[tid_in] = 0.f; }
    v4u kraw0, kraw1, qraw0, qraw1, vraw[4]; float2 glrq = {0.f, 0.f};
#define GLA_REQ(ROWC, T) do { const bf16* qp_ = GB + ((ROWC) + ((T) >> 3)) * 3072 + h * 128 + ((T) & 7) * 8; kraw0 = *(const v4u*)(qp_ + 512); kraw1 = *(const v4u*)(qp_ + 576); \
        if constexpr (FULL) { qraw0 = *(const v4u*)qp_; qraw1 = *(const v4u*)(qp_ + 64); } \
        _Pragma("unroll") for (int c4_ = 0; c4_ < 4; ++c4_) vraw[c4_] = *(const v4u*)(qp_ + 1024 + 128 * h + 64 * c4_); } while (0)
    { int t3 = tid_in; asm volatile("" : "+v"(t3) :: "memory"); GLA_REQ(rowb, t3); }
    __syncthreads();
    { int t4 = tid_in; asm volatile("" : "+v"(t4) :: "memory"); glrq = *(const float2*)(GLR + (rowb + 64) * 16 + t4 * 2); asm volatile("" ::: "memory"); }
#pragma unroll 1
    for (int n = 0; n < 16; ++n) {
        const size_t rowc = rowb + (size_t)n * 64;
        int tid_ = tid_in; asm volatile("" : "+v"(tid_));
        const int tid = tid_, lane = tid & 63, l31 = lane & 31, hi = lane >> 5;
        asm volatile("" ::: "memory");
        const int srow = tid >> 3, sc8 = tid & 7;
        v4u grl[2][2];
        if constexpr (FULL) {
#pragma unroll
            for (int i2 = 0; i2 < 2; ++i2)
#pragma unroll
                for (int pp = 0; pp < 2; ++pp) grl[i2][pp] = *(const v4u*)(GB + (rowc + i2 * 32 + l31) * 3072 + 2048 + h * 256 + 32 * wave + 16 * pp + 8 * hi); }
        asm volatile("" ::: "memory");
        f32x16 yv;
        { float gx[8]; { const LAS float* gsrc = GLRS + (n & 1) * 1024 + (it * 32 + l31) * 16 + 8 * hi; const f32x4 g0 = *(const LAS f32x4*)gsrc, g1 = *(const LAS f32x4*)(gsrc + 4);
              gx[0] = g0.x; gx[1] = g0.y; gx[2] = g0.z; gx[3] = g0.w; gx[4] = g1.x; gx[5] = g1.y; gx[6] = g1.z; gx[7] = g1.w; }
          v4u al; const v4u ah = split_hi4(gx, al);
          f32x16 z;
#pragma unroll
          for (int e = 0; e < 16; ++e) z[e] = biasv;
          z = __builtin_amdgcn_mfma_f32_32x32x16_bf16(__builtin_bit_cast(bf16x8, al), __builtin_bit_cast(bf16x8, wgh), z, 0, 0, 0);
          z = __builtin_amdgcn_mfma_f32_32x32x16_bf16(__builtin_bit_cast(bf16x8, ah), __builtin_bit_cast(bf16x8, wgl), z, 0, 0, 0);
          z = __builtin_amdgcn_mfma_f32_32x32x16_bf16(__builtin_bit_cast(bf16x8, ah), __builtin_bit_cast(bf16x8, wgh), z, 0, 0, 0);
          float la[16];
#pragma unroll
          for (int e = 0; e < 16; ++e) la[e] = (fminf(z[e], 0.f) - LN2 * __builtin_amdgcn_logf(1.0f + __builtin_amdgcn_exp2f(-LOG2E * fabsf(z[e])))) * (1.0f / 16.0f);
#pragma unroll
          for (int e = 0; e < 16; ++e) yv[e] = 0.f;
#pragma unroll
          for (int s2 = 0; s2 < 2; ++s2) { v4u ll; const v4u lh = split_hi4(la + 8 * s2, ll);
              unsigned uw[4];
#pragma unroll
              for (int i2 = 0; i2 < 4; ++i2) { const int j0 = 2 * i2, j1 = 2 * i2 + 1; const int t0 = 16 * s2 + 8 * (j0 >> 2) + 4 * hi + (j0 & 3), t1 = 16 * s2 + 8 * (j1 >> 2) + 4 * hi + (j1 & 3);
                  uw[i2] = (t0 <= l31 ? 0x3f80u : 0u) | (t1 <= l31 ? 0x3f800000u : 0u); }
              v4u ut; ut.x = uw[0]; ut.y = uw[1]; ut.z = uw[2]; ut.w = uw[3];
              yv = __builtin_amdgcn_mfma_f32_32x32x16_bf16(__builtin_bit_cast(bf16x8, ll), __builtin_bit_cast(bf16x8, ut), yv, 0, 0, 0);
              yv = __builtin_amdgcn_mfma_f32_32x32x16_bf16(__builtin_bit_cast(bf16x8, lh), __builtin_bit_cast(bf16x8, ut), yv, 0, 0, 0); } }
        if (l31 == 31) { LAS float* tp = (it ? TOT1 : TOT0) + 32 * dt + 4 * hi;
#pragma unroll
            for (int gq = 0; gq < 4; ++gq) *(LAS f32x4*)(tp + 8 * gq) = (f32x4){yv[4 * gq], yv[4 * gq + 1], yv[4 * gq + 2], yv[4 * gq + 3]}; }
        if (l31 == 0 && it == 1) { LAS float* tp = F2 + 32 * dt + 4 * hi;
#pragma unroll
            for (int gq = 0; gq < 4; ++gq) *(LAS f32x4*)(tp + 8 * gq) = (f32x4){yv[4 * gq], yv[4 * gq + 1], yv[4 * gq + 2], yv[4 * gq + 3]}; }
        { const unsigned o0 = img_off(srow, sc8), o1 = img_off(srow, sc8 + 8);
          if constexpr (FULL) { *(LAS v4u*)(QRAW + o0) = qraw0; *(LAS v4u*)(QRAW + o1) = qraw1; }
          *(LAS v4u*)(K1 + o0) = kraw0; *(LAS v4u*)(K1 + o1) = kraw1;
          *(LAS v4u*)(VI + o0) = vraw[0]; *(LAS v4u*)(VI + o1) = vraw[1]; *(LAS v4u*)(VI + 16384 + o0) = vraw[2]; *(LAS v4u*)(VI + 16384 + o1) = vraw[3]; }
        WG_BAR();
        {
#pragma unroll
            for (int gq = 0; gq < 4; ++gq) { const int d0 = 32 * dt + 8 * gq + 4 * hi;
                const f32x4 t0 = *(const LAS f32x4*)(TOT0 + d0), f2 = *(const LAS f32x4*)(F2 + d0);
                if (it == 0 && l31 == 0) { const f32x4 t1 = *(const LAS f32x4*)(TOT1 + d0), el = *(const LAS f32x4*)(EBL + d0), lsm = *(const LAS f32x4*)(LDSUM + d0); f32x4 eb, nl, ns;
#pragma unroll
                    for (int c = 0; c < 4; ++c) { const float bref = t0[c] + f2[c], blast = t0[c] + t1[c]; eb[c] = __builtin_amdgcn_exp2f(LOG2E * (el[c] + bref)); nl[c] = blast - bref; ns[c] = lsm[c] + blast; }
                    *(LAS f32x4*)(EB + d0) = eb; *(LAS f32x4*)(EBL + d0) = nl; *(LAS f32x4*)(LDSUM + d0) = ns; }
                const unsigned ao = img_off(it * 32 + l31, 4 * dt + gq) + 8 * hi;
                const u32x2w kr = *(const LAS u32x2w*)(K1 + ao); u32x2w qr = {0u, 0u};
                if constexpr (FULL) qr = *(const LAS u32x2w*)(QRAW + ao);
                float e1[4], e2[4];
#pragma unroll
                for (int c = 0; c < 4; ++c) { const float rel = LOG2E * (yv[4 * gq + c] - (it ? f2[c] : t0[c] + f2[c])); e1[c] = __builtin_amdgcn_exp2f(rel); e2[c] = __builtin_amdgcn_exp2f(-rel); }
                u32x2w kw; kw.x = cvtpk2(bflo(kr.x) * e2[0], bfhi(kr.x) * e2[1]); kw.y = cvtpk2(bflo(kr.y) * e2[2], bfhi(kr.y) * e2[3]);
                *(LAS u32x2w*)(K1 + ao) = kw;
                if constexpr (FULL) { u32x2w qw; qw.x = cvtpk2(bflo(qr.x) * e1[0], bfhi(qr.x) * e1[1]); qw.y = cvtpk2(bflo(qr.y) * e1[2], bfhi(qr.y) * e1[3]);
                    *(LAS u32x2w*)(Q1P + img_off(it * 32 + l31, 4 * dt + 2 * (gq >> 1) + hi) + 8 * (gq & 1)) = qw; } }
        }
        WG_BAR();
        if (n + 1 < 16) { LAS float* gd = GLRS + ((n + 1) & 1) * 1024 + tid * 2; gd[0] = glrq.x; gd[1] = glrq.y; }
        asm volatile("" ::: "memory");
        { const size_t rn1 = rowb + (size_t)(n + 1 < 16 ? n + 1 : 15) * 64, rn2 = rowb + (size_t)(n + 2 < 16 ? n + 2 : 15) * 64;
          GLA_REQ(rn1, tid); glrq = *(const float2*)(GLR + rn2 * 16 + tid * 2); }
        asm volatile("" ::: "memory");
#pragma unroll
        for (int db = 0; db < 4; ++db)
#pragma unroll
            for (int gq = 0; gq < 4; ++gq) { const f32x4 e4 = *(const LAS f32x4*)(EB + db * 32 + 8 * gq + 4 * hi);
                sacc[db][4 * gq] *= e4.x; sacc[db][4 * gq + 1] *= e4.y; sacc[db][4 * gq + 2] *= e4.z; sacc[db][4 * gq + 3] *= e4.w; }
        f32x16 oacc[2];
#pragma unroll
        for (int i2 = 0; i2 < 2; ++i2)
#pragma unroll
            for (int e = 0; e < 16; ++e) oacc[i2][e] = 0.f;
        if constexpr (FULL) {
        if (wave < 3) { const int ia = wave > 0 ? 1 : 0, ja = wave == 2 ? 1 : 0; f32x16 a16;
#pragma unroll
            for (int e = 0; e < 16; ++e) a16[e] = 0.f;
#pragma unroll
            for (int ks = 0; ks < 8; ++ks) { const unsigned ka = img_off(ja * 32 + l31, 2 * ks) + 8 * hi, kb2 = img_off(ja * 32 + l31, 2 * ks + 1) + 8 * hi;
                const s16x4 lo = *(const LAS s16x4*)(K1 + ka), hh = *(const LAS s16x4*)(K1 + kb2);
                const bf16x8 af = (bf16x8){lo[0], lo[1], lo[2], lo[3], hh[0], hh[1], hh[2], hh[3]};
                const bf16x8 bfr = *(const LAS bf16x8*)(Q1P + img_off(ia * 32 + l31, 2 * ks + hi));
                a16 = __builtin_amdgcn_mfma_f32_32x32x16_bf16(af, bfr, a16, 0, 0, 0); }
#pragma unroll
            for (int gq = 0; gq < 4; ++gq) { const int i = ia * 32 + l31, j0 = ja * 32 + 8 * gq + 4 * hi; u32x2w w;
                w.x = cvtpk2(j0 <= i ? a16[4 * gq] : 0.f, j0 + 1 <= i ? a16[4 * gq + 1] : 0.f); w.y = cvtpk2(j0 + 2 <= i ? a16[4 * gq + 2] : 0.f, j0 + 3 <= i ? a16[4 * gq + 3] : 0.f);
                *(LAS u32x2w*)(AM + i * GAS_ + j0) = w; } }
#pragma unroll
        for (int db = 0; db < 4; ++db)
#pragma unroll
            for (int s2 = 0; s2 < 2; ++s2) { v4u w; w.x = cvtpk2(sacc[db][8 * s2], sacc[db][8 * s2 + 1]); w.y = cvtpk2(sacc[db][8 * s2 + 2], sacc[db][8 * s2 + 3]);
                w.z = cvtpk2(sacc[db][8 * s2 + 4], sacc[db][8 * s2 + 5]); w.w = cvtpk2(sacc[db][8 * s2 + 6], sacc[db][8 * s2 + 7]); const bf16x8 af = __builtin_bit_cast(bf16x8, w);
#pragma unroll
                for (int i2 = 0; i2 < 2; ++i2) { const bf16x8 bfr = *(const LAS bf16x8*)(Q1P + img_off(i2 * 32 + l31, 4 * db + 2 * s2 + hi));
                    oacc[i2] = __builtin_amdgcn_mfma_f32_32x32x16_bf16(af, bfr, oacc[i2], 0, 0, 0); } }
        WG_BAR();
        }
        bf16x8 vf[4];
        { const LAS unsigned char* vim = VI + (wave >> 2) * 16384;
#pragma unroll
          for (int ks = 0; ks < 4; ++ks) { const s16x4 lo = img_tr_read(vim + img_tr_off(lane, 16 * ks + 8 * hi, wave & 3)), hh = img_tr_read(vim + img_tr_off(lane, 16 * ks + 8 * hi + 4, wave & 3));
              vf[ks] = (bf16x8){lo[0], lo[1], lo[2], lo[3], hh[0], hh[1], hh[2], hh[3]}; } }
        if constexpr (FULL) {
#pragma unroll
        for (int i2 = 0; i2 < 2; ++i2)
#pragma unroll
            for (int ks = 0; ks < 4; ++ks) { if (i2 == 0 && ks >= 2) continue;
                const bf16x8 bfr = *(const LAS bf16x8*)(AM + (i2 * 32 + l31) * GAS_ + 16 * ks + 8 * hi);
                oacc[i2] = __builtin_amdgcn_mfma_f32_32x32x16_bf16(vf[ks], bfr, oacc[i2], 0, 0, 0); }
        }
#pragma unroll
        for (int db = 0; db < 4; ++db)
#pragma unroll
            for (int ks = 0; ks < 4; ++ks) { const s16x4 lo = img_tr_read(K1 + img_tr_off(lane, 16 * ks + 8 * hi, db)), hh = img_tr_read(K1 + img_tr_off(lane, 16 * ks + 8 * hi + 4, db));
                const bf16x8 af = (bf16x8){lo[0], lo[1], lo[2], lo[3], hh[0], hh[1], hh[2], hh[3]};
                sacc[db] = __builtin_amdgcn_mfma_f32_32x32x16_bf16(af, vf[ks], sacc[db], 0, 0, 0); }
        if constexpr (FULL) {
#pragma unroll
        for (int i2 = 0; i2 < 2; ++i2) { float sq = 0.f;
#pragma unroll
            for (int e = 0; e < 16; ++e) sq += oacc[i2][e] * oacc[i2][e];
            sq += __shfl_xor(sq, 32);
            if (hi == 0) SSQP[(i2 * 32 + l31) * 8 + wave] = sq; }
        }
        WG_BAR();
        if constexpr (FULL) {
#pragma unroll
        for (int i2 = 0; i2 < 2; ++i2) { const int tok = i2 * 32 + l31; const f32x4 p0 = *(const LAS f32x4*)(SSQP + tok * 8), p1 = *(const LAS f32x4*)(SSQP + tok * 8 + 4);
            const float rstd = __builtin_amdgcn_rsqf(((p0.x + p0.y) + (p0.z + p0.w) + (p1.x + p1.y) + (p1.z + p1.w)) * (1.0f / 256.0f) + EPS);
            const size_t row = rowc + tok;
#pragma unroll
            for (int pp = 0; pp < 2; ++pp) { u32x2t ga_, gb_; unwiden_pair(grl[i2][pp], ga_, gb_); u32x2t ya, yb;
#pragma unroll
                for (int q2 = 0; q2 < 2; ++q2) { const int gq = 2 * pp + q2; const int v0 = 32 * wave + 8 * gq + 4 * hi; const u32x2t g2 = q2 ? gb_ : ga_;
                    const f32x4 gnv = *(const LAS f32x4*)(GNL + v0);
                    const float y0 = oacc[i2][4 * gq] * rstd * gnv.x * bflo(g2.x), y1 = oacc[i2][4 * gq + 1] * rstd * gnv.y * bfhi(g2.x);
                    const float y2 = oacc[i2][4 * gq + 2] * rstd * gnv.z * bflo(g2.y), y3 = oacc[i2][4 * gq + 3] * rstd * gnv.w * bfhi(g2.y);
                    u32x2t w; w.x = cvtpk2(y0, y1); w.y = cvtpk2(y2, y3); if (q2) yb = w; else ya = w; }
                *(v4u*)(GLAOUT + row * 1536 + 512 + h * 256 + 32 * wave + 16 * pp + 8 * hi) = widen_pair(ya, yb);     } }
        }
    }
#undef GLA_REQ
    if constexpr (!FULL) {
        int ln2 = lane_in; asm volatile("" : "+v"(ln2) :: "memory");
        const int hii = ln2 >> 5;
        f32x4* sl = (f32x4*)(SLOC + (size_t)(bh3 + sg) * 32768) + (wave * 64 + ln2);
#pragma unroll
        for (int db = 0; db < 4; ++db)
#pragma unroll
            for (int gq = 0; gq < 4; ++gq) { const int d0 = db * 32 + 8 * gq + 4 * hii; const f32x4 el = *(const LAS f32x4*)(EBL + d0);
                { f32x4 o4;
#pragma unroll
                for (int c = 0; c < 4; ++c) o4[c] = sacc[db][4 * gq + c] * __builtin_amdgcn_exp2f(LOG2E * el[c]);
                sl[(db * 4 + gq) * 512] = o4; } }
        if (tid_in < 128) LOGD[(bh3 + sg) * 128 + tid_in] = LDSUM[tid_in];
    }
}


__device__ __forceinline__ void gla_loc(LAS unsigned char* lds, const bf16* GB, const float* GLR, const float* w_gate_lr, const float* b_gate,
                                        float* SLOC, float* LOGD, int b, int h, int sg, int tid_in0, int lane_in0, int wave) {
    typedef unsigned u32x2w __attribute__((ext_vector_type(2)));
    int tid_in = tid_in0, lane_in = lane_in0; asm volatile("" : "+v"(tid_in), "+v"(lane_in));
    constexpr int P_K1 = 0, P_V = 32768, P_TOT0 = 98304, P_TOT1 = P_TOT0 + 512, P_CARRY = P_TOT1 + 512, P_GLRS = P_CARRY + 1024, P_END = P_GLRS + 8192;
    static_assert(P_END <= RING_BYTES, "gla_loc lds");
    LAS float* TOT0 = (LAS float*)(lds + P_TOT0); LAS float* TOT1 = (LAS float*)(lds + P_TOT1); LAS float* CARRY = (LAS float*)(lds + P_CARRY); LAS float* GLRS = (LAS float*)(lds + P_GLRS);
    const int it = wave >> 2, dt = wave & 3;
    constexpr float LOG2E = 1.4426950408889634f, LN2 = 0.6931471805599453f;
    f32x16 sacc[4];
#pragma unroll
    for (int db = 0; db < 4; ++db)
#pragma unroll
        for (int e = 0; e < 16; ++e) sacc[db][e] = 0.f;
    const size_t rowb = (size_t)b * SEQ + (size_t)sg * 1024;
    const int bh3 = (b * 4 + h) * 3;
    v4u wgh, wgl; float biasv;
    { int ln0 = lane_in; asm volatile("" : "+v"(ln0));
      const int l31i = ln0 & 31, hii = ln0 >> 5, dd = h * 128 + dt * 32 + l31i; float wv[8];
#pragma unroll
      for (int j = 0; j < 8; ++j) wv[j] = w_gate_lr[(8 * hii + j) * 512 + dd];
      wgh = split_hi4(wv, wgl); biasv = b_gate[dd]; }
    { const float2 g2 = *(const float2*)(GLR + (rowb + 15 * 64) * 16 + tid_in * 2); GLRS[tid_in * 2] = g2.x; GLRS[tid_in * 2 + 1] = g2.y; }
    if (tid_in < 128) CARRY[tid_in] = 0.f;
    v4u kraw0, kraw1, vraw[4]; float2 glrq = {0.f, 0.f};
#define GLL_REQ(ROWC, T) do { const bf16* qp_ = GB + ((ROWC) + ((T) >> 3)) * 3072 + h * 128 + ((T) & 7) * 8; kraw0 = *(const v4u*)(qp_ + 512); kraw1 = *(const v4u*)(qp_ + 576); \
        _Pragma("unroll") for (int c4_ = 0; c4_ < 4; ++c4_) vraw[c4_] = *(const v4u*)(qp_ + 1024 + 128 * h + 64 * c4_); } while (0)
    { int t3 = tid_in; asm volatile("" : "+v"(t3) :: "memory"); GLL_REQ(rowb + 15 * 64, t3); }
    __syncthreads();
    { int t4 = tid_in; asm volatile("" : "+v"(t4) :: "memory"); glrq = *(const float2*)(GLR + (rowb + 14 * 64) * 16 + t4 * 2); asm volatile("" ::: "memory"); }
    f32x16 yv;
#pragma unroll
    for (int e = 0; e < 16; ++e) yv[e] = 0.f;
#pragma unroll 1
    for (int i = 0; i <= 16; ++i) {
        int tid_ = tid_in; asm volatile("" : "+v"(tid_));
        const int tid = tid_, lane = tid & 63, l31 = lane & 31, hi = lane >> 5;
        asm volatile("" ::: "memory");
        auto gates = [&]() __attribute__((always_inline)) {
            { float gx[8]; { const LAS float* gsrc = GLRS + (i & 1) * 1024 + (it * 32 + l31) * 16 + 8 * hi; const f32x4 g0 = *(const LAS f32x4*)gsrc, g1 = *(const LAS f32x4*)(gsrc + 4);
                  gx[0] = g0.x; gx[1] = g0.y; gx[2] = g0.z; gx[3] = g0.w; gx[4] = g1.x; gx[5] = g1.y; gx[6] = g1.z; gx[7] = g1.w; }
              v4u al; const v4u ah = split_hi4(gx, al);
              f32x16 z;
#pragma unroll
              for (int e = 0; e < 16; ++e) z[e] = biasv;
              z = __builtin_amdgcn_mfma_f32_32x32x16_bf16(__builtin_bit_cast(bf16x8, al), __builtin_bit_cast(bf16x8, wgh), z, 0, 0, 0);
              z = __builtin_amdgcn_mfma_f32_32x32x16_bf16(__builtin_bit_cast(bf16x8, ah), __builtin_bit_cast(bf16x8, wgl), z, 0, 0, 0);
              z = __builtin_amdgcn_mfma_f32_32x32x16_bf16(__builtin_bit_cast(bf16x8, ah), __builtin_bit_cast(bf16x8, wgh), z, 0, 0, 0);
              float la[16];
#pragma unroll
              for (int e = 0; e < 16; ++e) la[e] = (fminf(z[e], 0.f) - LN2 * __builtin_amdgcn_logf(1.0f + __builtin_amdgcn_exp2f(-LOG2E * fabsf(z[e])))) * (1.0f / 16.0f);
#pragma unroll
              for (int e = 0; e < 16; ++e) yv[e] = 0.f;
#pragma unroll
              for (int s2 = 0; s2 < 2; ++s2) { v4u ll; const v4u lh = split_hi4(la + 8 * s2, ll);
                  unsigned uw[4];
#pragma unroll
                  for (int i2 = 0; i2 < 4; ++i2) { const int j0 = 2 * i2, j1 = 2 * i2 + 1; const int t0 = 16 * s2 + 8 * (j0 >> 2) + 4 * hi + (j0 & 3), t1 = 16 * s2 + 8 * (j1 >> 2) + 4 * hi + (j1 & 3);
                      uw[i2] = (t0 <= l31 ? 0x3f80u : 0u) | (t1 <= l31 ? 0x3f800000u : 0u); }
                  v4u ut; ut.x = uw[0]; ut.y = uw[1]; ut.z = uw[2]; ut.w = uw[3];
                  yv = __builtin_amdgcn_mfma_f32_32x32x16_bf16(__builtin_bit_cast(bf16x8, ll), __builtin_bit_cast(bf16x8, ut), yv, 0, 0, 0);
                  yv = __builtin_amdgcn_mfma_f32_32x32x16_bf16(__builtin_bit_cast(bf16x8, lh), __builtin_bit_cast(bf16x8, ut), yv, 0, 0, 0); } }
            if (l31 == 31) { LAS float* tp = (it ? TOT1 : TOT0) + 32 * dt + 4 * hi;
#pragma unroll
                for (int gq = 0; gq < 4; ++gq) *(LAS f32x4*)(tp + 8 * gq) = (f32x4){yv[4 * gq], yv[4 * gq + 1], yv[4 * gq + 2], yv[4 * gq + 3]}; }
            { const int srow = tid >> 3, sc8 = tid & 7; const unsigned o0 = img_off(srow, sc8), o1 = img_off(srow, sc8 + 8);
              LAS unsigned char* K1 = lds + P_K1 + (i & 1) * 16384; LAS unsigned char* VI = lds + P_V + (i & 1) * 32768;
              *(LAS v4u*)(K1 + o0) = kraw0; *(LAS v4u*)(K1 + o1) = kraw1;
              *(LAS v4u*)(VI + o0) = vraw[0]; *(LAS v4u*)(VI + o1) = vraw[1]; *(LAS v4u*)(VI + 16384 + o0) = vraw[2]; *(LAS v4u*)(VI + 16384 + o1) = vraw[3]; }
            if (i + 1 < 16) { LAS float* gd = GLRS + ((i + 1) & 1) * 1024 + tid * 2; gd[0] = glrq.x; gd[1] = glrq.y; }
            asm volatile("" ::: "memory");
            { const size_t rn1 = rowb + (size_t)(14 - i > 0 ? 14 - i : 0) * 64, rn2 = rowb + (size_t)(13 - i > 0 ? 13 - i : 0) * 64;
              GLL_REQ(rn1, tid); glrq = *(const float2*)(GLR + rn2 * 16 + tid * 2); }
            asm volatile("" ::: "memory");
        };
        auto update = [&]() __attribute__((always_inline)) {
            const LAS unsigned char* K1 = lds + P_K1 + ((i - 1) & 1) * 16384; const LAS unsigned char* vim = lds + P_V + ((i - 1) & 1) * 32768 + (wave >> 2) * 16384;
            bf16x8 vf[4];
#pragma unroll
            for (int ks = 0; ks < 4; ++ks) { const s16x4 lo = img_tr_read(vim + img_tr_off(lane, 16 * ks + 8 * hi, wave & 3)), hh = img_tr_read(vim + img_tr_off(lane, 16 * ks + 8 * hi + 4, wave & 3));
                vf[ks] = (bf16x8){lo[0], lo[1], lo[2], lo[3], hh[0], hh[1], hh[2], hh[3]}; }
#pragma unroll
            for (int db = 0; db < 4; ++db)
#pragma unroll
                for (int ks = 0; ks < 4; ++ks) { const s16x4 lo = img_tr_read(K1 + img_tr_off(lane, 16 * ks + 8 * hi, db)), hh = img_tr_read(K1 + img_tr_off(lane, 16 * ks + 8 * hi + 4, db));
                    const bf16x8 af = (bf16x8){lo[0], lo[1], lo[2], lo[3], hh[0], hh[1], hh[2], hh[3]};
                    sacc[db] = __builtin_amdgcn_mfma_f32_32x32x16_bf16(af, vf[ks], sacc[db], 0, 0, 0); }
        };
        if (wave >= 4 && i > 0) update();
        if (i < 16) gates();
        if (wave < 4 && i > 0) update();
        WG_BAR();
        if (i < 16) {
            LAS unsigned char* K1 = lds + P_K1 + (i & 1) * 16384; const LAS float* cyb = CARRY + (i & 1) * 128; LAS float* cyn = CARRY + ((i + 1) & 1) * 128;
#pragma unroll
            for (int gq = 0; gq < 4; ++gq) { const int d0 = 32 * dt + 8 * gq + 4 * hi;
                const f32x4 t0 = *(const LAS f32x4*)(TOT0 + d0), t1 = *(const LAS f32x4*)(TOT1 + d0), cy = *(const LAS f32x4*)(cyb + d0);
                if (it == 0 && l31 == 0) { f32x4 nc;
#pragma unroll
                    for (int c = 0; c < 4; ++c) nc[c] = cy[c] + (t0[c] + t1[c]);
                    *(LAS f32x4*)(cyn + d0) = nc; }
                const unsigned ao = img_off(it * 32 + l31, 4 * dt + gq) + 8 * hi;
                const u32x2w kr = *(const LAS u32x2w*)(K1 + ao);
                float e2[4];
#pragma unroll
                for (int c = 0; c < 4; ++c) { const float sa = ((it ? t1[c] : t0[c] + t1[c]) - yv[4 * gq + c]) + cy[c]; e2[c] = __builtin_amdgcn_exp2f(LOG2E * sa); }
                u32x2w kw; kw.x = cvtpk2(bflo(kr.x) * e2[0], bfhi(kr.x) * e2[1]); kw.y = cvtpk2(bflo(kr.y) * e2[2], bfhi(kr.y) * e2[3]);
                *(LAS u32x2w*)(K1 + ao) = kw; }
        }
        WG_BAR();
    }
#undef GLL_REQ
    { int ln2 = lane_in; asm volatile("" : "+v"(ln2) :: "memory");
      f32x4* sl = (f32x4*)(SLOC + (size_t)(bh3 + sg) * 32768) + (wave * 64 + ln2);
#pragma unroll
      for (int db = 0; db < 4; ++db)
#pragma unroll
          for (int gq = 0; gq < 4; ++gq) sl[(db * 4 + gq) * 512] = (f32x4){sacc[db][4 * gq], sacc[db][4 * gq + 1], sacc[db][4 * gq + 2], sacc[db][4 * gq + 3]};
      if (tid_in < 128) LOGD[(bh3 + sg) * 128 + tid_in] = CARRY[tid_in]; }
}

struct Args { const float* in[13]; float* out; unsigned char* ws; };

__global__ void __launch_bounds__(NWAVES * 64, 2) hyb_fwd(Args args) {
    extern __shared__ __attribute__((aligned(16))) unsigned char lds[];
    LAS unsigned char* L = (LAS unsigned char*)lds;
    volatile LAS unsigned* MISC = (volatile LAS unsigned*)(L + MISC_OFF);
    const int tid = threadIdx.x, lane = tid & 63, wave = __builtin_amdgcn_readfirstlane(tid >> 6);
    const int G = gridDim.x; const int bx = blockIdx.x; const int vcu = (G % 8 == 0) ? (bx % 8) * (G / 8) + bx / 8 : bx;
    unsigned char* ws = args.ws;
    gu32* ctl = (gu32*)(ws + WS_CTL);
    const float* x = args.in[0]; const float* norm1_g = args.in[1]; const float* w_in = args.in[2]; const float* w_gate_lr = args.in[3]; const float* b_gate = args.in[4];
    const float* gla_norm_g = args.in[5]; const float* w_branch_a = args.in[6]; const float* w_branch_b = args.in[7]; const float* w_out = args.in[8]; const float* norm2_g = args.in[9];
    const float* w_ffn_in = args.in[10]; const float* w_ffn_down = args.in[11]; const float* norm_f_g = args.in[12];
    float* out = args.out;
    bf16* WB_t = (bf16*)(ws + WS_WB); bf16* WA_t = (bf16*)(ws + WS_WA); bf16* WCAT_t = (bf16*)(ws + WS_WBA);
    bf16* WOUT_t = (bf16*)(ws + WS_WOUT); bf16* WFF_t = (bf16*)(ws + WS_WFF); bf16* WDN_t = (bf16*)(ws + WS_WDN);
    bf16* H = (bf16*)(ws + WS_H); bf16* CAT = (bf16*)(ws + WS_CAT); bf16* GB = (bf16*)(ws + WS_BIG); bf16* PA = (bf16*)(ws + WS_BIG);
    bf16* MIX = (bf16*)(ws + WS_H); bf16* X2B = (bf16*)(ws + WS_H); bf16* X1B = (bf16*)(ws + WS_BIG); bf16* ACT = (bf16*)(ws + WS_BIG) + 1024;
    bf16* GR = (bf16*)out; bf16* GS = GR + (size_t)M * 1024;
    float* ROPE = (float*)(ws + WS_ROPE); float* GLR = (float*)(ws + WS_GLR); float* SSQ1 = (float*)(ws + WS_SSQ1); float* SSQ2 = (float*)(ws + WS_SSQ2);

    for (int u = tid; u < (LDS_BYTES - LDSCTL_OFF) / 4; u += NWAVES * 64) ((LAS unsigned*)(L + LDSCTL_OFF))[u] = 0u;
    __syncthreads();
    XcdBarrier bar = xcd_barrier_post((unsigned*)(ctl + CW_BAR), MISC + 8);
    if (threadIdx.x == 0 && (G != 256 || bar.x != (unsigned)(bx & 7))) (void)__hip_atomic_fetch_or(ctl + CW_MAP, 1u, RLX_AGENT);
    const int gw = vcu * NWAVES + wave, NGW = G * NWAVES;

#if PH(0)
    for (int rep_ = 0; rep_ < ((PROBE_DUP & 4) ? 2 : 1); ++rep_)
    {
        if (rep_) __syncthreads();
        PHASE_IDS();
        LAS float* WL = (LAS float*)(L + RING_OFF);
        { float wt[32];
#pragma unroll
          for (int it = 0; it < 32; ++it) { const int i = tid + 512 * it; const int q = i & 3, ln = (i >> 2) & 63, p = (i >> 8) & 3, e = (i >> 10) & 3, j = i >> 12; const int k = 4 * (ln + 64 * j) + e;
              wt[it] = w_in[(size_t)k * INW + C_GLR + 4 * p + q]; }
#pragma unroll
          for (int it = 0; it < 32; ++it) WL[tid + 512 * it] = wt[it]; }
        __syncthreads();
        if (wave >= 6) {
            LAS float* scr = (LAS float*)(L + RING_OFF + 65536 + (wave - 6) * 8704);
            constexpr int I_B = 16 * (NB / 32), I_A = 16 * (NA / 32), I_BA = 8 * 32, I_BB = 16 * 32, I_O = 16 * 32, I_FF = 16 * (NFF / 32), I_DN = 44 * 32;
            constexpr int NITEMS = I_B + I_A + I_BA + I_BB + I_O + I_FF + I_DN;
            for (int it = vcu * 2 + (wave - 6); it < NITEMS; it += G * 2) {
                int r = it;
                if (r < I_B) { const int nb = r % (NB / 32), kb = r / (NB / 32), n0 = nb * 32; const int g0_ = n0 - 3072; const int scb = (n0 < 3072) ? C_GQ + n0 : (((g0_ >> 7) & 1) ? C_GA + 1024 : C_GA) + (g0_ >> 8) * 128 + (g0_ & 127);
                    tr_item(w_in, INW, 1024, WB_t, n0, scb, false, nullptr, kb * 64, scr, lane); continue; } r -= I_B;
                if (r < I_A) { const int nb = r % (NA / 32), kb = r / (NA / 32), n0 = nb * 32; const bool rope = (n0 < 3072) && ((n0 & 127) == 0);
                    tr_item(w_in, INW, 1024, WA_t, n0, n0, rope, nullptr, kb * 64, scr, lane); continue; } r -= I_A;
                if (r < I_BA) { const int nb = r % 32, kb = r / 32; tr_item(w_branch_a, 1024, 512, WCAT_t, nb * 32, nb * 32, false, nullptr, kb * 64, scr, lane, 1536, 0); continue; } r -= I_BA;
                if (r < I_BB) { const int nb = r % 32, kb = r / 32; tr_item(w_branch_b, 1024, 1024, WCAT_t, nb * 32, nb * 32, false, nullptr, kb * 64, scr, lane, 1536, 512); continue; } r -= I_BB;
                if (r < I_O) { const int nb = r % 32, kb = r / 32; tr_item(w_out, 1024, 1024, WOUT_t, nb * 32, nb * 32, false, nullptr, kb * 64, scr, lane); continue; } r -= I_O;
                if (r < I_FF) { const int nb = r % (NFF / 32), kb = r / (NFF / 32), n0 = nb * 32; const int t = n0 >> 8, half = (n0 >> 7) & 1; const int scb = (half ? FFH : 0) + t * 128 + (n0 & 127);
                    tr_item(w_ffn_in, NFF, 1024, WFF_t, n0, scb, false, norm2_g, kb * 64, scr, lane); continue; } r -= I_FF;
                { const int nb = r % 32, kb = r / 32; tr_item(w_ffn_down, 1024, FFH, WDN_t, nb * 32, nb * 32, false, nullptr, kb * 64, scr, lane); }
            }
            for (int i = bx * 128 + (tid - 384); i < SEQ * 16; i += G * 128) { const int pos = i >> 4, f = i & 15;
                const float inv = exp2f(-(float)f * (18.931568569324174f / 16.0f)); const float ang = (float)pos * inv;
                const double rev = (double)ang * 0.15915494309189535; const float fr = (float)(rev - __builtin_rint(rev));
                ROPE[pos * 32 + f] = __builtin_amdgcn_cosf(fr); ROPE[pos * 32 + 16 + f] = __builtin_amdgcn_sinf(fr); }
        } else {
        f32x4 g1[4];
#pragma unroll
        for (int j = 0; j < 4; ++j) g1[j] = ((const f32x4*)norm1_g)[lane + 64 * j];
        f32x4 xn[2][4];
        { const int mf = (vcu * 6 + wave) * 2;
#pragma unroll
          for (int rr = 0; rr < 2; ++rr) { const GAS f32x4* xr = (const GAS f32x4*)(x + (size_t)(mf + rr) * DM) + lane;
#pragma unroll
              for (int j = 0; j < 4; ++j) xn[rr][j] = __builtin_nontemporal_load(xr + 64 * j); }     }
#pragma unroll 1
        for (int m0 = (vcu * 6 + wave) * 2; m0 < M; m0 += G * 12) {
            asm volatile("" ::: "memory");
            float hx[2][16];
#pragma unroll
            for (int rr = 0; rr < 2; ++rr)
#pragma unroll
                for (int j = 0; j < 4; ++j) { const f32x4 t = xn[rr][j]; hx[rr][4 * j] = t.x; hx[rr][4 * j + 1] = t.y; hx[rr][4 * j + 2] = t.z; hx[rr][4 * j + 3] = t.w; }
            if (m0 + G * 12 < M) {
#pragma unroll
                for (int rr = 0; rr < 2; ++rr) { const GAS f32x4* xr = (const GAS f32x4*)(x + (size_t)(m0 + G * 12 + rr) * DM) + lane;
#pragma unroll
                    for (int j = 0; j < 4; ++j) xn[rr][j] = __builtin_nontemporal_load(xr + 64 * j); }     }
            asm volatile("" ::: "memory");
#pragma unroll
            for (int rr = 0; rr < 2; ++rr) { float s = 0.f;
#pragma unroll
                for (int i = 0; i < 16; ++i) s += hx[rr][i] * hx[rr][i];
                const float rs = __builtin_amdgcn_rsqf(wave_sum(s) * (1.0f / DM) + EPS);
#pragma unroll
                for (int j = 0; j < 4; ++j) { hx[rr][4 * j] *= rs * g1[j].x; hx[rr][4 * j + 1] *= rs * g1[j].y; hx[rr][4 * j + 2] *= rs * g1[j].z; hx[rr][4 * j + 3] *= rs * g1[j].w; }
#pragma unroll
                for (int jj = 0; jj < 2; ++jj) { const int j0 = 2 * jj, j1 = 2 * jj + 1; const bool odd = (lane & 1) != 0;
                    const unsigned a0 = pk2(hx[rr][4 * j0], hx[rr][4 * j0 + 1]), a1 = pk2(hx[rr][4 * j0 + 2], hx[rr][4 * j0 + 3]), b0 = pk2(hx[rr][4 * j1], hx[rr][4 * j1 + 1]), b1 = pk2(hx[rr][4 * j1 + 2], hx[rr][4 * j1 + 3]);
                    const unsigned r0 = (unsigned)__builtin_amdgcn_mov_dpp((int)(odd ? a0 : b0), 0xB1, 0xF, 0xF, true), r1 = (unsigned)__builtin_amdgcn_mov_dpp((int)(odd ? a1 : b1), 0xB1, 0xF, 0xF, true);
                    v4u w; if (odd) { w.x = r0; w.y = r1; w.z = b0; w.w = b1; } else { w.x = a0; w.y = a1; w.z = r0; w.w = r1; }
                    { const bf16* hrow_ = H + (size_t)(m0 + rr) * DM; const unsigned ho_ = (unsigned)(8 * ((lane & ~1) + 64 * (odd ? j1 : j0))); ST16_S(hrow_, ho_, w, 0); } } }
#pragma unroll
            for (int rr = 0; rr < 2; ++rr) asm volatile("" : "+v"(hx[rr][0]), "+v"(hx[rr][1]), "+v"(hx[rr][2]), "+v"(hx[rr][3]), "+v"(hx[rr][4]), "+v"(hx[rr][5]), "+v"(hx[rr][6]), "+v"(hx[rr][7]),
                                                                "+v"(hx[rr][8]), "+v"(hx[rr][9]), "+v"(hx[rr][10]), "+v"(hx[rr][11]), "+v"(hx[rr][12]), "+v"(hx[rr][13]), "+v"(hx[rr][14]), "+v"(hx[rr][15]));
            __builtin_amdgcn_sched_barrier(0);
            float a[2][16];
#pragma unroll
            for (int rr = 0; rr < 2; ++rr)
#pragma unroll
                for (int i = 0; i < 16; ++i) a[rr][i] = 0.f;
#pragma unroll
            for (int je = 0; je < 16; ++je) {
#pragma unroll
                for (int p = 0; p < 4; ++p) { const f32x4 w4 = ((const LAS f32x4*)WL)[(je * 4 + p) * 64 + lane];
#pragma unroll
                    for (int rr = 0; rr < 2; ++rr) { const float xv = hx[rr][je]; a[rr][4 * p] += w4.x * xv; a[rr][4 * p + 1] += w4.y * xv; a[rr][4 * p + 2] += w4.z * xv; a[rr][4 * p + 3] += w4.w * xv; } }

#pragma unroll
                for (int rr = 0; rr < 2; ++rr) asm volatile("" : "+v"(a[rr][0]), "+v"(a[rr][1]), "+v"(a[rr][2]), "+v"(a[rr][3]), "+v"(a[rr][4]), "+v"(a[rr][5]), "+v"(a[rr][6]), "+v"(a[rr][7]),
                                                                    "+v"(a[rr][8]), "+v"(a[rr][9]), "+v"(a[rr][10]), "+v"(a[rr][11]), "+v"(a[rr][12]), "+v"(a[rr][13]), "+v"(a[rr][14]), "+v"(a[rr][15]) :: "memory"); }
#pragma unroll
            for (int rr = 0; rr < 2; ++rr) {
            float b8[8], c4[4], d2[2];
#pragma unroll
            for (int i = 0; i < 8; ++i) { const bool hi = (lane & 32) != 0; const float mine = hi ? a[rr][i + 8] : a[rr][i], oth = hi ? a[rr][i] : a[rr][i + 8]; b8[i] = mine + __shfl_xor(oth, 32); }
#pragma unroll
            for (int i = 0; i < 4; ++i) { const bool hi = (lane & 16) != 0; const float mine = hi ? b8[i + 4] : b8[i], oth = hi ? b8[i] : b8[i + 4]; c4[i] = mine + __shfl_xor(oth, 16); }
#pragma unroll
            for (int i = 0; i < 2; ++i) { const bool hi = (lane & 8) != 0; const float mine = hi ? c4[i + 2] : c4[i], oth = hi ? c4[i] : c4[i + 2]; d2[i] = mine + __shfl_xor(oth, 8); }
            float f1; { const bool hi = (lane & 4) != 0; const float mine = hi ? d2[1] : d2[0], oth = hi ? d2[0] : d2[1]; f1 = mine + __shfl_xor(oth, 4); }
            f1 += __shfl_xor(f1, 2); f1 += __shfl_xor(f1, 1);
            if ((lane & 3) == 0) GLR[(size_t)(m0 + rr) * 16 + ((lane >> 2) & 15)] = f1; }
        }
        }
    }
#endif
    GRID_BAR();

#if PH(1)
    for (int rep_ = 0; rep_ < ((PROBE_DUP & 8) ? 2 : 1); ++rep_)
    { pg8::Gemm g{H, WB_t, M, NB, 1024}; pg8::StaticOrder S; S.init(M, NB, G, bx); pg8::EpiB E{GB, GR, GS};
      pg8::gemm_phase<pg8::EpiB, pg8::StaticOrder, true, true>(L + RING_OFF, g, S, E, wave); }
#endif
    LOCAL_BAR();

#if PH(2)
    for (int rep_ = 0; rep_ < ((PROBE_DUP & 1) ? 2 : 1); ++rep_)
    {
        if (rep_) GRID_BAR();
        float* SLOC = (float*)(ws + WS_SLOC); float* LOGD = (float*)(ws + WS_LOGD);
        {
        for (int prep_ = 0; prep_ < ((PROBE_DUP & 512) ? 2 : 1); ++prep_)
        for (int unit = (G == 256) ? ((vcu & 31) < 24 ? (vcu >> 5) * 24 + (vcu & 31) : 192) : vcu; unit < 192; unit += G) { const int bh = unit / 3, sg = unit % 3; PHASE_IDS();
            gla_loc(L + RING_OFF, GB, GLR, w_gate_lr, b_gate, SLOC, LOGD, bh >> 2, bh & 3, sg, tid, lane, wave); __syncthreads(); } }
        LOCAL_BAR();
        {
        for (int unit = vcu; unit < 256; unit += G) { const int bh = unit >> 2, sg = unit & 3; PHASE_IDS();
            gla_seg<true>(L + RING_OFF, GB, GLR, w_gate_lr, b_gate, gla_norm_g, CAT, SLOC, LOGD, bh >> 2, bh & 3, sg, tid, lane, wave); __syncthreads(); } }
    }
#endif
    GRID_BAR();

#if PH(3)
    for (int rep_ = 0; rep_ < ((PROBE_DUP & 16) ? 2 : 1); ++rep_)
    { pg8::Gemm g{H, WA_t, M, NA, 1024}; pg8::StaticOrder S; S.init(M, NA, G, bx); pg8::EpiA E{PA, ROPE, QSCALE};
      pg8::gemm_phase<pg8::EpiA, pg8::StaticOrder, true, true>(L + RING_OFF, g, S, E, wave); }
#endif
    LOCAL_BAR();

#if PH(4)
    {
        bf16* OG01 = (bf16*)(ws + WS_OG01); bf16* OG2 = (bf16*)(ws + WS_OG2); float* ML = (float*)(ws + WS_ML);
        { PHASE_IDS();
        for (int v = vcu; v < 256; v += G) { const int b = v >> 4, j = (v >> 2) & 3, q = v & 3;
            attn_stream<false>(L + RING_OFF, PA, OG01, OG2, ML, CAT, b, 4 + j, q, 0, 1024, tid, lane, wave);
#pragma unroll 1
            for (int i = 0; i < 4; ++i) attn_stream<false>(L + RING_OFF, PA, OG01, OG2, ML, CAT, b, 8 + j, 4 * q + i, 0, 256, tid, lane, wave); } }
        LOCAL_BAR();
        { PHASE_IDS();
        for (int v = vcu; v < 256; v += G) { const int b = v >> 4, j = (v >> 2) & 3, q = v & 3;
            attn_stream<true>(L + RING_OFF, PA, OG01, OG2, ML, CAT, b, j, 0, 1024 * q, 1024, tid, lane, wave); } }
    }
#endif
    LOCAL_BAR();

#if PH(5)
    for (int rep_ = 0; rep_ < ((PROBE_DUP & 32) ? 2 : 1); ++rep_) {
    { pg8::Gemm g{CAT, WCAT_t, M, 1024, 1536}; pg8::StaticOrder S; S.init(M, 1024, G, bx); pg8::EpiMixF E{GR, GS, MIX};
      pg8::gemm_phase<pg8::EpiMixF, pg8::StaticOrder, true, true>(L + RING_OFF, g, S, E, wave); }
    __syncthreads(); }
#endif
    LOCAL_BAR();

#if PH(6)
    { pg8::Gemm g{MIX, WOUT_t, M, 1024, 1024}; pg8::StaticOrder S; S.init(M, 1024, G, bx); pg8::EpiX1 E{x, X1B, SSQ1};
      pg8::gemm_phase<pg8::EpiX1, pg8::StaticOrder, true, true>(L + RING_OFF, g, S, E, wave); }
#endif
    LOCAL_BAR();

#if PH(7)
    for (int rep_ = 0; rep_ < ((PROBE_DUP & 64) ? 2 : 1); ++rep_)
    { pg8::Gemm g{X1B, WFF_t, M, NFF, 1024, 4608}; pg8::StaticOrder S; S.init(M, NFF, G, bx); pg8::EpiSwi E{ACT, SSQ1};
      pg8::gemm_phase<pg8::EpiSwi, pg8::StaticOrder, true, true>(L + RING_OFF, g, S, E, wave); }
    if (PROBE_DUP & 256) { pg8::Gemm g{X1B, WFF_t, M, NFF, 1024, 4608}; pg8::StaticOrder S; S.init(M, NFF, G, bx); pg8::EpiNull E{};
      pg8::gemm_phase<pg8::EpiNull, pg8::StaticOrder, true, true>(L + RING_OFF, g, S, E, wave); }
#endif
    LOCAL_BAR();

#if PH(8)
    { pg8::Gemm g{ACT, WDN_t, M, 1024, FFH, 4608}; pg8::StaticOrder S; S.init(M, 1024, G, bx); pg8::EpiX2 E{X1B, X2B, SSQ2};
      pg8::gemm_phase<pg8::EpiX2, pg8::StaticOrder, true, true>(L + RING_OFF, g, S, E, wave); }
#endif
    GRID_BAR();

#if PH(9)
    {
        PHASE_IDS();
        const bool bad = (__hip_atomic_load(ctl + CW_BAR + XB_TMO, RLX_AGENT) != 0u);
        f32x4 gfv[2][2];
#pragma unroll
        for (int hf = 0; hf < 2; ++hf) { gfv[hf][0] = ((const f32x4*)norm_f_g)[(hf * 512 + lane * 8) >> 2]; gfv[hf][1] = ((const f32x4*)norm_f_g)[((hf * 512 + lane * 8) >> 2) + 1]; }
        for (int m0 = gw * 4; m0 < M; m0 += NGW * 4) {
            v4u tv[4][2]; float sq[4];
#pragma unroll
            for (int rr = 0; rr < 4; ++rr) { sq[rr] = SSQ2[m0 + rr];
#pragma unroll
                for (int hf = 0; hf < 2; ++hf) tv[rr][hf] = __builtin_nontemporal_load((const v4u*)(X2B + (size_t)(m0 + rr) * DM + hf * 512 + lane * 8)); }
#pragma unroll
            for (int rr = 0; rr < 4; ++rr) { const int row = m0 + rr; float rs = __builtin_amdgcn_rsqf(sq[rr] * (1.0f / DM) + EPS); if (bad) rs = __builtin_nanf("");
#pragma unroll
                for (int hf = 0; hf < 2; ++hf) { const int c0 = hf * 512 + lane * 8; const v4u t = tv[rr][hf]; const f32x4 g0 = gfv[hf][0], g1 = gfv[hf][1];
                    f32x4 o0, o1; o0[0] = bflo(t.x) * rs * g0[0]; o0[1] = bfhi(t.x) * rs * g0[1]; o0[2] = bflo(t.y) * rs * g0[2]; o0[3] = bfhi(t.y) * rs * g0[3];
                    o1[0] = bflo(t.z) * rs * g1[0]; o1[1] = bfhi(t.z) * rs * g1[1]; o1[2] = bflo(t.w) * rs * g1[2]; o1[3] = bfhi(t.w) * rs * g1[3];
                    const float* orow = out + (size_t)row * DM; const unsigned lo_ = (unsigned)(lane * 32);
                    if (hf == 0) { ST16_S(orow, lo_, o0, 0); ST16_S(orow, lo_, o1, 16); } else { ST16_S(orow, lo_, o0, 2048); ST16_S(orow, lo_, o1, 2064); } } } }
    }
#endif
}

extern "C" void kernel_launch(void* const* d_in, const int* in_sizes, int n_in, void* d_out, int out_size, void* d_ws, size_t ws_size, hipStream_t stream) {
    static int grid = 0;
    if (grid == 0) {
        if (n_in != 13 || in_sizes[0] != M * DM || out_size != M * DM || ws_size < WS_END) { fprintf(stderr, "kernel_launch: unexpected shapes (n_in %d, in0 %d, out %d, ws %zu)\n", n_in, n_in > 0 ? in_sizes[0] : -1, out_size, ws_size); grid = -1; return; }
        int dev = 0, cus = 0, per_cu = 0;
        if (hipGetDevice(&dev) != hipSuccess || hipDeviceGetAttribute(&cus, hipDeviceAttributeMultiprocessorCount, dev) != hipSuccess) { grid = -1; return; }
        if (hipFuncSetAttribute((const void*)hyb_fwd, hipFuncAttributeMaxDynamicSharedMemorySize, LDS_BYTES) != hipSuccess) { grid = -1; return; }
        if (hipOccupancyMaxActiveBlocksPerMultiprocessor(&per_cu, (const void*)hyb_fwd, NWAVES * 64, LDS_BYTES) != hipSuccess || per_cu < 1) { fprintf(stderr, "kernel_launch: occupancy query says %d\n", per_cu); }
        (void)hipGetLastError();
        grid = cus;
    }
    if (grid < 0) return;
    if (hipMemsetAsync((char*)d_ws + WS_CTL, 0, CTL_ZERO_BYTES, stream) != hipSuccess) return;
    Args a{};
    for (int i = 0; i < 13; ++i) a.in[i] = (const float*)d_in[i];
    a.out = (float*)d_out; a.ws = (unsigned char*)d_ws;
    hipLaunchKernelGGL(hyb_fwd, dim3(grid), dim3(NWAVES * 64), LDS_BYTES, stream, a);
}
```

```cpp
#include <hip/hip_runtime.h>
#include <cstdio>
#include <cstdint>
namespace pg8 {
#define PG8_LAS __attribute__((address_space(3)))
typedef unsigned short bf16_t;
typedef short bf16x8 __attribute__((ext_vector_type(8)));
typedef float f32x4 __attribute__((ext_vector_type(4)));
typedef unsigned u32x4 __attribute__((ext_vector_type(4)));
constexpr int BM = 256, BK = 64, HALF = 128, HTB = HALF * BK * 2  , STAGE_BYTES = 8 * HTB, NXCD = 8, WGM = 8;

__host__ __device__ __forceinline__ int lds_byte(int r, int c) { const int st = (r >> 4) * 2 + (c >> 5), rr = r & 15, cc = c & 31, ob = rr * 64 + cc * 2; return st * 1024 + (ob ^ (((ob >> 9) & 1) << 5)); }
__host__ __device__ __forceinline__ void stage_rc(int b, int& R, int& C) { const int st = b / 1024, sb = b % 1024, swz = sb ^ (((sb >> 9) & 1) << 5); R = (st >> 1) * 16 + swz / 64; C = (st & 1) * 32 + (swz % 64) / 2; }
__host__ __device__ __forceinline__ int perm32(int rho) { const int n = rho >> 4, i = rho & 15; return 8 * (i >> 2) + 4 * n + (i & 3); }

struct Unit { int pm, pn; };
struct Gemm { const bf16_t* A; const bf16_t* Bt; int M, N, K; int lda = 0; };

struct StaticOrder {
    int nM, nN, nwg, G, c;
    __host__ __device__ void init(int M, int N, int G_, int c_) { nM = M / BM; nN = N / BM; nwg = nM * nN; G = G_; c = c_; }
    __host__ __device__ bool next(int i, Unit& u) const {
        const long L = (long)i * G + c; if (L >= nwg) return false;
        int wgid = (int)L; { const int q = nwg / NXCD, r = nwg % NXCD, xcd = wgid % NXCD, off = wgid / NXCD; wgid = (xcd < r ? xcd * (q + 1) : r * (q + 1) + (xcd - r) * q) + off; }
        const int nig = WGM * nN, gid = wgid / nig, fm = gid * WGM, gsz = (nM - fm) < WGM ? (nM - fm) : WGM;
        u.pm = fm + ((wgid % nig) % gsz); u.pn = (wgid % nig) / gsz; return true;
    }
    __device__ __forceinline__ void a_ready(const Unit&) const {}
    __device__ __forceinline__ void done(const Unit&) const {}
};

__device__ __forceinline__ unsigned cvt_pk_bf16(float lo, float hi) { unsigned r; asm volatile("v_cvt_pk_bf16_f32 %0, %1, %2" : "=v"(r) : "v"(lo), "v"(hi)); return r; }
typedef float f32x2 __attribute__((ext_vector_type(2)));
__device__ __forceinline__ f32x2 gelu_pk(f32x2 v) {
    const f32x2 av = __builtin_elementwise_abs(v), d = av * 0.2316418882f + 1.0f;
    f32x2 t; t.x = __builtin_amdgcn_rcpf(d.x); t.y = __builtin_amdgcn_rcpf(d.y);
    f32x2 q = t * 0.5307027145f + (-0.7265760135f); q = q * t + 0.7107068705f; q = q * t + (-0.142248368f); q = q * t + 0.127414796f; q = q * t;
    const f32x2 s = (v * v) * (-0.72134752044f);
    f32x2 e; e.x = __builtin_amdgcn_exp2f(s.x); e.y = __builtin_amdgcn_exp2f(s.y);
    const f32x2 m = v * (q * e), r = v - m;
    f32x2 o; o.x = v.x < 0.f ? m.x : r.x; o.y = v.y < 0.f ? m.y : r.y; return o;
}

template <int ACT  > struct EpiBf16 {
    static constexpr bool PERM = true, AFTER_DRAIN = false; static_assert(ACT == 0 || ACT == 1, "EpiBf16: ACT is 0 (none) or 1 (gelu_pk)");
    bf16_t* O; int ldc; const float* bias; int split_cols; size_t split_stride; float scale0;
    __device__ __forceinline__ void operator()(const f32x4 (&acc)[2][2][4][2], const Unit& u, int wr, int wc, int fr, int fq) const {
        const int row0 = u.pm * BM + wr * 64 + fr; int colt = u.pn * BM; bf16_t* base = O;
        float sc = 1.f; if (split_cols) { const int t = colt / split_cols; base += (size_t)t * split_stride; colt -= t * split_cols; if (t == 0) sc = scale0; }
        const int col0 = colt + wc * 32 + 8 * fq, bcol0 = u.pn * BM + wc * 32 + 8 * fq;
        f32x4 bv[2][2];
#pragma unroll
        for (int bj = 0; bj < 2; ++bj)
#pragma unroll
            for (int n = 0; n < 2; ++n) bv[bj][n] = bias ? *(const f32x4*)(bias + bcol0 + bj * HALF + 4 * n) : (f32x4){0.f, 0.f, 0.f, 0.f};
#pragma unroll
        for (int ai = 0; ai < 2; ++ai)
#pragma unroll
            for (int m = 0; m < 4; ++m) { bf16_t* rowp = base + (size_t)(row0 + ai * HALF + m * 16) * ldc + col0;
#pragma unroll
                for (int bj = 0; bj < 2; ++bj) { f32x4 v0 = acc[ai][bj][m][0] + bv[bj][0], v1 = acc[ai][bj][m][1] + bv[bj][1];
                    if (ACT == 1) { f32x2 a = gelu_pk((f32x2){v0[0], v0[1]}), b = gelu_pk((f32x2){v0[2], v0[3]}), c = gelu_pk((f32x2){v1[0], v1[1]}), d = gelu_pk((f32x2){v1[2], v1[3]});
                        v0 = (f32x4){a.x, a.y, b.x, b.y}; v1 = (f32x4){c.x, c.y, d.x, d.y}; }
                    v0 = v0 * sc; v1 = v1 * sc; u32x4 w; w.x = cvt_pk_bf16(v0[0], v0[1]); w.y = cvt_pk_bf16(v0[2], v0[3]); w.z = cvt_pk_bf16(v1[0], v1[1]); w.w = cvt_pk_bf16(v1[2], v1[3]);
                    *(u32x4*)(rowp + bj * HALF) = w; } }
    }
};

struct PanelStats {
    unsigned* xbuf;
    unsigned* cnt;
    unsigned* tmo;
    int ntn; float eps;
    unsigned code;
    __device__ __forceinline__ bool run(const f32x4 (&v)[2][2][4][2], const Unit& u, int wr, int wc, int fr, int fq, PG8_LAS unsigned char* lds, int wid, int lane) const {
        typedef float f32x2v __attribute__((ext_vector_type(2)));
        PG8_LAS f32x2v* P = (PG8_LAS f32x2v*)lds;
        PG8_LAS f32x2v* S = (PG8_LAS f32x2v*)(lds + 8192);
        PG8_LAS unsigned* flag = (PG8_LAS unsigned*)(lds + 8192 + 2048);
#pragma unroll
        for (int ai = 0; ai < 2; ++ai)
#pragma unroll
            for (int m = 0; m < 4; ++m) {
                float s = 0.f;
#pragma unroll
                for (int bj = 0; bj < 2; ++bj)
#pragma unroll
                    for (int n = 0; n < 2; ++n) { const f32x4 x = v[ai][bj][m][n]; s += (x[0] + x[1]) + (x[2] + x[3]); }
                s += __shfl_xor(s, 16); s += __shfl_xor(s, 32);
                const float mw = s * (1.0f / 64.0f); float q = 0.f;
#pragma unroll
                for (int bj = 0; bj < 2; ++bj)
#pragma unroll
                    for (int n = 0; n < 2; ++n) { const f32x4 d = v[ai][bj][m][n] - mw; q += (d[0] * d[0] + d[1] * d[1]) + (d[2] * d[2] + d[3] * d[3]); }
                q += __shfl_xor(q, 16); q += __shfl_xor(q, 32);
                if (fq == 0) P[(ai * HALF + wr * 64 + m * 16 + fr) * 4 + wc] = (f32x2v){mw, q};
            }
        asm volatile("s_waitcnt lgkmcnt(0)" ::: "memory"); __builtin_amdgcn_s_barrier(); asm volatile("" ::: "memory");
#if defined(BROKEN_EXCHANGE_NO_WAIT)
#warning BROKEN CONTROL BUILD: the row-statistics exchange does not wait; results are wrong by design
        if (blockIdx.x >= 64) { const long long t0_ = clock64(); while (clock64() - t0_ < 60000) __builtin_amdgcn_s_sleep(8); }
#endif
        const int row = wid * 32 + (lane & 31);
        if (lane < 32) {
            const f32x2v a = P[row * 4 + 0], b = P[row * 4 + 1], c = P[row * 4 + 2], d = P[row * 4 + 3];
            const float mt = (a.x + b.x + c.x + d.x) * 0.25f;
            const float da = a.x - mt, db = b.x - mt, dc = c.x - mt, dd = d.x - mt;
            const float m2 = (a.y + b.y) + (c.y + d.y) + 64.0f * ((da * da + db * db) + (dc * dc + dd * dd));
            unsigned long long* slot = (unsigned long long*)xbuf + ((size_t)(u.pm * BM + row) * 4 + u.pn);
            __hip_atomic_store(slot, ((unsigned long long)__float_as_uint(m2) << 32) | __float_as_uint(mt), __ATOMIC_RELAXED, __HIP_MEMORY_SCOPE_AGENT);
        }
        asm volatile("s_waitcnt vmcnt(0)" ::: "memory");
        if (lane == 0) __hip_atomic_fetch_add(cnt + 64 * u.pm, 1u, __ATOMIC_RELAXED, __HIP_MEMORY_SCOPE_AGENT);
        if (wid == 0) {
            bool dead = false; const unsigned long long t0 = __builtin_amdgcn_s_memrealtime(); const unsigned want = 8u * (unsigned)ntn;
            for (;;) {
#if defined(BROKEN_EXCHANGE_NO_WAIT)
                break;
#endif
                if ((unsigned)__builtin_amdgcn_readfirstlane(__hip_atomic_load(cnt + 64 * u.pm, __ATOMIC_RELAXED, __HIP_MEMORY_SCOPE_AGENT)) >= want) break;
                if (__builtin_amdgcn_s_memrealtime() - t0 > 2000000ull) {
                    if (lane == 0) { unsigned expect = 0u; __hip_atomic_compare_exchange_strong(tmo + 1, &expect, code | (unsigned)(u.pm & 0xff), __ATOMIC_RELAXED, __ATOMIC_RELAXED, __HIP_MEMORY_SCOPE_AGENT);
                                     __hip_atomic_store(tmo, 1u, __ATOMIC_RELAXED, __HIP_MEMORY_SCOPE_AGENT); }
                    dead = true; break; }
                __builtin_amdgcn_s_sleep(2);
            }
            __builtin_amdgcn_fence(__ATOMIC_ACQUIRE, "agent");
            if (lane == 0) flag[0] = dead ? 1u : 0u;
        }
        asm volatile("s_waitcnt vmcnt(0) lgkmcnt(0)" ::: "memory"); __builtin_amdgcn_s_barrier(); asm volatile("" ::: "memory");
        const bool bad = flag[0] != 0u;
        if (lane < 32) {
            const unsigned long long* slot = (const unsigned long long*)xbuf + (size_t)(u.pm * BM + row) * 4; float mt[4], m2[4]; float ms = 0.f;
#pragma unroll
            for (int t = 0; t < 4; ++t) { if (t < ntn) { const unsigned long long w = __hip_atomic_load(slot + t, __ATOMIC_RELAXED, __HIP_MEMORY_SCOPE_AGENT); mt[t] = __uint_as_float((unsigned)w); m2[t] = __uint_as_float((unsigned)(w >> 32)); } else { mt[t] = 0.f; m2[t] = 0.f; } ms += mt[t]; }
            const float mean = ms / (float)ntn; float q = 0.f;
#pragma unroll
            for (int t = 0; t < 4; ++t) if (t < ntn) { const float dm = mt[t] - mean; q += m2[t] + 256.0f * dm * dm; }
            S[row] = (f32x2v){mean, 1.0f / sqrtf(q / (256.0f * (float)ntn) + eps)};
        }
        asm volatile("s_waitcnt lgkmcnt(0)" ::: "memory"); __builtin_amdgcn_s_barrier(); asm volatile("" ::: "memory");
        return bad;
    }
};
struct EpiLnRes {
    static constexpr bool PERM = false, AFTER_DRAIN = true;
    const float* base; float* out; int ldc; const float* bias; PanelStats st; unsigned poison;
    __device__ __forceinline__ void fused(f32x4 (&acc)[2][2][4][2], const Unit& u, int wr, int wc, int fr, int fq, PG8_LAS unsigned char* lds, int wid, int lane) const {
        typedef float f32x2v __attribute__((ext_vector_type(2)));
        const PG8_LAS f32x2v* S = (const PG8_LAS f32x2v*)(lds + 8192);
        const int col0 = u.pn * BM + wc * 32 + 4 * fq;
#pragma unroll
        for (int bj = 0; bj < 2; ++bj)
#pragma unroll
            for (int n = 0; n < 2; ++n) { const f32x4 bv = bias ? *(const f32x4*)(bias + col0 + bj * HALF + n * 16) : (f32x4){0.f, 0.f, 0.f, 0.f};
#pragma unroll
                for (int ai = 0; ai < 2; ++ai)
#pragma unroll
                    for (int m = 0; m < 4; ++m) acc[ai][bj][m][n] += bv; }
        f32x4 pre[4][2][2];
#pragma unroll
        for (int m = 0; m < 4; ++m) { const size_t off = (size_t)(u.pm * BM + wr * 64 + m * 16 + fr) * ldc + col0;
#pragma unroll
            for (int bj = 0; bj < 2; ++bj)
#pragma unroll
                for (int n = 0; n < 2; ++n) pre[m][bj][n] = *(const f32x4*)(base + off + bj * HALF + n * 16); }
        const bool bad = st.run(acc, u, wr, wc, fr, fq, lds, wid, lane) || poison != 0u;
        const float qnan = __builtin_nanf("");
#pragma unroll
        for (int ai = 0; ai < 2; ++ai)
#pragma unroll
            for (int m = 0; m < 4; ++m) { const int r = ai * HALF + wr * 64 + m * 16 + fr; const f32x2v sr = S[r]; const size_t off = (size_t)(u.pm * BM + r) * ldc + col0;
#pragma unroll
                for (int bj = 0; bj < 2; ++bj)
#pragma unroll
                    for (int n = 0; n < 2; ++n) { const f32x4 bs = ai == 0 ? pre[m][bj][n] : *(const f32x4*)(base + off + bj * HALF + n * 16); f32x4 o = bs + (acc[ai][bj][m][n] - sr.x) * sr.y;
                        if (bad) o = (f32x4){qnan, qnan, qnan, qnan}; *(f32x4*)(out + off + bj * HALF + n * 16) = o; }
                if (m & 1) asm volatile("" ::: "memory"); }
    }
};
struct EpiLnResLn {
    static constexpr bool PERM = false, AFTER_DRAIN = true;
    const float* base; float* out; bf16_t* xn; int ldc; const float* bias; PanelStats st1, st2; unsigned poison;
    __device__ __forceinline__ void fused(f32x4 (&acc)[2][2][4][2], const Unit& u, int wr, int wc, int fr, int fq, PG8_LAS unsigned char* lds, int wid, int lane) const {
        typedef float f32x2v __attribute__((ext_vector_type(2))); typedef unsigned u32x2v __attribute__((ext_vector_type(2)));
        const PG8_LAS f32x2v* S = (const PG8_LAS f32x2v*)(lds + 8192);
        const int col0 = u.pn * BM + wc * 32 + 4 * fq;
#pragma unroll
        for (int bj = 0; bj < 2; ++bj)
#pragma unroll
            for (int n = 0; n < 2; ++n) { const f32x4 bv = bias ? *(const f32x4*)(bias + col0 + bj * HALF + n * 16) : (f32x4){0.f, 0.f, 0.f, 0.f};
#pragma unroll
                for (int ai = 0; ai < 2; ++ai)
#pragma unroll
                    for (int m = 0; m < 4; ++m) acc[ai][bj][m][n] += bv; }
        bool bad = st1.run(acc, u, wr, wc, fr, fq, lds, wid, lane) || poison != 0u;
        const float qnan = __builtin_nanf("");
#pragma unroll
        for (int ai = 0; ai < 2; ++ai)
#pragma unroll
            for (int m = 0; m < 4; ++m) { const int r = ai * HALF + wr * 64 + m * 16 + fr; const f32x2v sr = S[r]; const size_t off = (size_t)(u.pm * BM + r) * ldc + col0;
#pragma unroll
                for (int bj = 0; bj < 2; ++bj)
#pragma unroll
                    for (int n = 0; n < 2; ++n) { const f32x4 bs = *(const f32x4*)(base + off + bj * HALF + n * 16); acc[ai][bj][m][n] = bs + (acc[ai][bj][m][n] - sr.x) * sr.y; }
                asm volatile("" : "+v"(acc[ai][0][m][0]), "+v"(acc[ai][0][m][1]), "+v"(acc[ai][1][m][0]), "+v"(acc[ai][1][m][1]));
                if (m & 1) asm volatile("" ::: "memory"); }
        const bool bad1 = bad;
        bad = st2.run(acc, u, wr, wc, fr, fq, lds, wid, lane) || bad;
#pragma unroll
        for (int ai = 0; ai < 2; ++ai)
#pragma unroll
            for (int m = 0; m < 4; ++m) { const int r = ai * HALF + wr * 64 + m * 16 + fr; const f32x2v sr = S[r]; const size_t off = (size_t)(u.pm * BM + r) * ldc + col0;
#pragma unroll
                for (int bj = 0; bj < 2; ++bj)
#pragma unroll
                    for (int n = 0; n < 2; ++n) { const f32x4 x1 = acc[ai][bj][m][n]; *(f32x4*)(out + off + bj * HALF + n * 16) = bad1 ? (f32x4){qnan, qnan, qnan, qnan} : x1;
                        const f32x4 o = (x1 - sr.x) * sr.y; u32x2v w; w.x = cvt_pk_bf16(o[0], o[1]); w.y = cvt_pk_bf16(o[2], o[3]);
                        if (bad) { w.x = 0x7fc07fc0u; w.y = 0x7fc07fc0u; } *(u32x2v*)(xn + off + bj * HALF + n * 16) = w; }
                asm volatile("" ::: "memory"); }
    }
};

template <class Epi, class Sched, bool ALIGN_EPI = false, bool SP2 = false>
__device__ __forceinline__ void gemm_phase(PG8_LAS unsigned char* lds, const Gemm g, const Sched& S, const Epi& E, const int wave_in  ) {
    int tid_o; asm volatile("v_mbcnt_lo_u32_b32 %0, -1, 0\n\tv_mbcnt_hi_u32_b32 %0, -1, %0" : "=v"(tid_o)); tid_o += wave_in * 64; asm volatile("" : "+v"(tid_o));
    const int tid = tid_o, wid = __builtin_amdgcn_readfirstlane(tid >> 6), lane = tid & 63, wr = wid >> 2, wc = wid & 3, fr = lane & 15, fq = lane >> 4;
    const int K = g.K, nt = K / BK, lda = g.lda ? g.lda : K;
    unsigned voffA[2], voffB[2];
#pragma unroll
    for (int i = 0; i < 2; ++i) { int R, C; stage_rc(tid * 16 + i * 8192, R, C); const int Rb = Epi::PERM ? ((R & ~31) + perm32(R & 31)) : R;
        voffA[i] = (unsigned)(R * lda + C) * 2u; voffB[i] = (unsigned)(Rb * K + C) * 2u; }
    const size_t kstep = (size_t)(BK * 2);
    const size_t hstep = (size_t)HALF * K * 2;
    const size_t hstepA = (size_t)HALF * lda * 2, tstepA = 2 * hstepA;
    const size_t tstep = 2 * hstep;
    const unsigned ldsw = (unsigned)wid * 1024u;
    const int aoff = lds_byte(wr * 64 + fr, fq * 8), boff = lds_byte(wc * 32 + fr, fq * 8);
#define PG8_SA(b, h) (((b) * 2 + (h)) * HTB)
#define PG8_SB(b, h) ((4 + (b) * 2 + (h)) * HTB)
#define PG8_STAGE(bufoff, gbase, voff) do { _Pragma("unroll") for (int _i = 0; _i < 2; ++_i) { const unsigned la_ = (unsigned)(size_t)(lds + (bufoff) + ldsw + _i * 8192); \
        asm volatile("s_mov_b32 m0, %2\n\ts_nop 0\n\tglobal_load_lds_dwordx4 %0, %1" :: "v"((voff)[_i]), "s"((const char*)(gbase)), "s"(la_) : "memory", "m0"); } } while (0)
#define PG8_LDA(dst, b, h) do { _Pragma("unroll") for (int m = 0; m < 4; ++m) _Pragma("unroll") for (int k = 0; k < 2; ++k) dst[m][k] = *(const PG8_LAS bf16x8*)(lds + PG8_SA(b, h) + aoff + m * 2048 + k * 1024); } while (0)
#define PG8_LDB(dst, b, h) do { _Pragma("unroll") for (int n = 0; n < 2; ++n) _Pragma("unroll") for (int k = 0; k < 2; ++k) dst[n][k] = *(const PG8_LAS bf16x8*)(lds + PG8_SB(b, h) + boff + n * 2048 + k * 1024); } while (0)
#define PG8_MMA(ai, bj, At, Bt) do { __builtin_amdgcn_s_setprio(1); _Pragma("unroll") for (int m = 0; m < 4; ++m) _Pragma("unroll") for (int n = 0; n < 2; ++n) _Pragma("unroll") for (int k = 0; k < 2; ++k) \
        acc[ai][bj][m][n] = __builtin_amdgcn_mfma_f32_16x16x32_bf16(Bt[n][k], At[m][k], acc[ai][bj][m][n], 0, 0, 0); __builtin_amdgcn_s_setprio(0); } while (0)
#define PG8_WAIT_V(n) asm volatile("s_waitcnt vmcnt(" #n ")" ::: "memory")
#define PG8_WAIT_REL(st) asm volatile("s_waitcnt vmcnt(%1)\n\ts_cmp_eq_u32 %0, 0\n\ts_cbranch_scc1 .Lpg8rel%=\n\ts_waitcnt vmcnt(8)\n.Lpg8rel%=:" :: "s"(st), "n"(8 + Epi::EPI_VMEM) : "memory", "scc")
#define PG8_WAIT_L(n) asm volatile("s_waitcnt lgkmcnt(" #n ")" ::: "memory")
#define PG8_BAR __builtin_amdgcn_s_barrier()
#define PG8_SCHED __builtin_amdgcn_sched_barrier(0)
    Unit cur, nxt; int ui = 0;
    if (!S.next(0, cur)) return;
    f32x4 acc[2][2][4][2];
#pragma unroll
    for (int a = 0; a < 2; ++a)
#pragma unroll
        for (int b = 0; b < 2; ++b)
#pragma unroll
            for (int m = 0; m < 4; ++m)
#pragma unroll
                for (int n = 0; n < 2; ++n) acc[a][b][m][n] = (f32x4){0.f, 0.f, 0.f, 0.f};
    bf16x8 At[4][2], B0[2][2], B1[2][2];
    const char* cA = (const char*)g.A + (size_t)cur.pm * tstepA; const char* cB = (const char*)g.Bt + (size_t)cur.pn * tstep;
    S.a_ready(cur);
    if constexpr (SP2) {
        PG8_STAGE(PG8_SB(0, 0), cB, voffB); PG8_STAGE(PG8_SB(0, 1), cB + hstep, voffB); PG8_STAGE(PG8_SA(0, 0), cA, voffA); PG8_STAGE(PG8_SA(0, 1), cA + hstepA, voffA);
        if (wr == 1) PG8_BAR;
        PG8_WAIT_V(2); PG8_BAR;
        PG8_STAGE(PG8_SB(1, 0), cB + kstep, voffB); PG8_STAGE(PG8_SA(1, 0), cA + kstep, voffA); PG8_STAGE(PG8_SB(1, 1), cB + hstep + kstep, voffB);
        PG8_WAIT_V(6); PG8_BAR;
    } else {
        PG8_STAGE(PG8_SB(0, 0), cB, voffB); PG8_STAGE(PG8_SA(0, 0), cA, voffA); PG8_STAGE(PG8_SB(0, 1), cB + hstep, voffB); PG8_STAGE(PG8_SA(0, 1), cA + hstepA, voffA);
        if (wr == 1) PG8_BAR;
        PG8_WAIT_V(4); PG8_BAR;
        PG8_STAGE(PG8_SB(1, 0), cB + kstep, voffB); PG8_STAGE(PG8_SA(1, 0), cA + kstep, voffA); PG8_STAGE(PG8_SB(1, 1), cB + hstep + kstep, voffB);
        PG8_WAIT_V(6); PG8_BAR;
    }
    for (;;) {
        const bool has_next = S.next(ui + 1, nxt);
        const char* nA = has_next ? (const char*)g.A + (size_t)nxt.pm * tstepA : cA; const char* nB = has_next ? (const char*)g.Bt + (size_t)nxt.pn * tstep : cB;
        for (int t = 0; t < nt; t += 2) {
            const bool last = (t == nt - 2);
            const char* a1 = cA + (size_t)(t + 1) * kstep;
            const char* a2 = last ? nA : cA + (size_t)(t + 2) * kstep; const char* b2 = last ? nB : cB + (size_t)(t + 2) * kstep;
            const char* a3 = a2 + kstep; const char* b3 = b2 + kstep;
            if (last && has_next) S.a_ready(nxt);
            const int strict = __builtin_amdgcn_readfirstlane(t | (ui == 0 ? 1 : 0));
            if constexpr (SP2) {
            PG8_LDB(B0, 0, 0); PG8_LDB(B1, 0, 1); PG8_SCHED; PG8_LDA(At, 0, 0); PG8_STAGE(PG8_SA(1, 1), a1 + hstepA, voffA);
            PG8_WAIT_REL(strict); PG8_WAIT_L(0); PG8_BAR; PG8_MMA(0, 0, At, B0); PG8_MMA(0, 1, At, B1); PG8_BAR; PG8_SCHED;
            PG8_LDA(At, 0, 1); PG8_STAGE(PG8_SB(0, 0), b2, voffB); PG8_STAGE(PG8_SB(0, 1), b2 + hstep, voffB); PG8_STAGE(PG8_SA(0, 0), a2, voffA);
            PG8_WAIT_REL(strict); PG8_WAIT_L(0); PG8_BAR; PG8_MMA(1, 0, At, B0); PG8_MMA(1, 1, At, B1); PG8_BAR; PG8_SCHED;
            PG8_LDB(B0, 1, 0); PG8_LDB(B1, 1, 1); PG8_SCHED; PG8_LDA(At, 1, 0); PG8_STAGE(PG8_SA(0, 1), a2 + hstepA, voffA);
            PG8_WAIT_V(8); PG8_WAIT_L(0); PG8_BAR; PG8_MMA(0, 0, At, B0); PG8_MMA(0, 1, At, B1); PG8_BAR; PG8_SCHED;
            PG8_LDA(At, 1, 1); PG8_STAGE(PG8_SB(1, 0), b3, voffB); PG8_STAGE(PG8_SB(1, 1), b3 + hstep, voffB); PG8_STAGE(PG8_SA(1, 0), a3, voffA);
            PG8_WAIT_V(8); PG8_WAIT_L(0); PG8_BAR; PG8_MMA(1, 0, At, B0); PG8_MMA(1, 1, At, B1); PG8_BAR; PG8_SCHED;
            if constexpr (Epi::MID_KT > 0) { if (t + 2 == Epi::MID_KT) { E.mid(acc, cur, wr, wc, fr, fq); PG8_SCHED; } }
            } else {
            PG8_LDB(B0, 0, 0); PG8_SCHED; PG8_LDA(At, 0, 0); PG8_STAGE(PG8_SA(1, 1), a1 + hstepA, voffA);
            PG8_WAIT_L(8); PG8_BAR; PG8_WAIT_L(0); PG8_MMA(0, 0, At, B0); PG8_BAR; PG8_SCHED;
            PG8_LDB(B1, 0, 1); PG8_STAGE(PG8_SB(0, 0), b2, voffB);
            PG8_BAR; PG8_WAIT_L(0); PG8_MMA(0, 1, At, B1); PG8_BAR;
            PG8_LDA(At, 0, 1); PG8_STAGE(PG8_SA(0, 0), a2, voffA);
            PG8_BAR; PG8_WAIT_L(0); PG8_MMA(1, 0, At, B0); PG8_BAR; PG8_SCHED;
            PG8_STAGE(PG8_SB(0, 1), b2 + hstep, voffB);
            PG8_WAIT_V(6); PG8_BAR; PG8_MMA(1, 1, At, B1); PG8_BAR;
            PG8_LDB(B0, 1, 0); PG8_SCHED; PG8_LDA(At, 1, 0); PG8_STAGE(PG8_SA(0, 1), a2 + hstepA, voffA);
            PG8_WAIT_L(8); PG8_BAR; PG8_WAIT_L(0); PG8_MMA(0, 0, At, B0); PG8_BAR; PG8_SCHED;
            PG8_LDB(B1, 1, 1); PG8_STAGE(PG8_SB(1, 0), b3, voffB);
            PG8_BAR; PG8_WAIT_L(0); PG8_MMA(0, 1, At, B1); PG8_BAR;
            PG8_LDA(At, 1, 1); PG8_STAGE(PG8_SA(1, 0), a3, voffA);
            PG8_BAR; PG8_WAIT_L(0); PG8_MMA(1, 0, At, B0); PG8_BAR; PG8_SCHED;
            PG8_STAGE(PG8_SB(1, 1), b3 + hstep, voffB);
            PG8_WAIT_V(6); PG8_BAR; PG8_MMA(1, 1, At, B1); PG8_BAR;
            }
        }
        if constexpr (ALIGN_EPI) { if (wr == 0) PG8_BAR; }
        if constexpr (!Epi::AFTER_DRAIN) { E(acc, cur, wr, wc, fr, fq); S.done(cur); }
        if (!has_next) break;
#pragma unroll
        for (int a = 0; a < 2; ++a)
#pragma unroll
            for (int b = 0; b < 2; ++b)
#pragma unroll
                for (int m = 0; m < 4; ++m)
#pragma unroll
                    for (int n = 0; n < 2; ++n) acc[a][b][m][n] = (f32x4){0.f, 0.f, 0.f, 0.f};
        cur = nxt; cA = nA; cB = nB; ++ui;
        if constexpr (ALIGN_EPI) { if (wr == 1) PG8_BAR; }
    }
    PG8_WAIT_V(0);
    if constexpr (!ALIGN_EPI) { if (wr == 0) PG8_BAR; }
    PG8_BAR;
    if constexpr (Epi::AFTER_DRAIN) { E.fused(acc, cur, wr, wc, fr, fq, lds, wid, lane); S.done(cur); }
#undef PG8_SA
#undef PG8_SB
#undef PG8_STAGE
#undef PG8_LDA
#undef PG8_LDB
#undef PG8_MMA
#undef PG8_WAIT_V
#undef PG8_WAIT_REL
#undef PG8_WAIT_L
#undef PG8_BAR
#undef PG8_SCHED
}
}
#define GAS __attribute__((address_space(1)))
#define LAS __attribute__((address_space(3)))
typedef unsigned short bf16;
typedef unsigned v4u __attribute__((ext_vector_type(4)));
typedef float f32x4 __attribute__((ext_vector_type(4)));
typedef short bf16x8 __attribute__((ext_vector_type(8)));
typedef GAS unsigned gu32;
typedef GAS unsigned long long gu64;
#define RLX_AGENT __ATOMIC_RELAXED, __HIP_MEMORY_SCOPE_AGENT
#define LDS_WAIT() asm volatile("s_waitcnt lgkmcnt(0)" ::: "memory")
#define VM_WAIT() asm volatile("s_waitcnt vmcnt(0)" ::: "memory")
__device__ __forceinline__ unsigned long long rt() { return __builtin_amdgcn_s_memrealtime(); }
__device__ __forceinline__ unsigned f2bf(float f) { unsigned u = __builtin_bit_cast(unsigned, f); return (u + 0x7fffu + ((u >> 16) & 1u)) >> 16; }
__device__ __forceinline__ unsigned pk2(float lo, float hi) { return f2bf(lo) | (f2bf(hi) << 16); }

#define XB_TMO      128
#define XB_XCNT(j)  (256  + 64 * (j))
#define XB_XSUB(j)  (1280 + 64 * (j))
#define XB_XGEN(j)  (2304 + 64 * (j))
#define XB_TOP      3328
#define XB_TOPGEN   3392
#define XCD_BAR_WORDS 3456
#define XB_SPIN_CAP (1u << 18)

__device__ __forceinline__ unsigned xb_ld(unsigned* p)              { return __hip_atomic_load(p, __ATOMIC_RELAXED, __HIP_MEMORY_SCOPE_AGENT); }
__device__ __forceinline__ unsigned xb_add(unsigned* p, unsigned v) { return __hip_atomic_fetch_add(p, v, __ATOMIC_RELAXED, __HIP_MEMORY_SCOPE_AGENT); }
__device__ __forceinline__ unsigned xb_xcc_id() { return (unsigned)__builtin_amdgcn_s_getreg((3 << 11) | 20) & 0xFu; }
#define XB_SPIN(cond, bar) do { unsigned _sp = 0; while (cond) { __builtin_amdgcn_s_sleep(1); \
    if ((++_sp & 255u) == 0u) { if (xb_ld(&(bar)[XB_TMO])) break; if (_sp > XB_SPIN_CAP) { atomicAdd(&(bar)[XB_TMO], 1u); break; } } } } while (0)

struct XcdBarrier {
    unsigned* bar; unsigned x;
    volatile LAS unsigned* st;
};

__device__ __forceinline__ XcdBarrier xcd_barrier_post(unsigned* bar, volatile LAS unsigned* st) {
    XcdBarrier b; b.bar = bar; b.x = xb_xcc_id(); b.st = st;
    if (threadIdx.x == 0) (void)xb_add(&bar[XB_XCNT(b.x)], 1u);
    return b;
}
__device__ __forceinline__ void xcd_barrier_complete(unsigned* bar, unsigned x, unsigned& nloc, unsigned& nx) {
    const unsigned G = gridDim.x * gridDim.y * gridDim.z;
    unsigned sum, cnt, mine, sp = 0u;
    for (;;) {
        sum = 0u; cnt = 0u; mine = 0u;
#pragma unroll
        for (unsigned j = 0; j < 16; ++j) { const unsigned c = xb_ld(&bar[XB_XCNT(j)]); sum += c; cnt += (c > 0u) ? 1u : 0u; mine = (j == x) ? c : mine; }
        if (sum == G) break;
        __builtin_amdgcn_s_sleep(1);
        if ((++sp & 255u) == 0u) { if (xb_ld(&bar[XB_TMO])) break; if (sp > XB_SPIN_CAP) { atomicAdd(&bar[XB_TMO], 1u); break; } }
    }
    nloc = mine > 0u ? mine : 1u; nx = cnt > 0u ? cnt : 1u;
}

__device__ __forceinline__ void xcd_barrier(const XcdBarrier& b, const bool thread0  ) {
    asm volatile("s_waitcnt vmcnt(0)" ::: "memory");
    __syncthreads();
    if (thread0) {
        unsigned* bar = b.bar;
        __builtin_amdgcn_s_waitcnt(0);
        unsigned nloc = b.st[0], nx = b.st[1];
        if (nloc == 0u) { xcd_barrier_complete(bar, b.x, nloc, nx); b.st[0] = nloc; b.st[1] = nx; }
        const unsigned old = xb_add(&bar[XB_XSUB(b.x)], 1u);
        const unsigned gen = old / nloc;
        if (old + 1u == (gen + 1u) * nloc) {
            __builtin_amdgcn_fence(__ATOMIC_RELEASE, "agent");
            asm volatile("s_waitcnt vmcnt(0)" ::: "memory");
            const unsigned og = xb_add(&bar[XB_TOP], 1u);
            const unsigned tg = og / nx;
            if (og + 1u == (tg + 1u) * nx) xb_add(&bar[XB_TOPGEN], 1u);
            else XB_SPIN(xb_ld(&bar[XB_TOPGEN]) == tg, bar);
            __builtin_amdgcn_fence(__ATOMIC_ACQUIRE, "agent");
            xb_add(&bar[XB_XGEN(b.x)], 1u);
            asm volatile("s_waitcnt vmcnt(0)" ::: "memory");
        } else {
            XB_SPIN(xb_ld(&bar[XB_XGEN(b.x)]) == gen, bar);
            __builtin_amdgcn_fence(__ATOMIC_ACQUIRE, "agent");
            asm volatile("s_waitcnt vmcnt(0)" ::: "memory");
        }
    }
    __syncthreads();
}

__device__ __forceinline__ void xcd_local_barrier(const XcdBarrier& b, const bool thread0) {
    asm volatile("s_waitcnt vmcnt(0)" ::: "memory");
    __syncthreads();
    if (thread0) {
        unsigned* bar = b.bar;
        __builtin_amdgcn_s_waitcnt(0);
        unsigned nloc = b.st[0]; if (nloc == 0u) nloc = 1u;
        const unsigned old = xb_add(&bar[XB_XSUB(b.x)], 1u);
        const unsigned gen = old / nloc;
        if (old + 1u == (gen + 1u) * nloc) xb_add(&bar[XB_XGEN(b.x)], 1u);
        else XB_SPIN(xb_ld(&bar[XB_XGEN(b.x)]) == gen, bar);
        __builtin_amdgcn_fence(__ATOMIC_ACQUIRE, "agent");
        asm volatile("s_waitcnt vmcnt(0)" ::: "memory");
    }
    __syncthreads();
}

#ifndef PH_MASK
#define PH_MASK 0x3ff
#endif
#define PH(n) ((PH_MASK >> (n)) & 1)
__device__ __forceinline__ int lane_now() { int l; asm volatile("v_mbcnt_lo_u32_b32 %0, -1, 0\n\tv_mbcnt_hi_u32_b32 %0, -1, %0" : "=v"(l)); return l; }
#define TID_NOW() (wave * 64 + lane_now())
#define GRID_BAR() do { XcdBarrier b2_ = bar; asm volatile("" : "+s"(b2_.x)); xcd_barrier(b2_, TID_NOW() == 0); } while (0)
#define LOCAL_BAR() do { XcdBarrier b2_ = bar; asm volatile("" : "+s"(b2_.x)); const unsigned mb_ = __builtin_amdgcn_readfirstlane(__hip_atomic_load(ctl + CW_MAP, RLX_AGENT)); \
    if (mb_ == 0u) xcd_local_barrier(b2_, TID_NOW() == 0); else xcd_barrier(b2_, TID_NOW() == 0); } while (0)
#define PHASE_IDS() int tid__ = TID_NOW(); asm volatile("" : "+v"(tid__)); const int tid = tid__, lane = tid & 63; (void)tid; (void)lane
#ifndef PROBE_DUP
#define PROBE_DUP 0
#endif
#ifndef P0SUB
#define P0SUB 7
#endif
constexpr int NWAVES = 8;
constexpr int BATCH = 16, SEQ = 4096, DM = 1024, M = BATCH * SEQ;
constexpr int INW = 9744;
constexpr int C_GQ = 4608, C_GLR = 7680, C_GA = 7696;
constexpr int NA = 4608, NB = 5120, NGLA = 3072, NGATE = 2048, FFH = 2816, NFF = 5632, AOW = 512;
constexpr float EPS = 1e-6f;
constexpr float QSCALE = 0.08838834764831845f * 1.4426950408889634f;
constexpr float GLA_QS = 0.08838834764831845f;

constexpr size_t MiB = 1u << 20;
constexpr size_t WS_CTL = 0, CTL_ZERO_BYTES = 1 * MiB;
constexpr int CW_TMO = 0, CW_MAP = 64, CW_BAR = 4096;
constexpr size_t WS_SSQ1 = 256 * 1024, WS_SSQ2 = 512 * 1024;
constexpr size_t WS_ROPE = 1 * MiB;
constexpr size_t WS_GLR = 2 * MiB;
constexpr size_t WS_WB = 6 * MiB, WS_WA = 16 * MiB, WS_WBA = 25 * MiB, WS_WBB = 26 * MiB, WS_WOUT = 28 * MiB, WS_WFF = 30 * MiB, WS_WDN = 41 * MiB;
constexpr size_t WS_H = 48 * MiB;
constexpr size_t WS_CAT = 176 * MiB;
constexpr size_t WS_BIG = 368 * MiB;
constexpr size_t WS_MIX = 368 * MiB, WS_X1B = 496 * MiB, WS_ACT = 624 * MiB;
constexpr size_t WS_OG01 = 48 * MiB, WS_OG2 = 944 * MiB, WS_ML = 1008 * MiB;
constexpr size_t WS_SLOC = 752 * MiB, WS_LOGD = 784 * MiB;
constexpr size_t WS_END = 1024 * MiB;
static_assert(WS_CAT + (size_t)M * 1536 * 2 <= WS_BIG && WS_BIG + (size_t)M * NA * 2 <= WS_OG2 && WS_ACT + (size_t)M * FFH * 2 <= WS_END && WS_BIG + (size_t)M * NGLA * 2 <= WS_SLOC, "ws map");

constexpr int RING_OFF = 0, RING_BYTES = 131072;
constexpr int LDSCTL_OFF = RING_BYTES, MISC_OFF = LDSCTL_OFF + 320;
constexpr int LDS_BYTES = 147456;

#define ST16_S(sbase, voff, data, IMM) asm volatile("global_store_dwordx4 %0, %1, %2 offset:" #IMM "\n\ts_nop 4" :: "v"(voff), "v"(data), "s"(sbase) : "memory")
__device__ __forceinline__ float bf2f(unsigned short b) { return __builtin_bit_cast(float, (unsigned)b << 16); }
__device__ __forceinline__ float bflo(unsigned w) { return __builtin_bit_cast(float, w << 16); }
__device__ __forceinline__ float bfhi(unsigned w) { return __builtin_bit_cast(float, w & 0xffff0000u); }
__device__ __forceinline__ float wave_sum(float v) {
#pragma unroll
    for (int o = 1; o < 64; o <<= 1) v += __shfl_xor(v, o);
    return v;
}
__device__ __forceinline__ float wave_max(float v) {
#pragma unroll
    for (int o = 1; o < 64; o <<= 1) v = fmaxf(v, __shfl_xor(v, o));
    return v;
}
#define WG_BAR() do { asm volatile("s_waitcnt lgkmcnt(0)" ::: "memory"); __builtin_amdgcn_s_barrier(); asm volatile("" ::: "memory"); } while (0)
__device__ __forceinline__ float sigmoidf_(float v) { return 1.0f / (1.0f + __expf(-v)); }

namespace pg8 {
struct EpiB {
    static constexpr bool PERM = true, AFTER_DRAIN = false; static constexpr int MID_KT = 0, EPI_VMEM = 16;
    bf16_t* __restrict__ G; bf16_t* __restrict__ GRp; bf16_t* __restrict__ GSp;
    __device__ __forceinline__ void operator()(const f32x4 (&acc)[2][2][4][2], const Unit& u, int wr, int wc, int fr, int fq) const {
        const int row0 = u.pm * BM + wr * 64 + fr; const int colt = u.pn * BM; constexpr float L2E = 1.4426950408889634f;
        if (colt >= 3072) {
            const int j0 = ((colt - 3072) >> 1) + wc * 32 + 8 * fq;
#pragma unroll
            for (int ai = 0; ai < 2; ++ai)
#pragma unroll
                for (int m = 0; m < 4; ++m) { const unsigned off = (unsigned)((row0 + ai * HALF + m * 16) * 1024 + j0) * 2u; float rv[8], sv[8];
#pragma unroll
                    for (int n = 0; n < 2; ++n)
#pragma unroll
                        for (int e = 0; e < 4; ++e) { const float ga = acc[ai][0][m][n][e], gb = fmaxf(acc[ai][1][m][n][e], -30.0f);
                            const float ea = __builtin_amdgcn_exp2f(-L2E * ga), eb = __builtin_amdgcn_exp2f(-L2E * gb);
                            sv[4 * n + e] = __builtin_amdgcn_rcpf(1.0f + eb); rv[4 * n + e] = (1.0f + eb) * __builtin_amdgcn_rcpf(1.0f + ea); }
                    u32x4 w; w.x = cvt_pk_bf16(rv[0], rv[1]); w.y = cvt_pk_bf16(rv[2], rv[3]); w.z = cvt_pk_bf16(rv[4], rv[5]); w.w = cvt_pk_bf16(rv[6], rv[7]); *(u32x4*)((char*)GRp + off) = w;
                    u32x4 w2; w2.x = cvt_pk_bf16(sv[0], sv[1]); w2.y = cvt_pk_bf16(sv[2], sv[3]); w2.z = cvt_pk_bf16(sv[4], sv[5]); w2.w = cvt_pk_bf16(sv[6], sv[7]); *(u32x4*)((char*)GSp + off) = w2; }
            return; }
        bf16_t* base = G + colt; const int col0 = wc * 32 + 8 * fq;
#pragma unroll
        for (int ai = 0; ai < 2; ++ai)
#pragma unroll
            for (int m = 0; m < 4; ++m) { const unsigned rowo = (unsigned)((row0 + ai * HALF + m * 16) * 3072 + col0) * 2u;
#pragma unroll
                for (int bj = 0; bj < 2; ++bj) { f32x4 v0 = acc[ai][bj][m][0], v1 = acc[ai][bj][m][1];
                    if (colt >= 2048) {
#pragma unroll
                        for (int e = 0; e < 4; ++e) { v0[e] = v0[e] * __builtin_amdgcn_rcpf(1.0f + __builtin_amdgcn_exp2f(-L2E * v0[e])); v1[e] = v1[e] * __builtin_amdgcn_rcpf(1.0f + __builtin_amdgcn_exp2f(-L2E * v1[e])); } }
                    else if (colt < 512) { v0 = v0 * GLA_QS; v1 = v1 * GLA_QS; }
                    u32x4 w; w.x = cvt_pk_bf16(v0[0], v0[1]); w.y = cvt_pk_bf16(v0[2], v0[3]); w.z = cvt_pk_bf16(v1[0], v1[1]); w.w = cvt_pk_bf16(v1[2], v1[3]);
                    *(u32x4*)((char*)base + (rowo + (unsigned)(bj * HALF * 2))) = w; } }
    }
};
struct EpiA {
    static constexpr bool PERM = true, AFTER_DRAIN = false; static constexpr int MID_KT = 0, EPI_VMEM = 16;
    bf16_t* __restrict__ O; const float* __restrict__ rope; float qsc;
    __device__ __forceinline__ void operator()(const f32x4 (&acc)[2][2][4][2], const Unit& u, int wr, int wc, int fr, int fq) const {
        const int row0 = u.pm * BM + wr * 64 + fr; const int colt = u.pn * BM;
        const int col0 = colt + wc * 32 + 8 * fq;
        const bool dorope = (colt < 3072) && (wc == 0);
        const float sc = (colt < 1536) ? qsc : 1.0f;
        f32x4 csv[2][4], snv[2][4];
        if (dorope) {
#pragma unroll
            for (int ai = 0; ai < 2; ++ai)
#pragma unroll
                for (int m = 0; m < 4; ++m) { const float* tp = rope + (size_t)((row0 + ai * HALF + m * 16) & (SEQ_MASK)) * 32 + 4 * fq; csv[ai][m] = *(const f32x4*)tp; snv[ai][m] = *(const f32x4*)(tp + 16); } }
#pragma unroll
        for (int ai = 0; ai < 2; ++ai)
#pragma unroll
            for (int m = 0; m < 4; ++m) { const int row = row0 + ai * HALF + m * 16; const unsigned rowo = (unsigned)(row * 4608 + col0) * 2u;
                f32x4 cs = {1.f, 1.f, 1.f, 1.f}, sn = {0.f, 0.f, 0.f, 0.f};
                if (dorope) { cs = csv[ai][m]; sn = snv[ai][m]; }
#pragma unroll
                for (int bj = 0; bj < 2; ++bj) { f32x4 v0 = acc[ai][bj][m][0], v1 = acc[ai][bj][m][1];
                    if (dorope) {
                        f32x4 a, b;
                        a[0] = v0[0] * cs[0] - v0[1] * sn[0]; a[1] = v0[1] * cs[0] + v0[0] * sn[0];
                        a[2] = v0[2] * cs[1] - v0[3] * sn[1]; a[3] = v0[3] * cs[1] + v0[2] * sn[1];
                        b[0] = v1[0] * cs[2] - v1[1] * sn[2]; b[1] = v1[1] * cs[2] + v1[0] * sn[2];
                        b[2] = v1[2] * cs[3] - v1[3] * sn[3]; b[3] = v1[3] * cs[3] + v1[2] * sn[3];
                        v0 = a; v1 = b; }
                    v0 = v0 * sc; v1 = v1 * sc;
                    u32x4 w; w.x = cvt_pk_bf16(v0[0], v0[1]); w.y = cvt_pk_bf16(v0[2], v0[3]); w.z = cvt_pk_bf16(v1[0], v1[1]); w.w = cvt_pk_bf16(v1[2], v1[3]);
                    *(u32x4*)((char*)O + (rowo + (unsigned)(bj * HALF * 2))) = w; } }
    }
    static constexpr int SEQ_MASK = 4095;
};
struct EpiMixF {
    static constexpr bool PERM = true, AFTER_DRAIN = false; static constexpr int MID_KT = 8, EPI_VMEM = 16;
    const bf16_t* __restrict__ GRp; const bf16_t* __restrict__ GSp; bf16_t* __restrict__ O;
    template <bool FINAL> __device__ __forceinline__ void run(f32x4 (&acc)[2][2][4][2], const Unit& u, int wr, int wc, int fr, int fq) const {
        const int row0 = u.pm * BM + wr * 64 + fr; const int col0 = u.pn * BM + wc * 32 + 8 * fq; const bf16_t* gp = FINAL ? GSp : GRp;
        constexpr int MB = FINAL ? 4 : 4;
#pragma unroll
        for (int ai = 0; ai < 2; ++ai)
#pragma unroll
        for (int mb = 0; mb < 4; mb += MB) {
            u32x4 gv[MB][2];
#pragma unroll
            for (int m = 0; m < MB; ++m)
#pragma unroll
                for (int bj = 0; bj < 2; ++bj) gv[m][bj] = __builtin_nontemporal_load((const u32x4*)((const char*)gp + (unsigned)((row0 + ai * HALF + (mb + m) * 16) * 1024 + col0 + bj * HALF) * 2u));
#pragma unroll
            for (int mm = 0; mm < MB; ++mm)
#pragma unroll
                for (int bj = 0; bj < 2; ++bj) { const int m = mb + mm; const u32x4 g = gv[mm][bj]; f32x4 v0 = acc[ai][bj][m][0], v1 = acc[ai][bj][m][1];
                    v0[0] *= __builtin_bit_cast(float, g.x << 16); v0[1] *= __builtin_bit_cast(float, g.x & 0xffff0000u);
                    v0[2] *= __builtin_bit_cast(float, g.y << 16); v0[3] *= __builtin_bit_cast(float, g.y & 0xffff0000u);
                    v1[0] *= __builtin_bit_cast(float, g.z << 16); v1[1] *= __builtin_bit_cast(float, g.z & 0xffff0000u);
                    v1[2] *= __builtin_bit_cast(float, g.w << 16); v1[3] *= __builtin_bit_cast(float, g.w & 0xffff0000u);
                    if (FINAL) { u32x4 w; w.x = cvt_pk_bf16(v0[0], v0[1]); w.y = cvt_pk_bf16(v0[2], v0[3]); w.z = cvt_pk_bf16(v1[0], v1[1]); w.w = cvt_pk_bf16(v1[2], v1[3]);
                        *(u32x4*)((char*)O + (unsigned)((row0 + ai * HALF + m * 16) * 1024 + col0 + bj * HALF) * 2u) = w; }
                    else { acc[ai][bj][m][0] = v0; acc[ai][bj][m][1] = v1; } } }
    }
    __device__ __forceinline__ void mid(f32x4 (&acc)[2][2][4][2], const Unit& u, int wr, int wc, int fr, int fq) const { int fr2 = fr, fq2 = fq; asm volatile("" : "+v"(fr2), "+v"(fq2));
        run<false>(acc, u, wr, wc, fr2, fq2); }
    __device__ __forceinline__ void operator()(const f32x4 (&acc)[2][2][4][2], const Unit& u, int wr, int wc, int fr, int fq) const { run<true>(const_cast<f32x4 (&)[2][2][4][2]>(acc), u, wr, wc, fr, fq); }
};
struct EpiX1 {
    static constexpr bool PERM = true, AFTER_DRAIN = false; static constexpr int MID_KT = 0, EPI_VMEM = 16;
    const float* __restrict__ base; bf16_t* __restrict__ ob; float* __restrict__ ssq;
    __device__ __forceinline__ void operator()(const f32x4 (&acc)[2][2][4][2], const Unit& u, int wr, int wc, int fr, int fq) const {
        const int row0 = u.pm * BM + wr * 64 + fr, col0 = u.pn * BM + wc * 32 + 8 * fq;
#pragma unroll
        for (int ai = 0; ai < 2; ++ai) {
            f32x4 bv[4][2][2];
#pragma unroll
            for (int m = 0; m < 4; ++m)
#pragma unroll
                for (int bj = 0; bj < 2; ++bj) { const unsigned off = (unsigned)((row0 + ai * HALF + m * 16) * 1024 + col0 + bj * HALF) * 4u; bv[m][bj][0] = __builtin_nontemporal_load((const f32x4*)((const char*)base + off)); bv[m][bj][1] = __builtin_nontemporal_load((const f32x4*)((const char*)base + (off + 16u))); }
#pragma unroll
            for (int m = 0; m < 4; ++m) { const int row = row0 + ai * HALF + m * 16; const unsigned off = (unsigned)(row * 4608 + col0) * 2u; float s = 0.f;
#pragma unroll
                for (int bj = 0; bj < 2; ++bj) { const f32x4 o0 = bv[m][bj][0] + acc[ai][bj][m][0], o1 = bv[m][bj][1] + acc[ai][bj][m][1];
                    s += (o0[0] * o0[0] + o0[1] * o0[1]) + (o0[2] * o0[2] + o0[3] * o0[3]) + (o1[0] * o1[0] + o1[1] * o1[1]) + (o1[2] * o1[2] + o1[3] * o1[3]);
                    u32x4 w; w.x = cvt_pk_bf16(o0[0], o0[1]); w.y = cvt_pk_bf16(o0[2], o0[3]); w.z = cvt_pk_bf16(o1[0], o1[1]); w.w = cvt_pk_bf16(o1[2], o1[3]);
                    *(u32x4*)((char*)ob + (off + (unsigned)(bj * HALF * 2))) = w; }
                s += __shfl_xor(s, 16); s += __shfl_xor(s, 32);
                if (fq == 0) __hip_atomic_fetch_add(ssq + row, s, __ATOMIC_RELAXED, __HIP_MEMORY_SCOPE_AGENT); } }
    }
};
struct EpiX2 {
    static constexpr bool PERM = true, AFTER_DRAIN = false; static constexpr int MID_KT = 0, EPI_VMEM = 16;
    const bf16_t* __restrict__ base; bf16_t* __restrict__ ob; float* __restrict__ ssq;
    __device__ __forceinline__ void operator()(const f32x4 (&acc)[2][2][4][2], const Unit& u, int wr, int wc, int fr, int fq) const {
        const int row0 = u.pm * BM + wr * 64 + fr, col0 = u.pn * BM + wc * 32 + 8 * fq;
#pragma unroll
        for (int ai = 0; ai < 2; ++ai) {
            u32x4 tv[4][2];
#pragma unroll
            for (int m = 0; m < 4; ++m)
#pragma unroll
                for (int bj = 0; bj < 2; ++bj) tv[m][bj] = *(const u32x4*)((const char*)base + (unsigned)((row0 + ai * HALF + m * 16) * 4608 + col0 + bj * HALF) * 2u);
#pragma unroll
            for (int m = 0; m < 4; ++m) { const int row = row0 + ai * HALF + m * 16; const unsigned off = (unsigned)(row * 1024 + col0) * 2u; float s = 0.f;
#pragma unroll
                for (int bj = 0; bj < 2; ++bj) { const u32x4 t = tv[m][bj];
                    f32x4 o0 = acc[ai][bj][m][0], o1 = acc[ai][bj][m][1];
                    o0[0] += __builtin_bit_cast(float, t.x << 16); o0[1] += __builtin_bit_cast(float, t.x & 0xffff0000u); o0[2] += __builtin_bit_cast(float, t.y << 16); o0[3] += __builtin_bit_cast(float, t.y & 0xffff0000u);
                    o1[0] += __builtin_bit_cast(float, t.z << 16); o1[1] += __builtin_bit_cast(float, t.z & 0xffff0000u); o1[2] += __builtin_bit_cast(float, t.w << 16); o1[3] += __builtin_bit_cast(float, t.w & 0xffff0000u);
                    s += (o0[0] * o0[0] + o0[1] * o0[1]) + (o0[2] * o0[2] + o0[3] * o0[3]) + (o1[0] * o1[0] + o1[1] * o1[1]) + (o1[2] * o1[2] + o1[3] * o1[3]);
                    u32x4 w; w.x = cvt_pk_bf16(o0[0], o0[1]); w.y = cvt_pk_bf16(o0[2], o0[3]); w.z = cvt_pk_bf16(o1[0], o1[1]); w.w = cvt_pk_bf16(o1[2], o1[3]);
                    *(u32x4*)((char*)ob + (off + (unsigned)(bj * HALF * 2))) = w; }
                s += __shfl_xor(s, 16); s += __shfl_xor(s, 32);
                if (fq == 0) __hip_atomic_fetch_add(ssq + row, s, __ATOMIC_RELAXED, __HIP_MEMORY_SCOPE_AGENT); } }
    }
};
struct EpiSwi {
    static constexpr bool PERM = true, AFTER_DRAIN = false; static constexpr int MID_KT = 0, EPI_VMEM = 8;
    bf16_t* __restrict__ O; const float* __restrict__ ssq;
    __device__ __forceinline__ void operator()(const f32x4 (&acc)[2][2][4][2], const Unit& u, int wr, int wc, int fr, int fq) const {
        const int row0 = u.pm * BM + wr * 64 + fr; const int col0 = u.pn * HALF + wc * 32 + 8 * fq;
        float sv[2][4];
#pragma unroll
        for (int ai = 0; ai < 2; ++ai)
#pragma unroll
            for (int m = 0; m < 4; ++m) sv[ai][m] = ssq[row0 + ai * HALF + m * 16];
#pragma unroll
        for (int ai = 0; ai < 2; ++ai)
#pragma unroll
            for (int m = 0; m < 4; ++m) { const int row = row0 + ai * HALF + m * 16; const float r = __builtin_amdgcn_rsqf(sv[ai][m] * (1.0f / 1024.0f) + EPS);
                f32x4 o[2];
#pragma unroll
                for (int n = 0; n < 2; ++n)
#pragma unroll
                    for (int e = 0; e < 4; ++e) { const float g = acc[ai][0][m][n][e] * r, uu = acc[ai][1][m][n][e] * r; o[n][e] = g * __builtin_amdgcn_rcpf(1.0f + __builtin_amdgcn_exp2f(-1.4426950408889634f * g)) * uu; }
                u32x4 w; w.x = cvt_pk_bf16(o[0][0], o[0][1]); w.y = cvt_pk_bf16(o[0][2], o[0][3]); w.z = cvt_pk_bf16(o[1][0], o[1][1]); w.w = cvt_pk_bf16(o[1][2], o[1][3]);
                *(u32x4*)((char*)O + (unsigned)(row * 4608 + col0) * 2u) = w; }
    }
};
struct EpiNull { static constexpr bool PERM = true, AFTER_DRAIN = false; static constexpr int MID_KT = 0, EPI_VMEM = 0;
    __device__ __forceinline__ void operator()(const f32x4 (&acc)[2][2][4][2], const Unit& u, int wr, int wc, int fr, int fq) const {
#pragma unroll
        for (int ai = 0; ai < 2; ++ai)
#pragma unroll
            for (int bj = 0; bj < 2; ++bj)
#pragma unroll
                for (int m = 0; m < 4; ++m) asm volatile("" :: "v"(acc[ai][bj][m][0]), "v"(acc[ai][bj][m][1])); } };
}

__device__ __forceinline__ void tr_item(const float* W, int ldw, int K, bf16* WT, int n0, int scb, bool rope, const float* kscale, int k0, LAS float* scr, int lane, int KD = 0, int koff = 0) {
    if (KD == 0) KD = K;
    float tv[32];
#pragma unroll
    for (int i = 0; i < 32; ++i) { const int kk = 2 * i + (lane >> 5); tv[i] = W[(size_t)(k0 + kk) * ldw + scb + (lane & 31)]; }
    if (kscale) {
#pragma unroll
        for (int i = 0; i < 32; ++i) tv[i] *= kscale[k0 + 2 * i + (lane >> 5)]; }
#pragma unroll
    for (int i = 0; i < 32; ++i) { const int kk = 2 * i + (lane >> 5); scr[kk * 33 + (lane & 31)] = tv[i]; }
    LDS_WAIT(); asm volatile("" ::: "memory");
    const int c = lane & 7;
#pragma unroll
    for (int j = 0; j < 4; ++j) { const int n = (lane >> 3) + 8 * j; const int sn = rope ? ((n >> 1) + 16 * (n & 1)) : n; const LAS float* s = scr + (8 * c) * 33 + sn;
        v4u o; o.x = pk2(s[0 * 33], s[1 * 33]); o.y = pk2(s[2 * 33], s[3 * 33]); o.z = pk2(s[4 * 33], s[5 * 33]); o.w = pk2(s[6 * 33], s[7 * 33]);
        *(GAS v4u*)(WT + (size_t)(n0 + n) * KD + koff + k0 + 8 * c) = o; }
    LDS_WAIT(); asm volatile("" ::: "memory");
}


typedef float f32x16 __attribute__((ext_vector_type(16)));
typedef short s16x4 __attribute__((ext_vector_type(4)));
typedef short v4i16_t __attribute__((ext_vector_type(4)));
__device__ __forceinline__ unsigned img_off(unsigned row, unsigned ch) { return 256u * row + 16u * (ch ^ (((row & 3u) << 2) | ((row >> 2) & 3u))); }
__device__ __forceinline__ unsigned img_tr_off(unsigned lane, unsigned R0, unsigned c) { const unsigned blk = (lane >> 4) & 1u, q = (lane & 15u) >> 2, p = lane & 3u; return img_off(R0 + q, 4u * c + 2u * blk + (p >> 1)) + 8u * (p & 1u); }
__device__ __forceinline__ s16x4 img_tr_read(const LAS unsigned char* p) { return __builtin_bit_cast(s16x4, __builtin_amdgcn_ds_read_tr16_b64_v4i16((LAS v4i16_t*)p)); }
constexpr int ALDS_BUF = 32768, ALDS_BYTES = 3 * ALDS_BUF;
static_assert(ALDS_BYTES <= RING_BYTES, "attention lds");
__device__ __forceinline__ unsigned cvtpk2(float lo, float hi) { unsigned r; asm volatile("v_cvt_pk_bf16_f32 %0, %1, %2" : "=v"(r) : "v"(lo), "v"(hi)); return r; }
typedef unsigned u32x2t __attribute__((ext_vector_type(2)));
__device__ __forceinline__ v4u widen_pair(u32x2t a, u32x2t b) {
    const auto r0 = __builtin_amdgcn_permlane32_swap(a.x, b.x, false, false); const auto r1 = __builtin_amdgcn_permlane32_swap(a.y, b.y, false, false);
    v4u w; w.x = r0[0]; w.y = r1[0]; w.z = r0[1]; w.w = r1[1]; return w; }
__device__ __forceinline__ void unwiden_pair(v4u L, u32x2t& a, u32x2t& b) {
    const auto r0 = __builtin_amdgcn_permlane32_swap(L.x, L.z, false, false); const auto r1 = __builtin_amdgcn_permlane32_swap(L.y, L.w, false, false);
    a.x = r0[0]; a.y = r1[0]; b.x = r0[1]; b.y = r1[1]; }
template <bool MERGE>
__device__ __forceinline__ void attn_stream(LAS unsigned char* lds, const bf16* PA, bf16* OG01, bf16* OG2, float* MLbase, bf16* CATp, int b, int h, int c, int i0, int nq, int tid, int lane, int wave) {
    typedef unsigned u32x2v __attribute__((ext_vector_type(2)));
    const int g = h >> 2, j = h & 3, r = 1 << (2 * g);
    const size_t rowb = (size_t)b * SEQ;
    const int l31 = lane & 31, hi = lane >> 5;
    const int nkb = nq >> 8;
    const int T = (nq >> 6) + 2, tt0 = (i0 == 0) ? 2 : 0;
    bf16* ogb = ((g == 2) ? OG2 : OG01) + j * 128; const int ogs = (g == 2) ? AOW : 2 * AOW;
    float* mlb = MLbase + (size_t)g * M * 8 + j * 2;
    v4u qf[8], qn[8]; f32x16 o[4]; float mrun = -1e30f, lrun = 0.f;
    int iq = i0 + 32 * wave + l31;
#pragma unroll
    for (int s = 0; s < 8; ++s) qf[s] = *(const v4u*)(PA + (rowb + (size_t)iq * r + c) * NA + h * 128 + 16 * s + 8 * hi);
#pragma unroll
    for (int d = 0; d < 4; ++d)
#pragma unroll
        for (int e = 0; e < 16; ++e) o[d][e] = 0.f;
    int koff[2];
    { const int q4 = lane >> 4, slot = lane & 15;
#pragma unroll
      for (int i = 0; i < 2; ++i) { const int row = 8 * wave + 4 * i + q4; const int ch = slot ^ (((row & 3) << 2) | ((row >> 2) & 3)); koff[i] = row * r * NA + ch * 8; } }
#define ATT_DMA(TILE, BUF) do { const bf16* kt_ = PA + (rowb + (size_t)((i0 - 128 + 64 * (TILE)) * r) + c) * NA + 1536 + h * 128; \
        _Pragma("unroll") for (int i_ = 0; i_ < 2; ++i_) { \
            __builtin_amdgcn_global_load_lds((const unsigned*)(kt_ + koff[i_]), (LAS unsigned*)(lds + (BUF) * ALDS_BUF + 256 * (8 * wave + 4 * i_)), 16, 0, 0); \
            __builtin_amdgcn_global_load_lds((const unsigned*)(kt_ + 1536 + koff[i_]), (LAS unsigned*)(lds + (BUF) * ALDS_BUF + 16384 + 256 * (8 * wave + 4 * i_)), 16, 0, 0); } } while (0)
    WG_BAR();
    ATT_DMA(tt0, 0);
    if (tt0 + 1 < T) ATT_DMA(tt0 + 1, 1);
    asm volatile("" :: "v"(qf[0]), "v"(qf[1]), "v"(qf[2]), "v"(qf[3]), "v"(qf[4]), "v"(qf[5]), "v"(qf[6]), "v"(qf[7]) : "memory");
    asm volatile("s_waitcnt vmcnt(0)" ::: "memory");
    WG_BAR();
    int cur = 0; bool pending = false;
#define ATT_FINAL() do { int hi_ = hi; asm volatile("" : "+v"(hi_));     \
        const float ltot_ = lrun + __shfl_xor(lrun, 32); const size_t qrow_ = rowb + (size_t)iq * r + c; \
        if constexpr (!MERGE) { const float il_ = __builtin_amdgcn_rcpf(ltot_); bf16* orow_ = ogb + qrow_ * ogs + 8 * hi_; \
            _Pragma("unroll") for (int d_ = 0; d_ < 4; ++d_) _Pragma("unroll") for (int p_ = 0; p_ < 2; ++p_) { u32x2t a_, b_; \
                a_.x = cvtpk2(o[d_][8 * p_] * il_, o[d_][8 * p_ + 1] * il_); a_.y = cvtpk2(o[d_][8 * p_ + 2] * il_, o[d_][8 * p_ + 3] * il_); \
                b_.x = cvtpk2(o[d_][8 * p_ + 4] * il_, o[d_][8 * p_ + 5] * il_); b_.y = cvtpk2(o[d_][8 * p_ + 6] * il_, o[d_][8 * p_ + 7] * il_); \
                *(v4u*)(orow_ + d_ * 32 + 16 * p_) = widen_pair(a_, b_); } \
            if (hi_ == 0) { typedef float f32x2v_ __attribute__((ext_vector_type(2))); *(f32x2v_*)(mlb + qrow_ * 8) = (f32x2v_){mrun, ltot_}; } } \
        else { typedef float f32x2v_ __attribute__((ext_vector_type(2))); \
            const f32x2v_ ml1_ = *(const f32x2v_*)(MLbase + ((size_t)1 * M + qrow_) * 8 + j * 2), ml2_ = *(const f32x2v_*)(MLbase + ((size_t)2 * M + qrow_) * 8 + j * 2); \
            const bf16* o1p_ = OG01 + qrow_ * (2 * AOW) + j * 128 + 8 * hi_; const bf16* o2p_ = OG2 + qrow_ * AOW + j * 128 + 8 * hi_; \
            v4u g1_[4][2], g2_[4][2]; \
            _Pragma("unroll") for (int d_ = 0; d_ < 4; ++d_) _Pragma("unroll") for (int p_ = 0; p_ < 2; ++p_) { g1_[d_][p_] = *(const v4u*)(o1p_ + d_ * 32 + 16 * p_); g2_[d_][p_] = *(const v4u*)(o2p_ + d_ * 32 + 16 * p_); } \
            const float mm_ = fmaxf(mrun, fmaxf(ml1_.x, ml2_.x)); const float a0_ = __builtin_amdgcn_exp2f(mrun - mm_), w1_ = ml1_.y * __builtin_amdgcn_exp2f(ml1_.x - mm_), w2_ = ml2_.y * __builtin_amdgcn_exp2f(ml2_.x - mm_); \
            const float inv_ = __builtin_amdgcn_rcpf(ltot_ * a0_ + w1_ + w2_); const float s0_ = a0_ * inv_, s1_ = w1_ * inv_, s2_ = w2_ * inv_; \
            bf16* crow_ = CATp + qrow_ * 1536 + j * 128 + 8 * hi_; \
            _Pragma("unroll") for (int d_ = 0; d_ < 4; ++d_) _Pragma("unroll") for (int p_ = 0; p_ < 2; ++p_) { u32x2t a1_, b1_, a2_, b2_; unwiden_pair(g1_[d_][p_], a1_, b1_); unwiden_pair(g2_[d_][p_], a2_, b2_); u32x2t ya_, yb_; \
                ya_.x = cvtpk2(o[d_][8 * p_] * s0_ + bflo(a1_.x) * s1_ + bflo(a2_.x) * s2_, o[d_][8 * p_ + 1] * s0_ + bfhi(a1_.x) * s1_ + bfhi(a2_.x) * s2_); \
                ya_.y = cvtpk2(o[d_][8 * p_ + 2] * s0_ + bflo(a1_.y) * s1_ + bflo(a2_.y) * s2_, o[d_][8 * p_ + 3] * s0_ + bfhi(a1_.y) * s1_ + bfhi(a2_.y) * s2_); \
                yb_.x = cvtpk2(o[d_][8 * p_ + 4] * s0_ + bflo(b1_.x) * s1_ + bflo(b2_.x) * s2_, o[d_][8 * p_ + 5] * s0_ + bfhi(b1_.x) * s1_ + bfhi(b2_.x) * s2_); \
                yb_.y = cvtpk2(o[d_][8 * p_ + 6] * s0_ + bflo(b1_.y) * s1_ + bflo(b2_.y) * s2_, o[d_][8 * p_ + 7] * s0_ + bfhi(b1_.y) * s1_ + bfhi(b2_.y) * s2_); \
                *(v4u*)(crow_ + d_ * 32 + 16 * p_) = widen_pair(ya_, yb_); } } } while (0)
#pragma unroll 1
    for (int tt = tt0; tt < T; ++tt) {
        const LAS unsigned char* Kb = lds + cur * ALDS_BUF; const LAS unsigned char* Vb = Kb + 16384;
        const int rel = tt - (wave >> 1), kb_ = rel >> 2, ph = rel & 3;
        const bool fin = (rel >= 0 && kb_ < nkb && ph == 3 && pending), nxq = fin && (kb_ + 1 < nkb), dma = (tt + 2 < T);
        const bool qpre = (rel >= 0 && kb_ + 1 < nkb && ph == 2);
        if (qpre) {
            int hq_ = hi; asm volatile("" : "+v"(hq_));
#pragma unroll
            for (int s = 0; s < 8; ++s) qn[s] = *(const v4u*)(PA + (rowb + (size_t)(iq + 256) * r + c) * NA + h * 128 + 16 * s + 8 * hq_); }
        if (fin) {
            ATT_FINAL(); pending = false;
            if (nxq) { iq += 256;
#pragma unroll
                for (int s = 0; s < 8; ++s) qf[s] = qn[s];
#pragma unroll
                for (int d = 0; d < 4; ++d)
#pragma unroll
                    for (int e = 0; e < 16; ++e) o[d][e] = 0.f;
                mrun = -1e30f; lrun = 0.f; } }
        asm volatile("" ::: "memory");
        if (dma) ATT_DMA(tt + 2, cur >= 1 ? cur - 1 : 2);
        asm volatile("" ::: "memory");
        if (rel >= 0 && kb_ < nkb && ph < 3) {
            const bool do0 = !((wave & 1) && ph == 0), do1 = !(!(wave & 1) && ph == 2);
            f32x16 s0, s1;
#pragma unroll
            for (int e = 0; e < 16; ++e) { s0[e] = 0.f; s1[e] = 0.f; }
            if (do0) {
#pragma unroll
                for (int s = 0; s < 8; ++s) { const bf16x8 a0 = *(const LAS bf16x8*)(Kb + img_off(l31, 2 * s + hi)); s0 = __builtin_amdgcn_mfma_f32_32x32x16_bf16(a0, __builtin_bit_cast(bf16x8, qf[s]), s0, 0, 0, 0); } }
            if (do1) {
#pragma unroll
                for (int s = 0; s < 8; ++s) { const bf16x8 a1 = *(const LAS bf16x8*)(Kb + img_off(32 + l31, 2 * s + hi)); s1 = __builtin_amdgcn_mfma_f32_32x32x16_bf16(a1, __builtin_bit_cast(bf16x8, qf[s]), s1, 0, 0, 0); } }
            const int dq = iq - (i0 - 128 + 64 * tt) - 4 * hi;
            float mx = -__builtin_inff();
            if (ph != 1) {
#pragma unroll
                for (int e = 0; e < 16; ++e) { const int ko = (e & 3) + 8 * (e >> 2);
                    if ((unsigned)(dq - ko) > 128u) s0[e] = -__builtin_inff();
                    if ((unsigned)(dq - ko - 32) > 128u) s1[e] = -__builtin_inff(); } }
            if (do0) {
#pragma unroll
                for (int e = 0; e < 16; ++e) mx = fmaxf(mx, s0[e]); }
            if (do1) {
#pragma unroll
                for (int e = 0; e < 16; ++e) mx = fmaxf(mx, s1[e]); }
            mx = fmaxf(mx, __shfl_xor(mx, 32));
            const float mnew = fmaxf(mrun, mx), alpha = __builtin_amdgcn_exp2f(mrun - mnew); mrun = mnew;
            float ps = 0.f;
            if (do0) {
#pragma unroll
                for (int e = 0; e < 16; ++e) { s0[e] = __builtin_amdgcn_exp2f(s0[e] - mnew); ps += s0[e]; } }
            if (do1) {
#pragma unroll
                for (int e = 0; e < 16; ++e) { s1[e] = __builtin_amdgcn_exp2f(s1[e] - mnew); ps += s1[e]; } }
            lrun = lrun * alpha + ps;
            if (__any(alpha != 1.0f)) {
#pragma unroll
            for (int d = 0; d < 4; ++d)
#pragma unroll
                for (int e = 0; e < 16; ++e) o[d][e] *= alpha; }
#pragma unroll
            for (int hf = 0; hf < 2; ++hf) { if (hf == 0 ? !do0 : !do1) continue;
                bf16x8 pb[2];
#pragma unroll
                for (int k2 = 0; k2 < 2; ++k2) { v4u w;
                    if (hf == 0) { w.x = cvtpk2(s0[8 * k2], s0[8 * k2 + 1]); w.y = cvtpk2(s0[8 * k2 + 2], s0[8 * k2 + 3]); w.z = cvtpk2(s0[8 * k2 + 4], s0[8 * k2 + 5]); w.w = cvtpk2(s0[8 * k2 + 6], s0[8 * k2 + 7]); }
                    else { w.x = cvtpk2(s1[8 * k2], s1[8 * k2 + 1]); w.y = cvtpk2(s1[8 * k2 + 2], s1[8 * k2 + 3]); w.z = cvtpk2(s1[8 * k2 + 4], s1[8 * k2 + 5]); w.w = cvtpk2(s1[8 * k2 + 6], s1[8 * k2 + 7]); }
                    pb[k2] = __builtin_bit_cast(bf16x8, w); }
#pragma unroll
                for (int dp = 0; dp < 2; ++dp) { s16x4 vlo[2][2], vhh[2][2];
#pragma unroll
                    for (int d2 = 0; d2 < 2; ++d2)
#pragma unroll
                        for (int k2 = 0; k2 < 2; ++k2) { const int ks = 2 * hf + k2, d = 2 * dp + d2;
                            const unsigned a0_ = (unsigned)(size_t)(Vb + img_tr_off(lane, 16 * ks + 4 * hi, d)), a1_ = (unsigned)(size_t)(Vb + img_tr_off(lane, 16 * ks + 4 * hi + 8, d));
                            asm volatile("ds_read_b64_tr_b16 %0, %1" : "=v"(vlo[d2][k2]) : "v"(a0_)); asm volatile("ds_read_b64_tr_b16 %0, %1" : "=v"(vhh[d2][k2]) : "v"(a1_)); }
                    asm volatile("s_waitcnt lgkmcnt(0)" : "+v"(vlo[0][0]), "+v"(vlo[0][1]), "+v"(vlo[1][0]), "+v"(vlo[1][1]), "+v"(vhh[0][0]), "+v"(vhh[0][1]), "+v"(vhh[1][0]), "+v"(vhh[1][1]));
#pragma unroll
                    for (int d2 = 0; d2 < 2; ++d2)
#pragma unroll
                        for (int k2 = 0; k2 < 2; ++k2) { const s16x4 lo = vlo[d2][k2], hh = vhh[d2][k2]; const int d = 2 * dp + d2;
                            const bf16x8 a = (bf16x8){lo[0], lo[1], lo[2], lo[3], hh[0], hh[1], hh[2], hh[3]};
                            o[d] = __builtin_amdgcn_mfma_f32_32x32x16_bf16(a, pb[k2], o[d], 0, 0, 0); } } }
            if (ph == 2) pending = true;
        }
        { const int ny = (fin ? 8 : 0) + (qpre ? 8 : 0) + (dma ? 4 : 0);
          if (ny >= 20) asm volatile("s_waitcnt vmcnt(20)" ::: "memory"); else if (ny >= 16) asm volatile("s_waitcnt vmcnt(16)" ::: "memory"); else if (ny >= 12) asm volatile("s_waitcnt vmcnt(12)" ::: "memory");
          else if (ny >= 8) asm volatile("s_waitcnt vmcnt(8)" ::: "memory"); else if (ny >= 4) asm volatile("s_waitcnt vmcnt(4)" ::: "memory"); else asm volatile("s_waitcnt vmcnt(0)" ::: "memory"); }
        WG_BAR();
        cur = cur == 2 ? 0 : cur + 1;
    }
    if (pending) ATT_FINAL();
#undef ATT_FINAL
#undef ATT_DMA
}

constexpr int GAS_ = 72;
constexpr int G_QRAW = 0, G_Q1P = 16384, G_K1 = 32768, G_V0 = 49152, G_AM = 81920, G_TOT0 = G_AM + 64 * GAS_ * 2, G_F2 = G_TOT0 + 512, G_TOT1 = G_F2 + 512,
              G_EB = G_TOT1 + 512, G_EBL = G_EB + 512, G_LDS = G_EBL + 512, G_SSQ = G_LDS + 512, G_GLR = G_SSQ + 2048, G_GNL = G_GLR + 8192, G_END = G_GNL + 1024;
static_assert(G_END <= RING_BYTES, "gla lds");
__device__ __forceinline__ v4u split_hi4(const float* x, v4u& lo) {
    v4u h; unsigned hw[4], lw[4];
#pragma unroll
    for (int i = 0; i < 4; ++i) { hw[i] = cvtpk2(x[2 * i], x[2 * i + 1]); const float r0 = x[2 * i] - bflo(hw[i]), r1 = x[2 * i + 1] - bfhi(hw[i]); lw[i] = cvtpk2(r0, r1); }
    h.x = hw[0]; h.y = hw[1]; h.z = hw[2]; h.w = hw[3]; lo.x = lw[0]; lo.y = lw[1]; lo.z = lw[2]; lo.w = lw[3]; return h;
}
template <bool FULL>
__device__ __forceinline__ void gla_seg(LAS unsigned char* lds, const bf16* GB, const float* GLR, const float* w_gate_lr, const float* b_gate, const float* gla_norm_g, bf16* GLAOUT,
                                        float* SLOC, float* LOGD, int b, int h, int sg, int tid_in0, int lane_in0, int wave) {
    typedef unsigned u32x2w __attribute__((ext_vector_type(2)));
    int tid_in = tid_in0, lane_in = lane_in0; asm volatile("" : "+v"(tid_in), "+v"(lane_in));
    LAS unsigned char* QRAW = lds + G_QRAW; LAS unsigned char* Q1P = lds + G_Q1P; LAS unsigned char* K1 = lds + G_K1; LAS unsigned char* VI = lds + G_V0; LAS bf16* AM = (LAS bf16*)(lds + G_AM);
    LAS float* TOT0 = (LAS float*)(lds + G_TOT0); LAS float* F2 = (LAS float*)(lds + G_F2); LAS float* TOT1 = (LAS float*)(lds + G_TOT1); LAS float* EB = (LAS float*)(lds + G_EB);
    LAS float* EBL = (LAS float*)(lds + G_EBL); LAS float* LDSUM = (LAS float*)(lds + G_LDS); LAS float* SSQP = (LAS float*)(lds + G_SSQ); LAS float* GLRS = (LAS float*)(lds + G_GLR); LAS float* GNL = (LAS float*)(lds + G_GNL);
    const int it = wave >> 2, dt = wave & 3;
    constexpr float LOG2E = 1.4426950408889634f, LN2 = 0.6931471805599453f;
    f32x16 sacc[4];
#pragma unroll
    for (int db = 0; db < 4; ++db)
#pragma unroll
        for (int e = 0; e < 16; ++e) sacc[db][e] = 0.f;
    const size_t rowb = (size_t)b * SEQ + (size_t)sg * 1024;
    const int bh3 = (b * 4 + h) * 3;
    if constexpr (FULL) {
        for (int sp = 0; sp < sg; ++sp) {
            int ln1 = lane_in, t1 = tid_in; asm volatile("" : "+v"(ln1), "+v"(t1) :: "memory");
            const int hii = ln1 >> 5;
            const f32x4* sl = (const f32x4*)(SLOC + (size_t)(bh3 + sp) * 32768) + (wave * 64 + ln1);
            f32x4 s4[16];
#pragma unroll
            for (int q = 0; q < 16; ++q) s4[q] = sl[q * 512];
            if (t1 < 128) EB[t1] = __builtin_amdgcn_exp2f(LOG2E * LOGD[(bh3 + sp) * 128 + t1]);
            WG_BAR();
#pragma unroll
            for (int db = 0; db < 4; ++db)
#pragma unroll
                for (int gq = 0; gq < 4; ++gq) { const int d0 = db * 32 + 8 * gq + 4 * hii; const f32x4 e4 = *(const LAS f32x4*)(EB + d0); const f32x4 v4 = s4[db * 4 + gq];
#pragma unroll
                    for (int c = 0; c < 4; ++c) sacc[db][4 * gq + c] = sacc[db][4 * gq + c] * e4[c] + v4[c]; }
            WG_BAR(); }
    }
    v4u wgh, wgl; float biasv;
    { int ln0 = lane_in; asm volatile("" : "+v"(ln0));
      const int l31i = ln0 & 31, hii = ln0 >> 5, dd = h * 128 + dt * 32 + l31i; float wv[8];
#pragma unroll
      for (int j = 0; j < 8; ++j) wv[j] = w_gate_lr[(8 * hii + j) * 512 + dd];
      wgh = split_hi4(wv, wgl); biasv = b_gate[dd]; }
    { const float2 g2 = *(const float2*)(GLR + rowb * 16 + tid_in * 2); GLRS[tid_in * 2] = g2.x; GLRS[tid_in * 2 + 1] = g2.y; }
    if (tid_in < 256) GNL[tid_in] = gla_norm_g[tid_in];
    if (tid_in < 128) { EBL[tid_in] = 0.f; LDSUM[tid_in] = 0.f; }
    v4u kraw0, kraw1, qraw0, qraw1, vraw[4]; float2 glrq = {0.f, 0.f};
#define GLA_REQ(ROWC, T) do { const bf16* qp_ = GB + ((ROWC) + ((T) >> 3)) * 3072 + h * 128 + ((T) & 7) * 8; kraw0 = *(const v4u*)(qp_ + 512); kraw1 = *(const v4u*)(qp_ + 576); \
        if constexpr (FULL) { qraw0 = *(const v4u*)qp_; qraw1 = *(const v4u*)(qp_ + 64); } \
        _Pragma("unroll") for (int c4_ = 0; c4_ < 4; ++c4_) vraw[c4_] = *(const v4u*)(qp_ + 1024 + 128 * h + 64 * c4_); } while (0)
    { int t3 = tid_in; asm volatile("" : "+v"(t3) :: "memory"); GLA_REQ(rowb, t3); }
    __syncthreads();
    { int t4 = tid_in; asm volatile("" : "+v"(t4) :: "memory"); glrq = *(const float2*)(GLR + (rowb + 64) * 16 + t4 * 2); asm volatile("" ::: "memory"); }
#pragma unroll 1
    for (int n = 0; n < 16; ++n) {
        const size_t rowc = rowb + (size_t)n * 64;
        int tid_ = tid_in; asm volatile("" : "+v"(tid_));
        const int tid = tid_, lane = tid & 63, l31 = lane & 31, hi = lane >> 5;
        asm volatile("" ::: "memory");
        const int srow = tid >> 3, sc8 = tid & 7;
        v4u grl[2][2];
        if constexpr (FULL) {
#pragma unroll
            for (int i2 = 0; i2 < 2; ++i2)
#pragma unroll
                for (int pp = 0; pp < 2; ++pp) grl[i2][pp] = *(const v4u*)(GB + (rowc + i2 * 32 + l31) * 3072 + 2048 + h * 256 + 32 * wave + 16 * pp + 8 * hi); }
        asm volatile("" ::: "memory");
        f32x16 yv;
        { float gx[8]; { const LAS float* gsrc = GLRS + (n & 1) * 1024 + (it * 32 + l31) * 16 + 8 * hi; const f32x4 g0 = *(const LAS f32x4*)gsrc, g1 = *(const LAS f32x4*)(gsrc + 4);
              gx[0] = g0.x; gx[1] = g0.y; gx[2] = g0.z; gx[3] = g0.w; gx[4] = g1.x; gx[5] = g1.y; gx[6] = g1.z; gx[7] = g1.w; }
          v4u al; const v4u ah = split_hi4(gx, al);
          f32x16 z;
#pragma unroll
          for (int e = 0; e < 16; ++e) z[e] = biasv;
          z = __builtin_amdgcn_mfma_f32_32x32x16_bf16(__builtin_bit_cast(bf16x8, al), __builtin_bit_cast(bf16x8, wgh), z, 0, 0, 0);
          z = __builtin_amdgcn_mfma_f32_32x32x16_bf16(__builtin_bit_cast(bf16x8, ah), __builtin_bit_cast(bf16x8, wgl), z, 0, 0, 0);
          z = __builtin_amdgcn_mfma_f32_32x32x16_bf16(__builtin_bit_cast(bf16x8, ah), __builtin_bit_cast(bf16x8, wgh), z, 0, 0, 0);
          float la[16];
#pragma unroll
          for (int e = 0; e < 16; ++e) la[e] = (fminf(z[e], 0.f) - LN2 * __builtin_amdgcn_logf(1.0f + __builtin_amdgcn_exp2f(-LOG2E * fabsf(z[e])))) * (1.0f / 16.0f);
#pragma unroll
          for (int e = 0; e < 16; ++e) yv[e] = 0.f;
#pragma unroll
          for (int s2 = 0; s2 < 2; ++s2) { v4u ll; const v4u lh = split_hi4(la + 8 * s2, ll);
              unsigned uw[4];
#pragma unroll
              for (int i2 = 0; i2 < 4; ++i2) { const int j0 = 2 * i2, j1 = 2 * i2 + 1; const int t0 = 16 * s2 + 8 * (j0 >> 2) + 4 * hi + (j0 & 3), t1 = 16 * s2 + 8 * (j1 >> 2) + 4 * hi + (j1 & 3);
                  uw[i2] = (t0 <= l31 ? 0x3f80u : 0u) | (t1 <= l31 ? 0x3f800000u : 0u); }
              v4u ut; ut.x = uw[0]; ut.y = uw[1]; ut.z = uw[2]; ut.w = uw[3];
              yv = __builtin_amdgcn_mfma_f32_32x32x16_bf16(__builtin_bit_cast(bf16x8, ll), __builtin_bit_cast(bf16x8, ut), yv, 0, 0, 0);
              yv = __builtin_amdgcn_mfma_f32_32x32x16_bf16(__builtin_bit_cast(bf16x8, lh), __builtin_bit_cast(bf16x8, ut), yv, 0, 0, 0); } }
        if (l31 == 31) { LAS float* tp = (it ? TOT1 : TOT0) + 32 * dt + 4 * hi;
#pragma unroll
            for (int gq = 0; gq < 4; ++gq) *(LAS f32x4*)(tp + 8 * gq) = (f32x4){yv[4 * gq], yv[4 * gq + 1], yv[4 * gq + 2], yv[4 * gq + 3]}; }
        if (l31 == 0 && it == 1) { LAS float* tp = F2 + 32 * dt + 4 * hi;
#pragma unroll
            for (int gq = 0; gq < 4; ++gq) *(LAS f32x4*)(tp + 8 * gq) = (f32x4){yv[4 * gq], yv[4 * gq + 1], yv[4 * gq + 2], yv[4 * gq + 3]}; }
        { const unsigned o0 = img_off(srow, sc8), o1 = img_off(srow, sc8 + 8);
          if constexpr (FULL) { *(LAS v4u*)(QRAW + o0) = qraw0; *(LAS v4u*)(QRAW + o1) = qraw1; }
          *(LAS v4u*)(K1 + o0) = kraw0; *(LAS v4u*)(K1 + o1) = kraw1;
          *(LAS v4u*)(VI + o0) = vraw[0]; *(LAS v4u*)(VI + o1) = vraw[1]; *(LAS v4u*)(VI + 16384 + o0) = vraw[2]; *(LAS v4u*)(VI + 16384 + o1) = vraw[3]; }
        WG_BAR();
        {
#pragma unroll
            for (int gq = 0; gq < 4; ++gq) { const int d0 = 32 * dt + 8 * gq + 4 * hi;
                const f32x4 t0 = *(const LAS f32x4*)(TOT0 + d0), f2 = *(const LAS f32x4*)(F2 + d0);
                if (it == 0 && l31 == 0) { const f32x4 t1 = *(const LAS f32x4*)(TOT1 + d0), el = *(const LAS f32x4*)(EBL + d0), lsm = *(const LAS f32x4*)(LDSUM + d0); f32x4 eb, nl, ns;
#pragma unroll
                    for (int c = 0; c < 4; ++c) { const float bref = t0[c] + f2[c], blast = t0[c] + t1[c]; eb[c] = __builtin_amdgcn_exp2f(LOG2E * (el[c] + bref)); nl[c] = blast - bref; ns[c] = lsm[c] + blast; }
                    *(LAS f32x4*)(EB + d0) = eb; *(LAS f32x4*)(EBL + d0) = nl; *(LAS f32x4*)(LDSUM + d0) = ns; }
                const unsigned ao = img_off(it * 32 + l31, 4 * dt + gq) + 8 * hi;
                const u32x2w kr = *(const LAS u32x2w*)(K1 + ao); u32x2w qr = {0u, 0u};
                if constexpr (FULL) qr = *(const LAS u32x2w*)(QRAW + ao);
                float e1[4], e2[4];
#pragma unroll
                for (int c = 0; c < 4; ++c) { const float rel = LOG2E * (yv[4 * gq + c] - (it ? f2[c] : t0[c] + f2[c])); e1[c] = __builtin_amdgcn_exp2f(rel); e2[c] = __builtin_amdgcn_exp2f(-rel); }
                u32x2w kw; kw.x = cvtpk2(bflo(kr.x) * e2[0], bfhi(kr.x) * e2[1]); kw.y = cvtpk2(bflo(kr.y) * e2[2], bfhi(kr.y) * e2[3]);
                *(LAS u32x2w*)(K1 + ao) = kw;
                if constexpr (FULL) { u32x2w qw; qw.x = cvtpk2(bflo(qr.x) * e1[0], bfhi(qr.x) * e1[1]); qw.y = cvtpk2(bflo(qr.y) * e1[2], bfhi(qr.y) * e1[3]);
                    *(LAS u32x2w*)(Q1P + img_off(it * 32 + l31, 4 * dt + 2 * (gq >> 1) + hi) + 8 * (gq & 1)) = qw; } }
        }
        WG_BAR();
        if (n + 1 < 16) { LAS float* gd = GLRS + ((n + 1) & 1) * 1024 + tid * 2; gd[0] = glrq.x; gd[1] = glrq.y; }
        asm volatile("" ::: "memory");
        { const size_t rn1 = rowb + (size_t)(n + 1 < 16 ? n + 1 : 15) * 64, rn2 = rowb + (size_t)(n + 2 < 16 ? n + 2 : 15) * 64;
          GLA_REQ(rn1, tid); glrq = *(const float2*)(GLR + rn2 * 16 + tid * 2); }
        asm volatile("" ::: "memory");
#pragma unroll
        for (int db = 0; db < 4; ++db)
#pragma unroll
            for (int gq = 0; gq < 4; ++gq) { const f32x4 e4 = *(const LAS f32x4*)(EB + db * 32 + 8 * gq + 4 * hi);
                sacc[db][4 * gq] *= e4.x; sacc[db][4 * gq + 1] *= e4.y; sacc[db][4 * gq + 2] *= e4.z; sacc[db][4 * gq + 3] *= e4.w; }
        f32x16 oacc[2];
#pragma unroll
        for (int i2 = 0; i2 < 2; ++i2)
#pragma unroll
            for (int e = 0; e < 16; ++e) oacc[i2][e] = 0.f;
        if constexpr (FULL) {
        if (wave < 3) { const int ia = wave > 0 ? 1 : 0, ja = wave == 2 ? 1 : 0; f32x16 a16;
#pragma unroll
            for (int e = 0; e < 16; ++e) a16[e] = 0.f;
#pragma unroll
            for (int ks = 0; ks < 8; ++ks) { const unsigned ka = img_off(ja * 32 + l31, 2 * ks) + 8 * hi, kb2 = img_off(ja * 32 + l31, 2 * ks + 1) + 8 * hi;
                const s16x4 lo = *(const LAS s16x4*)(K1 + ka), hh = *(const LAS s16x4*)(K1 + kb2);
                const bf16x8 af = (bf16x8){lo[0], lo[1], lo[2], lo[3], hh[0], hh[1], hh[2], hh[3]};
                const bf16x8 bfr = *(const LAS bf16x8*)(Q1P + img_off(ia * 32 + l31, 2 * ks + hi));
                a16 = __builtin_amdgcn_mfma_f32_32x32x16_bf16(af, bfr, a16, 0, 0, 0); }
#pragma unroll
            for (int gq = 0; gq < 4; ++gq) { const int i = ia * 32 + l31, j0 = ja * 32 + 8 * gq + 4 * hi; u32x2w w;
                w.x = cvtpk2(j0 <= i ? a16[4 * gq] : 0.f, j0 + 1 <= i ? a16[4 * gq + 1] : 0.f); w.y = cvtpk2(j0 + 2 <= i ? a16[4 * gq + 2] : 0.f, j0 + 3 <= i ? a16[4 * gq + 3] : 0.f);
                *(LAS u32x2w*)(AM + i * GAS_ + j0) = w; } }
#pragma unroll
        for (int db = 0; db < 4; ++db)
#pragma unroll
            for (int s2 = 0; s2 < 2; ++s2) { v4u w; w.x = cvtpk2(sacc[db][8 * s2], sacc[db][8 * s2 + 1]); w.y = cvtpk2(sacc[db][8 * s2 + 2], sacc[db][8 * s2 + 3]);
                w.z = cvtpk2(sacc[db][8 * s2 + 4], sacc[db][8 * s2 + 5]); w.w = cvtpk2(sacc[db][8 * s2 + 6], sacc[db][8 * s2 + 7]); const bf16x8 af = __builtin_bit_cast(bf16x8, w);
#pragma unroll
                for (int i2 = 0; i2 < 2; ++i2) { const bf16x8 bfr = *(const LAS bf16x8*)(Q1P + img_off(i2 * 32 + l31, 4 * db + 2 * s2 + hi));
                    oacc[i2] = __builtin_amdgcn_mfma_f32_32x32x16_bf16(af, bfr, oacc[i2], 0, 0, 0); } }
        WG_BAR();
        }
        bf16x8 vf[4];
        { const LAS unsigned char* vim = VI + (wave >> 2) * 16384;
#pragma unroll
          for (int ks = 0; ks < 4; ++ks) { const s16x4 lo = img_tr_read(vim + img_tr_off(lane, 16 * ks + 8 * hi, wave & 3)), hh = img_tr_read(vim + img_tr_off(lane, 16 * ks + 8 * hi + 4, wave & 3));
              vf[ks] = (bf16x8){lo[0], lo[1], lo[2], lo[3], hh[0], hh[1], hh[2], hh[3]}; } }
        if constexpr (FULL) {
#pragma unroll
        for (int i2 = 0; i2 < 2; ++i2)
#pragma unroll
            for (int ks = 0; ks < 4; ++ks) { if (i2 == 0 && ks >= 2) continue;
                const bf16x8 bfr = *(const LAS bf16x8*)(AM + (i2 * 32 + l31) * GAS_ + 16 * ks + 8 * hi);
                oacc[i2] = __builtin_amdgcn_mfma_f32_32x32x16_bf16(vf[ks], bfr, oacc[i2], 0, 0, 0); }
        }
#pragma unroll
        for (int db = 0; db < 4; ++db)
#pragma unroll
            for (int ks = 0; ks < 4; ++ks) { const s16x4 lo = img_tr_read(K1 + img_tr_off(lane, 16 * ks + 8 * hi, db)), hh = img_tr_read(K1 + img_tr_off(lane, 16 * ks + 8 * hi + 4, db));
                const bf16x8 af = (bf16x8){lo[0], lo[1], lo[2], lo[3], hh[0], hh[1], hh[2], hh[3]};
                sacc[db] = __builtin_amdgcn_mfma_f32_32x32x16_bf16(af, vf[ks], sacc[db], 0, 0, 0); }
        if constexpr (FULL) {
#pragma unroll
        for (int i2 = 0; i2 < 2; ++i2) { float sq = 0.f;
#pragma unroll
            for (int e = 0; e < 16; ++e) sq += oacc[i2][e] * oacc[i2][e];
            sq += __shfl_xor(sq, 32);
            if (hi == 0) SSQP[(i2 * 32 + l31) * 8 + wave] = sq; }
        }
        WG_BAR();
        if constexpr (FULL) {
#pragma unroll
        for (int i2 = 0; i2 < 2; ++i2) { const int tok = i2 * 32 + l31; const f32x4 p0 = *(const LAS f32x4*)(SSQP + tok * 8), p1 = *(const LAS f32x4*)(SSQP + tok * 8 + 4);
            const float rstd = __builtin_amdgcn_rsqf(((p0.x + p0.y) + (p0.z + p0.w) + (p1.x + p1.y) + (p1.z + p1.w)) * (1.0f / 256.0f) + EPS);
            const size_t row = rowc + tok;
#pragma unroll
            for (int pp = 0; pp < 2; ++pp) { u32x2t ga_, gb_; unwiden_pair(grl[i2][pp], ga_, gb_); u32x2t ya, yb;
#pragma unroll
                for (int q2 = 0; q2 < 2; ++q2) { const int gq = 2 * pp + q2; const int v0 = 32 * wave + 8 * gq + 4 * hi; const u32x2t g2 = q2 ? gb_ : ga_;
                    const f32x4 gnv = *(const LAS f32x4*)(GNL + v0);
                    const float y0 = oacc[i2][4 * gq] * rstd * gnv.x * bflo(g2.x), y1 = oacc[i2][4 * gq + 1] * rstd * gnv.y * bfhi(g2.x);
                    const float y2 = oacc[i2][4 * gq + 2] * rstd * gnv.z * bflo(g2.y), y3 = oacc[i2][4 * gq + 3] * rstd * gnv.w * bfhi(g2.y);
                    u32x2t w; w.x = cvtpk2(y0, y1); w.y = cvtpk2(y2, y3); if (q2) yb = w; else ya = w; }
                *(v4u*)(GLAOUT + row * 1536 + 512 + h * 256 + 32 * wave + 16 * pp + 8 * hi) = widen_pair(ya, yb);     } }
        }
    }
#undef GLA_REQ
    if constexpr (!FULL) {
        int ln2 = lane_in; asm volatile("" : "+v"(ln2) :: "memory");
        const int hii = ln2 >> 5;
        f32x4* sl = (f32x4*)(SLOC + (size_t)(bh3 + sg) * 32768) + (wave * 64 + ln2);
#pragma unroll
        for (int db = 0; db < 4; ++db)
#pragma unroll
            for (int gq = 0; gq < 4; ++gq) { const int d0 = db * 32 + 8 * gq + 4 * hii; const f32x4 el = *(const LAS f32x4*)(EBL + d0);
                { f32x4 o4;
#pragma unroll
                for (int c = 0; c < 4; ++c) o4[c] = sacc[db][4 * gq + c] * __builtin_amdgcn_exp2f(LOG2E * el[c]);
                sl[(db * 4 + gq) * 512] = o4; } }
        if (tid_in < 128) LOGD[(bh3 + sg) * 128 + tid_in] = LDSUM[tid_in];
    }
}


__device__ __forceinline__ void gla_loc(LAS unsigned char* lds, const bf16* GB, const float* GLR, const float* w_gate_lr, const float* b_gate,
                                        float* SLOC, float* LOGD, int b, int h, int sg, int tid_in0, int lane_in0, int wave) {
    typedef unsigned u32x2w __attribute__((ext_vector_type(2)));
    int tid_in = tid_in0, lane_in = lane_in0; asm volatile("" : "+v"(tid_in), "+v"(lane_in));
    constexpr int P_K1 = 0, P_V = 32768, P_TOT0 = 98304, P_TOT1 = P_TOT0 + 512, P_CARRY = P_TOT1 + 512, P_GLRS = P_CARRY + 1024, P_END = P_GLRS + 8192;
    static_assert(P_END <= RING_BYTES, "gla_loc lds");
    LAS float* TOT0 = (LAS float*)(lds + P_TOT0); LAS float* TOT1 = (LAS float*)(lds + P_TOT1); LAS float* CARRY = (LAS float*)(lds + P_CARRY); LAS float* GLRS = (LAS float*)(lds + P_GLRS);
    const int it = wave >> 2, dt = wave & 3;
    constexpr float LOG2E = 1.4426950408889634f, LN2 = 0.6931471805599453f;
    f32x16 sacc[4];
#pragma unroll
    for (int db = 0; db < 4; ++db)
#pragma unroll
        for (int e = 0; e < 16; ++e) sacc[db][e] = 0.f;
    const size_t rowb = (size_t)b * SEQ + (size_t)sg * 1024;
    const int bh3 = (b * 4 + h) * 3;
    v4u wgh, wgl; float biasv;
    { int ln0 = lane_in; asm volatile("" : "+v"(ln0));
      const int l31i = ln0 & 31, hii = ln0 >> 5, dd = h * 128 + dt * 32 + l31i; float wv[8];
#pragma unroll
      for (int j = 0; j < 8; ++j) wv[j] = w_gate_lr[(8 * hii + j) * 512 + dd];
      wgh = split_hi4(wv, wgl); biasv = b_gate[dd]; }
    { const float2 g2 = *(const float2*)(GLR + (rowb + 15 * 64) * 16 + tid_in * 2); GLRS[tid_in * 2] = g2.x; GLRS[tid_in * 2 + 1] = g2.y; }
    if (tid_in < 128) CARRY[tid_in] = 0.f;
    v4u kraw0, kraw1, vraw[4]; float2 glrq = {0.f, 0.f};
#define GLL_REQ(ROWC, T) do { const bf16* qp_ = GB + ((ROWC) + ((T) >> 3)) * 3072 + h * 128 + ((T) & 7) * 8; kraw0 = *(const v4u*)(qp_ + 512); kraw1 = *(const v4u*)(qp_ + 576); \
        _Pragma("unroll") for (int c4_ = 0; c4_ < 4; ++c4_) vraw[c4_] = *(const v4u*)(qp_ + 1024 + 128 * h + 64 * c4_); } while (0)
    { int t3 = tid_in; asm volatile("" : "+v"(t3) :: "memory"); GLL_REQ(rowb + 15 * 64, t3); }
    __syncthreads();
    { int t4 = tid_in; asm volatile("" : "+v"(t4) :: "memory"); glrq = *(const float2*)(GLR + (rowb + 14 * 64) * 16 + t4 * 2); asm volatile("" ::: "memory"); }
    f32x16 yv;
#pragma unroll
    for (int e = 0; e < 16; ++e) yv[e] = 0.f;
#pragma unroll 1
    for (int i = 0; i <= 16; ++i) {
        int tid_ = tid_in; asm volatile("" : "+v"(tid_));
        const int tid = tid_, lane = tid & 63, l31 = lane & 31, hi = lane >> 5;
        asm volatile("" ::: "memory");
        auto gates = [&]() __attribute__((always_inline)) {
            { float gx[8]; { const LAS float* gsrc = GLRS + (i & 1) * 1024 + (it * 32 + l31) * 16 + 8 * hi; const f32x4 g0 = *(const LAS f32x4*)gsrc, g1 = *(const LAS f32x4*)(gsrc + 4);
                  gx[0] = g0.x; gx[1] = g0.y; gx[2] = g0.z; gx[3] = g0.w; gx[4] = g1.x; gx[5] = g1.y; gx[6] = g1.z; gx[7] = g1.w; }
              v4u al; const v4u ah = split_hi4(gx, al);
              f32x16 z;
#pragma unroll
              for (int e = 0; e < 16; ++e) z[e] = biasv;
              z = __builtin_amdgcn_mfma_f32_32x32x16_bf16(__builtin_bit_cast(bf16x8, al), __builtin_bit_cast(bf16x8, wgh), z, 0, 0, 0);
              z = __builtin_amdgcn_mfma_f32_32x32x16_bf16(__builtin_bit_cast(bf16x8, ah), __builtin_bit_cast(bf16x8, wgl), z, 0, 0, 0);
              z = __builtin_amdgcn_mfma_f32_32x32x16_bf16(__builtin_bit_cast(bf16x8, ah), __builtin_bit_cast(bf16x8, wgh), z, 0, 0, 0);
              float la[16];
#pragma unroll
              for (int e = 0; e < 16; ++e) la[e] = (fminf(z[e], 0.f) - LN2 * __builtin_amdgcn_logf(1.0f + __builtin_amdgcn_exp2f(-LOG2E * fabsf(z[e])))) * (1.0f / 16.0f);
#pragma unroll
              for (int e = 0; e < 16; ++e) yv[e] = 0.f;
#pragma unroll
              for (int s2 = 0; s2 < 2; ++s2) { v4u ll; const v4u lh = split_hi4(la + 8 * s2, ll);
                  unsigned uw[4];
#pragma unroll
                  for (int i2 = 0; i2 < 4; ++i2) { const int j0 = 2 * i2, j1 = 2 * i2 + 1; const int t0 = 16 * s2 + 8 * (j0 >> 2) + 4 * hi + (j0 & 3), t1 = 16 * s2 + 8 * (j1 >> 2) + 4 * hi + (j1 & 3);
                      uw[i2] = (t0 <= l31 ? 0x3f80u : 0u) | (t1 <= l31 ? 0x3f800000u : 0u); }
                  v4u ut; ut.x = uw[0]; ut.y = uw[1]; ut.z = uw[2]; ut.w = uw[3];
                  yv = __builtin_amdgcn_mfma_f32_32x32x16_bf16(__builtin_bit_cast(bf16x8, ll), __builtin_bit_cast(bf16x8, ut), yv, 0, 0, 0);
                  yv = __builtin_amdgcn_mfma_f32_32x32x16_bf16(__builtin_bit_cast(bf16x8, lh), __builtin_bit_cast(bf16x8, ut), yv, 0, 0, 0); } }
            if (l31 == 31) { LAS float* tp = (it ? TOT1 : TOT0) + 32 * dt + 4 * hi;
#pragma unroll
                for (int gq = 0; gq < 4; ++gq) *(LAS f32x4*)(tp + 8 * gq) = (f32x4){yv[4 * gq], yv[4 * gq + 1], yv[4 * gq + 2], yv[4 * gq + 3]}; }
            { const int srow = tid >> 3, sc8 = tid & 7; const unsigned o0 = img_off(srow, sc8), o1 = img_off(srow, sc8 + 8);
              LAS unsigned char* K1 = lds + P_K1 + (i & 1) * 16384; LAS unsigned char* VI = lds + P_V + (i & 1) * 32768;
              *(LAS v4u*)(K1 + o0) = kraw0; *(LAS v4u*)(K1 + o1) = kraw1;
              *(LAS v4u*)(VI + o0) = vraw[0]; *(LAS v4u*)(VI + o1) = vraw[1]; *(LAS v4u*)(VI + 16384 + o0) = vraw[2]; *(LAS v4u*)(VI + 16384 + o1) = vraw[3]; }
            if (i + 1 < 16) { LAS float* gd = GLRS + ((i + 1) & 1) * 1024 + tid * 2; gd[0] = glrq.x; gd[1] = glrq.y; }
            asm volatile("" ::: "memory");
            { const size_t rn1 = rowb + (size_t)(14 - i > 0 ? 14 - i : 0) * 64, rn2 = rowb + (size_t)(13 - i > 0 ? 13 - i : 0) * 64;
              GLL_REQ(rn1, tid); glrq = *(const float2*)(GLR + rn2 * 16 + tid * 2); }
            asm volatile("" ::: "memory");
        };
        auto update = [&]() __attribute__((always_inline)) {
            const LAS unsigned char* K1 = lds + P_K1 + ((i - 1) & 1) * 16384; const LAS unsigned char* vim = lds + P_V + ((i - 1) & 1) * 32768 + (wave >> 2) * 16384;
            bf16x8 vf[4];
#pragma unroll
            for (int ks = 0; ks < 4; ++ks) { const s16x4 lo = img_tr_read(vim + img_tr_off(lane, 16 * ks + 8 * hi, wave & 3)), hh = img_tr_read(vim + img_tr_off(lane, 16 * ks + 8 * hi + 4, wave & 3));
                vf[ks] = (bf16x8){lo[0], lo[1], lo[2], lo[3], hh[0], hh[1], hh[2], hh[3]}; }
#pragma unroll
            for (int db = 0; db < 4; ++db)
#pragma unroll
                for (int ks = 0; ks < 4; ++ks) { const s16x4 lo = img_tr_read(K1 + img_tr_off(lane, 16 * ks + 8 * hi, db)), hh = img_tr_read(K1 + img_tr_off(lane, 16 * ks + 8 * hi + 4, db));
                    const bf16x8 af = (bf16x8){lo[0], lo[1], lo[2], lo[3], hh[0], hh[1], hh[2], hh[3]};
                    sacc[db] = __builtin_amdgcn_mfma_f32_32x32x16_bf16(af, vf[ks], sacc[db], 0, 0, 0); }
        };
        if (wave >= 4 && i > 0) update();
        if (i < 16) gates();
        if (wave < 4 && i > 0) update();
        WG_BAR();
        if (i < 16) {
            LAS unsigned char* K1 = lds + P_K1 + (i & 1) * 16384; const LAS float* cyb = CARRY + (i & 1) * 128; LAS float* cyn = CARRY + ((i + 1) & 1) * 128;
#pragma unroll
            for (int gq = 0; gq < 4; ++gq) { const int d0 = 32 * dt + 8 * gq + 4 * hi;
                const f32x4 t0 = *(const LAS f32x4*)(TOT0 + d0), t1 = *(const LAS f32x4*)(TOT1 + d0), cy = *(const LAS f32x4*)(cyb + d0);
                if (it == 0 && l31 == 0) { f32x4 nc;
#pragma unroll
                    for (int c = 0; c < 4; ++c) nc[c] = cy[c] + (t0[c] + t1[c]);
                    *(LAS f32x4*)(cyn + d0) = nc; }
                const unsigned ao = img_off(it * 32 + l31, 4 * dt + gq) + 8 * hi;
                const u32x2w kr = *(const LAS u32x2w*)(K1 + ao);
                float e2[4];
#pragma unroll
                for (int c = 0; c < 4; ++c) { const float sa = ((it ? t1[c] : t0[c] + t1[c]) - yv[4 * gq + c]) + cy[c]; e2[c] = __builtin_amdgcn_exp2f(LOG2E * sa); }
                u32x2w kw; kw.x = cvtpk2(bflo(kr.x) * e2[0], bfhi(kr.x) * e2[1]); kw.y = cvtpk2(bflo(kr.y) * e2[2], bfhi(kr.y) * e2[3]);
                *(LAS u32x2w*)(K1 + ao) = kw; }
        }
        WG_BAR();
    }
#undef GLL_REQ
    { int ln2 = lane_in; asm volatile("" : "+v"(ln2) :: "memory");
      f32x4* sl = (f32x4*)(SLOC + (size_t)(bh3 + sg) * 32768) + (wave * 64 + ln2);
#pragma unroll
      for (int db = 0; db < 4; ++db)
#pragma unroll
          for (int gq = 0; gq < 4; ++gq) sl[(db * 4 + gq) * 512] = (f32x4){sacc[db][4 * gq], sacc[db][4 * gq + 1], sacc[db][4 * gq + 2], sacc[db][4 * gq + 3]};
      if (tid_in < 128) LOGD[(bh3 + sg) * 128 + tid_in] = CARRY[tid_in]; }
}

struct Args { const float* in[13]; float* out; unsigned char* ws; };

__global__ void __launch_bounds__(NWAVES * 64, 2) hyb_fwd(Args args) {
    extern __shared__ __attribute__((aligned(16))) unsigned char lds[];
    LAS unsigned char* L = (LAS unsigned char*)lds;
    volatile LAS unsigned* MISC = (volatile LAS unsigned*)(L + MISC_OFF);
    const int tid = threadIdx.x, lane = tid & 63, wave = __builtin_amdgcn_readfirstlane(tid >> 6);
    const int G = gridDim.x; const int bx = blockIdx.x; const int vcu = (G % 8 == 0) ? (bx % 8) * (G / 8) + bx / 8 : bx;
    unsigned char* ws = args.ws;
    gu32* ctl = (gu32*)(ws + WS_CTL);
    const float* x = args.in[0]; const float* norm1_g = args.in[1]; const float* w_in = args.in[2]; const float* w_gate_lr = args.in[3]; const float* b_gate = args.in[4];
    const float* gla_norm_g = args.in[5]; const float* w_branch_a = args.in[6]; const float* w_branch_b = args.in[7]; const float* w_out = args.in[8]; const float* norm2_g = args.in[9];
    const float* w_ffn_in = args.in[10]; const float* w_ffn_down = args.in[11]; const float* norm_f_g = args.in[12];
    float* out = args.out;
    bf16* WB_t = (bf16*)(ws + WS_WB); bf16* WA_t = (bf16*)(ws + WS_WA); bf16* WCAT_t = (bf16*)(ws + WS_WBA);
    bf16* WOUT_t = (bf16*)(ws + WS_WOUT); bf16* WFF_t = (bf16*)(ws + WS_WFF); bf16* WDN_t = (bf16*)(ws + WS_WDN);
    bf16* H = (bf16*)(ws + WS_H); bf16* CAT = (bf16*)(ws + WS_CAT); bf16* GB = (bf16*)(ws + WS_BIG); bf16* PA = (bf16*)(ws + WS_BIG);
    bf16* MIX = (bf16*)(ws + WS_H); bf16* X2B = (bf16*)(ws + WS_H); bf16* X1B = (bf16*)(ws + WS_BIG); bf16* ACT = (bf16*)(ws + WS_BIG) + 1024;
    bf16* GR = (bf16*)out; bf16* GS = GR + (size_t)M * 1024;
    float* ROPE = (float*)(ws + WS_ROPE); float* GLR = (float*)(ws + WS_GLR); float* SSQ1 = (float*)(ws + WS_SSQ1); float* SSQ2 = (float*)(ws + WS_SSQ2);

    for (int u = tid; u < (LDS_BYTES - LDSCTL_OFF) / 4; u += NWAVES * 64) ((LAS unsigned*)(L + LDSCTL_OFF))[u] = 0u;
    __syncthreads();
    XcdBarrier bar = xcd_barrier_post((unsigned*)(ctl + CW_BAR), MISC + 8);
    if (threadIdx.x == 0 && (G != 256 || bar.x != (unsigned)(bx & 7))) (void)__hip_atomic_fetch_or(ctl + CW_MAP, 1u, RLX_AGENT);
    const int gw = vcu * NWAVES + wave, NGW = G * NWAVES;

#if PH(0)
    for (int rep_ = 0; rep_ < ((PROBE_DUP & 4) ? 2 : 1); ++rep_)
    {
        if (rep_) __syncthreads();
        PHASE_IDS();
        LAS float* WL = (LAS float*)(L + RING_OFF);
        { float wt[32];
#pragma unroll
          for (int it = 0; it < 32; ++it) { const int i = tid + 512 * it; const int q = i & 3, ln = (i >> 2) & 63, p = (i >> 8) & 3, e = (i >> 10) & 3, j = i >> 12; const int k = 4 * (ln + 64 * j) + e;
              wt[it] = w_in[(size_t)k * INW + C_GLR + 4 * p + q]; }
#pragma unroll
          for (int it = 0; it < 32; ++it) WL[tid + 512 * it] = wt[it]; }
        __syncthreads();
        if (wave >= 6) {
            LAS float* scr = (LAS float*)(L + RING_OFF + 65536 + (wave - 6) * 8704);
            constexpr int I_B = 16 * (NB / 32), I_A = 16 * (NA / 32), I_BA = 8 * 32, I_BB = 16 * 32, I_O = 16 * 32, I_FF = 16 * (NFF / 32), I_DN = 44 * 32;
            constexpr int NITEMS = I_B + I_A + I_BA + I_BB + I_O + I_FF + I_DN;
            for (int it = vcu * 2 + (wave - 6); it < NITEMS; it += G * 2) {
                int r = it;
                if (r < I_B) { const int nb = r % (NB / 32), kb = r / (NB / 32), n0 = nb * 32; const int g0_ = n0 - 3072; const int scb = (n0 < 3072) ? C_GQ + n0 : (((g0_ >> 7) & 1) ? C_GA + 1024 : C_GA) + (g0_ >> 8) * 128 + (g0_ & 127);
                    tr_item(w_in, INW, 1024, WB_t, n0, scb, false, nullptr, kb * 64, scr, lane); continue; } r -= I_B;
                if (r < I_A) { const int nb = r % (NA / 32), kb = r / (NA / 32), n0 = nb * 32; const bool rope = (n0 < 3072) && ((n0 & 127) == 0);
                    tr_item(w_in, INW, 1024, WA_t, n0, n0, rope, nullptr, kb * 64, scr, lane); continue; } r -= I_A;
                if (r < I_BA) { const int nb = r % 32, kb = r / 32; tr_item(w_branch_a, 1024, 512, WCAT_t, nb * 32, nb * 32, false, nullptr, kb * 64, scr, lane, 1536, 0); continue; } r -= I_BA;
                if (r < I_BB) { const int nb = r % 32, kb = r / 32; tr_item(w_branch_b, 1024, 1024, WCAT_t, nb * 32, nb * 32, false, nullptr, kb * 64, scr, lane, 1536, 512); continue; } r -= I_BB;
                if (r < I_O) { const int nb = r % 32, kb = r / 32; tr_item(w_out, 1024, 1024, WOUT_t, nb * 32, nb * 32, false, nullptr, kb * 64, scr, lane); continue; } r -= I_O;
                if (r < I_FF) { const int nb = r % (NFF / 32), kb = r / (NFF / 32), n0 = nb * 32; const int t = n0 >> 8, half = (n0 >> 7) & 1; const int scb = (half ? FFH : 0) + t * 128 + (n0 & 127);
                    tr_item(w_ffn_in, NFF, 1024, WFF_t, n0, scb, false, norm2_g, kb * 64, scr, lane); continue; } r -= I_FF;
                { const int nb = r % 32, kb = r / 32; tr_item(w_ffn_down, 1024, FFH, WDN_t, nb * 32, nb * 32, false, nullptr, kb * 64, scr, lane); }
            }
            for (int i = bx * 128 + (tid - 384); i < SEQ * 16; i += G * 128) { const int pos = i >> 4, f = i & 15;
                const float inv = exp2f(-(float)f * (18.931568569324174f / 16.0f)); const float ang = (float)pos * inv;
                const double rev = (double)ang * 0.15915494309189535; const float fr = (float)(rev - __builtin_rint(rev));
                ROPE[pos * 32 + f] = __builtin_amdgcn_cosf(fr); ROPE[pos * 32 + 16 + f] = __builtin_amdgcn_sinf(fr); }
        } else {
        f32x4 g1[4];
#pragma unroll
        for (int j = 0; j < 4; ++j) g1[j] = ((const f32x4*)norm1_g)[lane + 64 * j];
        f32x4 xn[2][4];
        { const int mf = (vcu * 6 + wave) * 2;
#pragma unroll
          for (int rr = 0; rr < 2; ++rr) { const GAS f32x4* xr = (const GAS f32x4*)(x + (size_t)(mf + rr) * DM) + lane;
#pragma unroll
              for (int j = 0; j < 4; ++j) xn[rr][j] = __builtin_nontemporal_load(xr + 64 * j); }     }
#pragma unroll 1
        for (int m0 = (vcu * 6 + wave) * 2; m0 < M; m0 += G * 12) {
            asm volatile("" ::: "memory");
            float hx[2][16];
#pragma unroll
            for (int rr = 0; rr < 2; ++rr)
#pragma unroll
                for (int j = 0; j < 4; ++j) { const f32x4 t = xn[rr][j]; hx[rr][4 * j] = t.x; hx[rr][4 * j + 1] = t.y; hx[rr][4 * j + 2] = t.z; hx[rr][4 * j + 3] = t.w; }
            if (m0 + G * 12 < M) {
#pragma unroll
                for (int rr = 0; rr < 2; ++rr) { const GAS f32x4* xr = (const GAS f32x4*)(x + (size_t)(m0 + G * 12 + rr) * DM) + lane;
#pragma unroll
                    for (int j = 0; j < 4; ++j) xn[rr][j] = __builtin_nontemporal_load(xr + 64 * j); }     }
            asm volatile("" ::: "memory");
#pragma unroll
            for (int rr = 0; rr < 2; ++rr) { float s = 0.f;
#pragma unroll
                for (int i = 0; i < 16; ++i) s += hx[rr][i] * hx[rr][i];
                const float rs = __builtin_amdgcn_rsqf(wave_sum(s) * (1.0f / DM) + EPS);
#pragma unroll
                for (int j = 0; j < 4; ++j) { hx[rr][4 * j] *= rs * g1[j].x; hx[rr][4 * j + 1] *= rs * g1[j].y; hx[rr][4 * j + 2] *= rs * g1[j].z; hx[rr][4 * j + 3] *= rs * g1[j].w; }
#pragma unroll
                for (int jj = 0; jj < 2; ++jj) { const int j0 = 2 * jj, j1 = 2 * jj + 1; const bool odd = (lane & 1) != 0;
                    const unsigned a0 = pk2(hx[rr][4 * j0], hx[rr][4 * j0 + 1]), a1 = pk2(hx[rr][4 * j0 + 2], hx[rr][4 * j0 + 3]), b0 = pk2(hx[rr][4 * j1], hx[rr][4 * j1 + 1]), b1 = pk2(hx[rr][4 * j1 + 2], hx[rr][4 * j1 + 3]);
                    const unsigned r0 = (unsigned)__builtin_amdgcn_mov_dpp((int)(odd ? a0 : b0), 0xB1, 0xF, 0xF, true), r1 = (unsigned)__builtin_amdgcn_mov_dpp((int)(odd ? a1 : b1), 0xB1, 0xF, 0xF, true);
                    v4u w; if (odd) { w.x = r0; w.y = r1; w.z = b0; w.w = b1; } else { w.x = a0; w.y = a1; w.z = r0; w.w = r1; }
                    { const bf16* hrow_ = H + (size_t)(m0 + rr) * DM; const unsigned ho_ = (unsigned)(8 * ((lane & ~1) + 64 * (odd ? j1 : j0))); ST16_S(hrow_, ho_, w, 0); } } }
#pragma unroll
            for (int rr = 0; rr < 2; ++rr) asm volatile("" : "+v"(hx[rr][0]), "+v"(hx[rr][1]), "+v"(hx[rr][2]), "+v"(hx[rr][3]), "+v"(hx[rr][4]), "+v"(hx[rr][5]), "+v"(hx[rr][6]), "+v"(hx[rr][7]),
                                                                "+v"(hx[rr][8]), "+v"(hx[rr][9]), "+v"(hx[rr][10]), "+v"(hx[rr][11]), "+v"(hx[rr][12]), "+v"(hx[rr][13]), "+v"(hx[rr][14]), "+v"(hx[rr][15]));
            __builtin_amdgcn_sched_barrier(0);
            float a[2][16];
#pragma unroll
            for (int rr = 0; rr < 2; ++rr)
#pragma unroll
                for (int i = 0; i < 16; ++i) a[rr][i] = 0.f;
#pragma unroll
            for (int je = 0; je < 16; ++je) {
#pragma unroll
                for (int p = 0; p < 4; ++p) { const f32x4 w4 = ((const LAS f32x4*)WL)[(je * 4 + p) * 64 + lane];
#pragma unroll
                    for (int rr = 0; rr < 2; ++rr) { const float xv = hx[rr][je]; a[rr][4 * p] += w4.x * xv; a[rr][4 * p + 1] += w4.y * xv; a[rr][4 * p + 2] += w4.z * xv; a[rr][4 * p + 3] += w4.w * xv; } }

#pragma unroll
                for (int rr = 0; rr < 2; ++rr) asm volatile("" : "+v"(a[rr][0]), "+v"(a[rr][1]), "+v"(a[rr][2]), "+v"(a[rr][3]), "+v"(a[rr][4]), "+v"(a[rr][5]), "+v"(a[rr][6]), "+v"(a[rr][7]),
                                                                    "+v"(a[rr][8]), "+v"(a[rr][9]), "+v"(a[rr][10]), "+v"(a[rr][11]), "+v"(a[rr][12]), "+v"(a[rr][13]), "+v"(a[rr][14]), "+v"(a[rr][15]) :: "memory"); }
#pragma unroll
            for (int rr = 0; rr < 2; ++rr) {
            float b8[8], c4[4], d2[2];
#pragma unroll
            for (int i = 0; i < 8; ++i) { const bool hi = (lane & 32) != 0; const float mine = hi ? a[rr][i + 8] : a[rr][i], oth = hi ? a[rr][i] : a[rr][i + 8]; b8[i] = mine + __shfl_xor(oth, 32); }
#pragma unroll
            for (int i = 0; i < 4; ++i) { const bool hi = (lane & 16) != 0; const float mine = hi ? b8[i + 4] : b8[i], oth = hi ? b8[i] : b8[i + 4]; c4[i] = mine + __shfl_xor(oth, 16); }
#pragma unroll
            for (int i = 0; i < 2; ++i) { const bool hi = (lane & 8) != 0; const float mine = hi ? c4[i + 2] : c4[i], oth = hi ? c4[i] : c4[i + 2]; d2[i] = mine + __shfl_xor(oth, 8); }
            float f1; { const bool hi = (lane & 4) != 0; const float mine = hi ? d2[1] : d2[0], oth = hi ? d2[0] : d2[1]; f1 = mine + __shfl_xor(oth, 4); }
            f1 += __shfl_xor(f1, 2); f1 += __shfl_xor(f1, 1);
            if ((lane & 3) == 0) GLR[(size_t)(m0 + rr) * 16 + ((lane >> 2) & 15)] = f1; }
        }
        }
    }
#endif
    GRID_BAR();

#if PH(1)
    for (int rep_ = 0; rep_ < ((PROBE_DUP & 8) ? 2 : 1); ++rep_)
    { pg8::Gemm g{H, WB_t, M, NB, 1024}; pg8::StaticOrder S; S.init(M, NB, G, bx); pg8::EpiB E{GB, GR, GS};
      pg8::gemm_phase<pg8::EpiB, pg8::StaticOrder, true, true>(L + RING_OFF, g, S, E, wave); }
#endif
    LOCAL_BAR();

#if PH(2)
    for (int rep_ = 0; rep_ < ((PROBE_DUP & 1) ? 2 : 1); ++rep_)
    {
        if (rep_) GRID_BAR();
        float* SLOC = (float*)(ws + WS_SLOC); float* LOGD = (float*)(ws + WS_LOGD);
        {
        for (int prep_ = 0; prep_ < ((PROBE_DUP & 512) ? 2 : 1); ++prep_)
        for (int unit = (G == 256) ? ((vcu & 31) < 24 ? (vcu >> 5) * 24 + (vcu & 31) : 192) : vcu; unit < 192; unit += G) { const int bh = unit / 3, sg = unit % 3; PHASE_IDS();
            gla_loc(L + RING_OFF, GB, GLR, w_gate_lr, b_gate, SLOC, LOGD, bh >> 2, bh & 3, sg, tid, lane, wave); __syncthreads(); } }
        LOCAL_BAR();
        {
        for (int unit = vcu; unit < 256; unit += G) { const int bh = unit >> 2, sg = unit & 3; PHASE_IDS();
            gla_seg<true>(L + RING_OFF, GB, GLR, w_gate_lr, b_gate, gla_norm_g, CAT, SLOC, LOGD, bh >> 2, bh & 3, sg, tid, lane, wave); __syncthreads(); } }
    }
#endif
    GRID_BAR();

#if PH(3)
    for (int rep_ = 0; rep_ < ((PROBE_DUP & 16) ? 2 : 1); ++rep_)
    { pg8::Gemm g{H, WA_t, M, NA, 1024}; pg8::StaticOrder S; S.init(M, NA, G, bx); pg8::EpiA E{PA, ROPE, QSCALE};
      pg8::gemm_phase<pg8::EpiA, pg8::StaticOrder, true, true>(L + RING_OFF, g, S, E, wave); }
#endif
    LOCAL_BAR();

#if PH(4)
    {
        bf16* OG01 = (bf16*)(ws + WS_OG01); bf16* OG2 = (bf16*)(ws + WS_OG2); float* ML = (float*)(ws + WS_ML);
        { PHASE_IDS();
        for (int v = vcu; v < 256; v += G) { const int b = v >> 4, j = (v >> 2) & 3, q = v & 3;
            attn_stream<false>(L + RING_OFF, PA, OG01, OG2, ML, CAT, b, 4 + j, q, 0, 1024, tid, lane, wave);
#pragma unroll 1
            for (int i = 0; i < 4; ++i) attn_stream<false>(L + RING_OFF, PA, OG01, OG2, ML, CAT, b, 8 + j, 4 * q + i, 0, 256, tid, lane, wave); } }
        LOCAL_BAR();
        { PHASE_IDS();
        for (int v = vcu; v < 256; v += G) { const int b = v >> 4, j = (v >> 2) & 3, q = v & 3;
            attn_stream<true>(L + RING_OFF, PA, OG01, OG2, ML, CAT, b, j, 0, 1024 * q, 1024, tid, lane, wave); } }
    }
#endif
    LOCAL_BAR();

#if PH(5)
    for (int rep_ = 0; rep_ < ((PROBE_DUP & 32) ? 2 : 1); ++rep_) {
    { pg8::Gemm g{CAT, WCAT_t, M, 1024, 1536}; pg8::StaticOrder S; S.init(M, 1024, G, bx); pg8::EpiMixF E{GR, GS, MIX};
      pg8::gemm_phase<pg8::EpiMixF, pg8::StaticOrder, true, true>(L + RING_OFF, g, S, E, wave); }
    __syncthreads(); }
#endif
    LOCAL_BAR();

#if PH(6)
    { pg8::Gemm g{MIX, WOUT_t, M, 1024, 1024}; pg8::StaticOrder S; S.init(M, 1024, G, bx); pg8::EpiX1 E{x, X1B, SSQ1};
      pg8::gemm_phase<pg8::EpiX1, pg8::StaticOrder, true, true>(L + RING_OFF, g, S, E, wave); }
#endif
    LOCAL_BAR();

#if PH(7)
    for (int rep_ = 0; rep_ < ((PROBE_DUP & 64) ? 2 : 1); ++rep_)
    { pg8::Gemm g{X1B, WFF_t, M, NFF, 1024, 4608}; pg8::StaticOrder S; S.init(M, NFF, G, bx); pg8::EpiSwi E{ACT, SSQ1};
      pg8::gemm_phase<pg8::EpiSwi, pg8::StaticOrder, true, true>(L + RING_OFF, g, S, E, wave); }
    if (PROBE_DUP & 256) { pg8::Gemm g{X1B, WFF_t, M, NFF, 1024, 4608}; pg8::StaticOrder S; S.init(M, NFF, G, bx); pg8::EpiNull E{};
      pg8::gemm_phase<pg8::EpiNull, pg8::StaticOrder, true, true>(L + RING_OFF, g, S, E, wave); }
#endif
    LOCAL_BAR();

#if PH(8)
    { pg8::Gemm g{ACT, WDN_t, M, 1024, FFH, 4608}; pg8::StaticOrder S; S.init(M, 1024, G, bx); pg8::EpiX2 E{X1B, X2B, SSQ2};
      pg8::gemm_phase<pg8::EpiX2, pg8::StaticOrder, true, true>(L + RING_OFF, g, S, E, wave); }
#endif
    GRID_BAR();

#if PH(9)
    {
        PHASE_IDS();
        const bool bad = (__hip_atomic_load(ctl + CW_BAR + XB_TMO, RLX_AGENT) != 0u);
        f32x4 gfv[2][2];
#pragma unroll
        for (int hf = 0; hf < 2; ++hf) { gfv[hf][0] = ((const f32x4*)norm_f_g)[(hf * 512 + lane * 8) >> 2]; gfv[hf][1] = ((const f32x4*)norm_f_g)[((hf * 512 + lane * 8) >> 2) + 1]; }
        for (int m0 = gw * 4; m0 < M; m0 += NGW * 4) {
            v4u tv[4][2]; float sq[4];
#pragma unroll
            for (int rr = 0; rr < 4; ++rr) { sq[rr] = SSQ2[m0 + rr];
#pragma unroll
                for (int hf = 0; hf < 2; ++hf) tv[rr][hf] = *(const v4u*)(X2B + (size_t)(m0 + rr) * DM + hf * 512 + lane * 8); }
#pragma unroll
            for (int rr = 0; rr < 4; ++rr) { const int row = m0 + rr; float rs = __builtin_amdgcn_rsqf(sq[rr] * (1.0f / DM) + EPS); if (bad) rs = __builtin_nanf("");
#pragma unroll
                for (int hf = 0; hf < 2; ++hf) { const int c0 = hf * 512 + lane * 8; const v4u t = tv[rr][hf]; const f32x4 g0 = gfv[hf][0], g1 = gfv[hf][1];
                    f32x4 o0, o1; o0[0] = bflo(t.x) * rs * g0[0]; o0[1] = bfhi(t.x) * rs * g0[1]; o0[2] = bflo(t.y) * rs * g0[2]; o0[3] = bfhi(t.y) * rs * g0[3];
                    o1[0] = bflo(t.z) * rs * g1[0]; o1[1] = bfhi(t.z) * rs * g1[1]; o1[2] = bflo(t.w) * rs * g1[2]; o1[3] = bfhi(t.w) * rs * g1[3];
                    const float* orow = out + (size_t)row * DM; const unsigned lo_ = (unsigned)(lane * 32);
                    if (hf == 0) { ST16_S(orow, lo_, o0, 0); ST16_S(orow, lo_, o1, 16); } else { ST16_S(orow, lo_, o0, 2048); ST16_S(orow, lo_, o1, 2064); } } } }
    }
#endif
}

extern "C" void kernel_launch(void* const* d_in, const int* in_sizes, int n_in, void* d_out, int out_size, void* d_ws, size_t ws_size, hipStream_t stream) {
    static int grid = 0;
    if (grid == 0) {
        if (n_in != 13 || in_sizes[0] != M * DM || out_size != M * DM || ws_size < WS_END) { fprintf(stderr, "kernel_launch: unexpected shapes (n_in %d, in0 %d, out %d, ws %zu)\n", n_in, n_in > 0 ? in_sizes[0] : -1, out_size, ws_size); grid = -1; return; }
        int dev = 0, cus = 0, per_cu = 0;
        if (hipGetDevice(&dev) != hipSuccess || hipDeviceGetAttribute(&cus, hipDeviceAttributeMultiprocessorCount, dev) != hipSuccess) { grid = -1; return; }
        if (hipFuncSetAttribute((const void*)hyb_fwd, hipFuncAttributeMaxDynamicSharedMemorySize, LDS_BYTES) != hipSuccess) { grid = -1; return; }
        if (hipOccupancyMaxActiveBlocksPerMultiprocessor(&per_cu, (const void*)hyb_fwd, NWAVES * 64, LDS_BYTES) != hipSuccess || per_cu < 1) { fprintf(stderr, "kernel_launch: occupancy query says %d\n", per_cu); }
        (void)hipGetLastError();
        grid = cus;
    }
    if (grid < 0) return;
    if (hipMemsetAsync((char*)d_ws + WS_CTL, 0, CTL_ZERO_BYTES, stream) != hipSuccess) return;
    Args a{};
    for (int i = 0; i < 13; ++i) a.in[i] = (const float*)d_in[i];
    a.out = (float*)d_out; a.ws = (unsigned char*)d_ws;
    hipLaunchKernelGGL(hyb_fwd, dim3(grid), dim3(NWAVES * 64), LDS_BYTES, stream, a);
}
```

```cpp
#include <hip/hip_runtime.h>
#include <cstdio>
#include <cstdint>
namespace pg8 {
#define PG8_LAS __attribute__((address_space(3)))
typedef unsigned short bf16_t;
typedef short bf16x8 __attribute__((ext_vector_type(8)));
typedef float f32x4 __attribute__((ext_vector_type(4)));
typedef unsigned u32x4 __attribute__((ext_vector_type(4)));
constexpr int BM = 256, BK = 64, HALF = 128, HTB = HALF * BK * 2  , STAGE_BYTES = 8 * HTB, NXCD = 8, WGM = 8;

__host__ __device__ __forceinline__ int lds_byte(int r, int c) { const int st = (r >> 4) * 2 + (c >> 5), rr = r & 15, cc = c & 31, ob = rr * 64 + cc * 2; return st * 1024 + (ob ^ (((ob >> 9) & 1) << 5)); }
__host__ __device__ __forceinline__ void stage_rc(int b, int& R, int& C) { const int st = b / 1024, sb = b % 1024, swz = sb ^ (((sb >> 9) & 1) << 5); R = (st >> 1) * 16 + swz / 64; C = (st & 1) * 32 + (swz % 64) / 2; }
__host__ __device__ __forceinline__ int perm32(int rho) { const int n = rho >> 4, i = rho & 15; return 8 * (i >> 2) + 4 * n + (i & 3); }

struct Unit { int pm, pn; };
struct Gemm { const bf16_t* A; const bf16_t* Bt; int M, N, K; int lda = 0; };

struct StaticOrder {
    int nM, nN, nwg, G, c;
    __host__ __device__ void init(int M, int N, int G_, int c_) { nM = M / BM; nN = N / BM; nwg = nM * nN; G = G_; c = c_; }
    __host__ __device__ bool next(int i, Unit& u) const {
        const long L = (long)i * G + c; if (L >= nwg) return false;
        int wgid = (int)L; { const int q = nwg / NXCD, r = nwg % NXCD, xcd = wgid % NXCD, off = wgid / NXCD; wgid = (xcd < r ? xcd * (q + 1) : r * (q + 1) + (xcd - r) * q) + off; }
        const int nig = WGM * nN, gid = wgid / nig, fm = gid * WGM, gsz = (nM - fm) < WGM ? (nM - fm) : WGM;
        u.pm = fm + ((wgid % nig) % gsz); u.pn = (wgid % nig) / gsz; return true;
    }
    __device__ __forceinline__ void a_ready(const Unit&) const {}
    __device__ __forceinline__ void done(const Unit&) const {}
};

__device__ __forceinline__ unsigned cvt_pk_bf16(float lo, float hi) { unsigned r; asm volatile("v_cvt_pk_bf16_f32 %0, %1, %2" : "=v"(r) : "v"(lo), "v"(hi)); return r; }
typedef float f32x2 __attribute__((ext_vector_type(2)));
__device__ __forceinline__ f32x2 gelu_pk(f32x2 v) {
    const f32x2 av = __builtin_elementwise_abs(v), d = av * 0.2316418882f + 1.0f;
    f32x2 t; t.x = __builtin_amdgcn_rcpf(d.x); t.y = __builtin_amdgcn_rcpf(d.y);
    f32x2 q = t * 0.5307027145f + (-0.7265760135f); q = q * t + 0.7107068705f; q = q * t + (-0.142248368f); q = q * t + 0.127414796f; q = q * t;
    const f32x2 s = (v * v) * (-0.72134752044f);
    f32x2 e; e.x = __builtin_amdgcn_exp2f(s.x); e.y = __builtin_amdgcn_exp2f(s.y);
    const f32x2 m = v * (q * e), r = v - m;
    f32x2 o; o.x = v.x < 0.f ? m.x : r.x; o.y = v.y < 0.f ? m.y : r.y; return o;
}

template <int ACT  > struct EpiBf16 {
    static constexpr bool PERM = true, AFTER_DRAIN = false; static_assert(ACT == 0 || ACT == 1, "EpiBf16: ACT is 0 (none) or 1 (gelu_pk)");
    bf16_t* O; int ldc; const float* bias; int split_cols; size_t split_stride; float scale0;
    __device__ __forceinline__ void operator()(const f32x4 (&acc)[2][2][4][2], const Unit& u, int wr, int wc, int fr, int fq) const {
        const int row0 = u.pm * BM + wr * 64 + fr; int colt = u.pn * BM; bf16_t* base = O;
        float sc = 1.f; if (split_cols) { const int t = colt / split_cols; base += (size_t)t * split_stride; colt -= t * split_cols; if (t == 0) sc = scale0; }
        const int col0 = colt + wc * 32 + 8 * fq, bcol0 = u.pn * BM + wc * 32 + 8 * fq;
        f32x4 bv[2][2];
#pragma unroll
        for (int bj = 0; bj < 2; ++bj)
#pragma unroll
            for (int n = 0; n < 2; ++n) bv[bj][n] = bias ? *(const f32x4*)(bias + bcol0 + bj * HALF + 4 * n) : (f32x4){0.f, 0.f, 0.f, 0.f};
#pragma unroll
        for (int ai = 0; ai < 2; ++ai)
#pragma unroll
            for (int m = 0; m < 4; ++m) { bf16_t* rowp = base + (size_t)(row0 + ai * HALF + m * 16) * ldc + col0;
#pragma unroll
                for (int bj = 0; bj < 2; ++bj) { f32x4 v0 = acc[ai][bj][m][0] + bv[bj][0], v1 = acc[ai][bj][m][1] + bv[bj][1];
                    if (ACT == 1) { f32x2 a = gelu_pk((f32x2){v0[0], v0[1]}), b = gelu_pk((f32x2){v0[2], v0[3]}), c = gelu_pk((f32x2){v1[0], v1[1]}), d = gelu_pk((f32x2){v1[2], v1[3]});
                        v0 = (f32x4){a.x, a.y, b.x, b.y}; v1 = (f32x4){c.x, c.y, d.x, d.y}; }
                    v0 = v0 * sc; v1 = v1 * sc; u32x4 w; w.x = cvt_pk_bf16(v0[0], v0[1]); w.y = cvt_pk_bf16(v0[2], v0[3]); w.z = cvt_pk_bf16(v1[0], v1[1]); w.w = cvt_pk_bf16(v1[2], v1[3]);
                    *(u32x4*)(rowp + bj * HALF) = w; } }
    }
};

struct PanelStats {
    unsigned* xbuf;
    unsigned* cnt;
    unsigned* tmo;
    int ntn; float eps;
    unsigned code;
    __device__ __forceinline__ bool run(const f32x4 (&v)[2][2][4][2], const Unit& u, int wr, int wc, int fr, int fq, PG8_LAS unsigned char* lds, int wid, int lane) const {
        typedef float f32x2v __attribute__((ext_vector_type(2)));
        PG8_LAS f32x2v* P = (PG8_LAS f32x2v*)lds;
        PG8_LAS f32x2v* S = (PG8_LAS f32x2v*)(lds + 8192);
        PG8_LAS unsigned* flag = (PG8_LAS unsigned*)(lds + 8192 + 2048);
#pragma unroll
        for (int ai = 0; ai < 2; ++ai)
#pragma unroll
            for (int m = 0; m < 4; ++m) {
                float s = 0.f;
#pragma unroll
                for (int bj = 0; bj < 2; ++bj)
#pragma unroll
                    for (int n = 0; n < 2; ++n) { const f32x4 x = v[ai][bj][m][n]; s += (x[0] + x[1]) + (x[2] + x[3]); }
                s += __shfl_xor(s, 16); s += __shfl_xor(s, 32);
                const float mw = s * (1.0f / 64.0f); float q = 0.f;
#pragma unroll
                for (int bj = 0; bj < 2; ++bj)
#pragma unroll
                    for (int n = 0; n < 2; ++n) { const f32x4 d = v[ai][bj][m][n] - mw; q += (d[0] * d[0] + d[1] * d[1]) + (d[2] * d[2] + d[3] * d[3]); }
                q += __shfl_xor(q, 16); q += __shfl_xor(q, 32);
                if (fq == 0) P[(ai * HALF + wr * 64 + m * 16 + fr) * 4 + wc] = (f32x2v){mw, q};
            }
        asm volatile("s_waitcnt lgkmcnt(0)" ::: "memory"); __builtin_amdgcn_s_barrier(); asm volatile("" ::: "memory");
#if defined(BROKEN_EXCHANGE_NO_WAIT)
#warning BROKEN CONTROL BUILD: the row-statistics exchange does not wait; results are wrong by design
        if (blockIdx.x >= 64) { const long long t0_ = clock64(); while (clock64() - t0_ < 60000) __builtin_amdgcn_s_sleep(8); }
#endif
        const int row = wid * 32 + (lane & 31);
        if (lane < 32) {
            const f32x2v a = P[row * 4 + 0], b = P[row * 4 + 1], c = P[row * 4 + 2], d = P[row * 4 + 3];
            const float mt = (a.x + b.x + c.x + d.x) * 0.25f;
            const float da = a.x - mt, db = b.x - mt, dc = c.x - mt, dd = d.x - mt;
            const float m2 = (a.y + b.y) + (c.y + d.y) + 64.0f * ((da * da + db * db) + (dc * dc + dd * dd));
            unsigned long long* slot = (unsigned long long*)xbuf + ((size_t)(u.pm * BM + row) * 4 + u.pn);
            __hip_atomic_store(slot, ((unsigned long long)__float_as_uint(m2) << 32) | __float_as_uint(mt), __ATOMIC_RELAXED, __HIP_MEMORY_SCOPE_AGENT);
        }
        asm volatile("s_waitcnt vmcnt(0)" ::: "memory");
        if (lane == 0) __hip_atomic_fetch_add(cnt + 64 * u.pm, 1u, __ATOMIC_RELAXED, __HIP_MEMORY_SCOPE_AGENT);
        if (wid == 0) {
            bool dead = false; const unsigned long long t0 = __builtin_amdgcn_s_memrealtime(); const unsigned want = 8u * (unsigned)ntn;
            for (;;) {
#if defined(BROKEN_EXCHANGE_NO_WAIT)
                break;
#endif
                if ((unsigned)__builtin_amdgcn_readfirstlane(__hip_atomic_load(cnt + 64 * u.pm, __ATOMIC_RELAXED, __HIP_MEMORY_SCOPE_AGENT)) >= want) break;
                if (__builtin_amdgcn_s_memrealtime() - t0 > 2000000ull) {
                    if (lane == 0) { unsigned expect = 0u; __hip_atomic_compare_exchange_strong(tmo + 1, &expect, code | (unsigned)(u.pm & 0xff), __ATOMIC_RELAXED, __ATOMIC_RELAXED, __HIP_MEMORY_SCOPE_AGENT);
                                     __hip_atomic_store(tmo, 1u, __ATOMIC_RELAXED, __HIP_MEMORY_SCOPE_AGENT); }
                    dead = true; break; }
                __builtin_amdgcn_s_sleep(2);
            }
            __builtin_amdgcn_fence(__ATOMIC_ACQUIRE, "agent");
            if (lane == 0) flag[0] = dead ? 1u : 0u;
        }
        asm volatile("s_waitcnt vmcnt(0) lgkmcnt(0)" ::: "memory"); __builtin_amdgcn_s_barrier(); asm volatile("" ::: "memory");
        const bool bad = flag[0] != 0u;
        if (lane < 32) {
            const unsigned long long* slot = (const unsigned long long*)xbuf + (size_t)(u.pm * BM + row) * 4; float mt[4], m2[4]; float ms = 0.f;
#pragma unroll
            for (int t = 0; t < 4; ++t) { if (t < ntn) { const unsigned long long w = __hip_atomic_load(slot + t, __ATOMIC_RELAXED, __HIP_MEMORY_SCOPE_AGENT); mt[t] = __uint_as_float((unsigned)w); m2[t] = __uint_as_float((unsigned)(w >> 32)); } else { mt[t] = 0.f; m2[t] = 0.f; } ms += mt[t]; }
            const float mean = ms / (float)ntn; float q = 0.f;
#pragma unroll
            for (int t = 0; t < 4; ++t) if (t < ntn) { const float dm = mt[t] - mean; q += m2[t] + 256.0f * dm * dm; }
            S[row] = (f32x2v){mean, 1.0f / sqrtf(q / (256.0f * (float)ntn) + eps)};
        }
        asm volatile("s_waitcnt lgkmcnt(0)" ::: "memory"); __builtin_amdgcn_s_barrier(); asm volatile("" ::: "memory");
        return bad;
    }
};
struct EpiLnRes {
    static constexpr bool PERM = false, AFTER_DRAIN = true;
    const float* base; float* out; int ldc; const float* bias; PanelStats st; unsigned poison;
    __device__ __forceinline__ void fused(f32x4 (&acc)[2][2][4][2], const Unit& u, int wr, int wc, int fr, int fq, PG8_LAS unsigned char* lds, int wid, int lane) const {
        typedef float f32x2v __attribute__((ext_vector_type(2)));
        const PG8_LAS f32x2v* S = (const PG8_LAS f32x2v*)(lds + 8192);
        const int col0 = u.pn * BM + wc * 32 + 4 * fq;
#pragma unroll
        for (int bj = 0; bj < 2; ++bj)
#pragma unroll
            for (int n = 0; n < 2; ++n) { const f32x4 bv = bias ? *(const f32x4*)(bias + col0 + bj * HALF + n * 16) : (f32x4){0.f, 0.f, 0.f, 0.f};
#pragma unroll
                for (int ai = 0; ai < 2; ++ai)
#pragma unroll
                    for (int m = 0; m < 4; ++m) acc[ai][bj][m][n] += bv; }
        f32x4 pre[4][2][2];
#pragma unroll
        for (int m = 0; m < 4; ++m) { const size_t off = (size_t)(u.pm * BM + wr * 64 + m * 16 + fr) * ldc + col0;
#pragma unroll
            for (int bj = 0; bj < 2; ++bj)
#pragma unroll
                for (int n = 0; n < 2; ++n) pre[m][bj][n] = *(const f32x4*)(base + off + bj * HALF + n * 16); }
        const bool bad = st.run(acc, u, wr, wc, fr, fq, lds, wid, lane) || poison != 0u;
        const float qnan = __builtin_nanf("");
#pragma unroll
        for (int ai = 0; ai < 2; ++ai)
#pragma unroll
            for (int m = 0; m < 4; ++m) { const int r = ai * HALF + wr * 64 + m * 16 + fr; const f32x2v sr = S[r]; const size_t off = (size_t)(u.pm * BM + r) * ldc + col0;
#pragma unroll
                for (int bj = 0; bj < 2; ++bj)
#pragma unroll
                    for (int n = 0; n < 2; ++n) { const f32x4 bs = ai == 0 ? pre[m][bj][n] : *(const f32x4*)(base + off + bj * HALF + n * 16); f32x4 o = bs + (acc[ai][bj][m][n] - sr.x) * sr.y;
                        if (bad) o = (f32x4){qnan, qnan, qnan, qnan}; *(f32x4*)(out + off + bj * HALF + n * 16) = o; }
                if (m & 1) asm volatile("" ::: "memory"); }
    }
};
struct EpiLnResLn {
    static constexpr bool PERM = false, AFTER_DRAIN = true;
    const float* base; float* out; bf16_t* xn; int ldc; const float* bias; PanelStats st1, st2; unsigned poison;
    __device__ __forceinline__ void fused(f32x4 (&acc)[2][2][4][2], const Unit& u, int wr, int wc, int fr, int fq, PG8_LAS unsigned char* lds, int wid, int lane) const {
        typedef float f32x2v __attribute__((ext_vector_type(2))); typedef unsigned u32x2v __attribute__((ext_vector_type(2)));
        const PG8_LAS f32x2v* S = (const PG8_LAS f32x2v*)(lds + 8192);
        const int col0 = u.pn * BM + wc * 32 + 4 * fq;
#pragma unroll
        for (int bj = 0; bj < 2; ++bj)
#pragma unroll
            for (int n = 0; n < 2; ++n) { const f32x4 bv = bias ? *(const f32x4*)(bias + col0 + bj * HALF + n * 16) : (f32x4){0.f, 0.f, 0.f, 0.f};
#pragma unroll
                for (int ai = 0; ai < 2; ++ai)
#pragma unroll
                    for (int m = 0; m < 4; ++m) acc[ai][bj][m][n] += bv; }
        bool bad = st1.run(acc, u, wr, wc, fr, fq, lds, wid, lane) || poison != 0u;
        const float qnan = __builtin_nanf("");
#pragma unroll
        for (int ai = 0; ai < 2; ++ai)
#pragma unroll
            for (int m = 0; m < 4; ++m) { const int r = ai * HALF + wr * 64 + m * 16 + fr; const f32x2v sr = S[r]; const size_t off = (size_t)(u.pm * BM + r) * ldc + col0;
#pragma unroll
                for (int bj = 0; bj < 2; ++bj)
#pragma unroll
                    for (int n = 0; n < 2; ++n) { const f32x4 bs = *(const f32x4*)(base + off + bj * HALF + n * 16); acc[ai][bj][m][n] = bs + (acc[ai][bj][m][n] - sr.x) * sr.y; }
                asm volatile("" : "+v"(acc[ai][0][m][0]), "+v"(acc[ai][0][m][1]), "+v"(acc[ai][1][m][0]), "+v"(acc[ai][1][m][1]));
                if (m & 1) asm volatile("" ::: "memory"); }
        const bool bad1 = bad;
        bad = st2.run(acc, u, wr, wc, fr, fq, lds, wid, lane) || bad;
#pragma unroll
        for (int ai = 0; ai < 2; ++ai)
#pragma unroll
            for (int m = 0; m < 4; ++m) { const int r = ai * HALF + wr * 64 + m * 16 + fr; const f32x2v sr = S[r]; const size_t off = (size_t)(u.pm * BM + r) * ldc + col0;
#pragma unroll
                for (int bj = 0; bj < 2; ++bj)
#pragma unroll
                    for (int n = 0; n < 2; ++n) { const f32x4 x1 = acc[ai][bj][m][n]; *(f32x4*)(out + off + bj * HALF + n * 16) = bad1 ? (f32x4){qnan, qnan, qnan, qnan} : x1;
                        const f32x4 o = (x1 - sr.x) * sr.y; u32x2v w; w.x = cvt_pk_bf16(o[0], o[1]); w.y = cvt_pk_bf16(o[2], o[3]);
                        if (bad) { w.x = 0x7fc07fc0u; w.y = 0x7fc07fc0u; } *(u32x2v*)(xn + off + bj * HALF + n * 16) = w; }
                asm volatile("" ::: "memory"); }
    }
};

template <class Epi, class Sched, bool ALIGN_EPI = false, bool SP2 = false>
__device__ __forceinline__ void gemm_phase(PG8_LAS unsigned char* lds, const Gemm g, const Sched& S, const Epi& E, const int wave_in  ) {
    int tid_o; asm volatile("v_mbcnt_lo_u32_b32 %0, -1, 0\n\tv_mbcnt_hi_u32_b32 %0, -1, %0" : "=v"(tid_o)); tid_o += wave_in * 64; asm volatile("" : "+v"(tid_o));
    const int tid = tid_o, wid = __builtin_amdgcn_readfirstlane(tid >> 6), lane = tid & 63, wr = wid >> 2, wc = wid & 3, fr = lane & 15, fq = lane >> 4;
    const int K = g.K, nt = K / BK, lda = g.lda ? g.lda : K;
    unsigned voffA[2], voffB[2];
#pragma unroll
    for (int i = 0; i < 2; ++i) { int R, C; stage_rc(tid * 16 + i * 8192, R, C); const int Rb = Epi::PERM ? ((R & ~31) + perm32(R & 31)) : R;
        voffA[i] = (unsigned)(R * lda + C) * 2u; voffB[i] = (unsigned)(Rb * K + C) * 2u; }
    const size_t kstep = (size_t)(BK * 2);
    const size_t hstep = (size_t)HALF * K * 2;
    const size_t hstepA = (size_t)HALF * lda * 2, tstepA = 2 * hstepA;
    const size_t tstep = 2 * hstep;
    const unsigned ldsw = (unsigned)wid * 1024u;
    const int aoff = lds_byte(wr * 64 + fr, fq * 8), boff = lds_byte(wc * 32 + fr, fq * 8);
#define PG8_SA(b, h) (((b) * 2 + (h)) * HTB)
#define PG8_SB(b, h) ((4 + (b) * 2 + (h)) * HTB)
#define PG8_STAGE(bufoff, gbase, voff) do { _Pragma("unroll") for (int _i = 0; _i < 2; ++_i) { const unsigned la_ = (unsigned)(size_t)(lds + (bufoff) + ldsw + _i * 8192); \
        asm volatile("s_mov_b32 m0, %2\n\ts_nop 0\n\tglobal_load_lds_dwordx4 %0, %1" :: "v"((voff)[_i]), "s"((const char*)(gbase)), "s"(la_) : "memory", "m0"); } } while (0)
#define PG8_LDA(dst, b, h) do { _Pragma("unroll") for (int m = 0; m < 4; ++m) _Pragma("unroll") for (int k = 0; k < 2; ++k) dst[m][k] = *(const PG8_LAS bf16x8*)(lds + PG8_SA(b, h) + aoff + m * 2048 + k * 1024); } while (0)
#define PG8_LDB(dst, b, h) do { _Pragma("unroll") for (int n = 0; n < 2; ++n) _Pragma("unroll") for (int k = 0; k < 2; ++k) dst[n][k] = *(const PG8_LAS bf16x8*)(lds + PG8_SB(b, h) + boff + n * 2048 + k * 1024); } while (0)
#define PG8_MMA(ai, bj, At, Bt) do { __builtin_amdgcn_s_setprio(1); _Pragma("unroll") for (int m = 0; m < 4; ++m) _Pragma("unroll") for (int n = 0; n < 2; ++n) _Pragma("unroll") for (int k = 0; k < 2; ++k) \
        acc[ai][bj][m][n] = __builtin_amdgcn_mfma_f32_16x16x32_bf16(Bt[n][k], At[m][k], acc[ai][bj][m][n], 0, 0, 0); __builtin_amdgcn_s_setprio(0); } while (0)
#define PG8_WAIT_V(n) asm volatile("s_waitcnt vmcnt(" #n ")" ::: "memory")
#define PG8_WAIT_REL(st) asm volatile("s_waitcnt vmcnt(%1)\n\ts_cmp_eq_u32 %0, 0\n\ts_cbranch_scc1 .Lpg8rel%=\n\ts_waitcnt vmcnt(8)\n.Lpg8rel%=:" :: "s"(st), "n"(8 + Epi::EPI_VMEM) : "memory", "scc")
#define PG8_WAIT_L(n) asm volatile("s_waitcnt lgkmcnt(" #n ")" ::: "memory")
#define PG8_BAR __builtin_amdgcn_s_barrier()
#define PG8_SCHED __builtin_amdgcn_sched_barrier(0)
    Unit cur, nxt; int ui = 0;
    if (!S.next(0, cur)) return;
    f32x4 acc[2][2][4][2];
#pragma unroll
    for (int a = 0; a < 2; ++a)
#pragma unroll
        for (int b = 0; b < 2; ++b)
#pragma unroll
            for (int m = 0; m < 4; ++m)
#pragma unroll
                for (int n = 0; n < 2; ++n) acc[a][b][m][n] = (f32x4){0.f, 0.f, 0.f, 0.f};
    bf16x8 At[4][2], B0[2][2], B1[2][2];
    const char* cA = (const char*)g.A + (size_t)cur.pm * tstepA; const char* cB = (const char*)g.Bt + (size_t)cur.pn * tstep;
    S.a_ready(cur);
    if constexpr (SP2) {
        PG8_STAGE(PG8_SB(0, 0), cB, voffB); PG8_STAGE(PG8_SB(0, 1), cB + hstep, voffB); PG8_STAGE(PG8_SA(0, 0), cA, voffA); PG8_STAGE(PG8_SA(0, 1), cA + hstepA, voffA);
        if (wr == 1) PG8_BAR;
        PG8_WAIT_V(2); PG8_BAR;
        PG8_STAGE(PG8_SB(1, 0), cB + kstep, voffB); PG8_STAGE(PG8_SA(1, 0), cA + kstep, voffA); PG8_STAGE(PG8_SB(1, 1), cB + hstep + kstep, voffB);
        PG8_WAIT_V(6); PG8_BAR;
    } else {
        PG8_STAGE(PG8_SB(0, 0), cB, voffB); PG8_STAGE(PG8_SA(0, 0), cA, voffA); PG8_STAGE(PG8_SB(0, 1), cB + hstep, voffB); PG8_STAGE(PG8_SA(0, 1), cA + hstepA, voffA);
        if (wr == 1) PG8_BAR;
        PG8_WAIT_V(4); PG8_BAR;
        PG8_STAGE(PG8_SB(1, 0), cB + kstep, voffB); PG8_STAGE(PG8_SA(1, 0), cA + kstep, voffA); PG8_STAGE(PG8_SB(1, 1), cB + hstep + kstep, voffB);
        PG8_WAIT_V(6); PG8_BAR;
    }
    for (;;) {
        const bool has_next = S.next(ui + 1, nxt);
        const char* nA = has_next ? (const char*)g.A + (size_t)nxt.pm * tstepA : cA; const char* nB = has_next ? (const char*)g.Bt + (size_t)nxt.pn * tstep : cB;
        for (int t = 0; t < nt; t += 2) {
            const bool last = (t == nt - 2);
            const char* a1 = cA + (size_t)(t + 1) * kstep;
            const char* a2 = last ? nA : cA + (size_t)(t + 2) * kstep; const char* b2 = last ? nB : cB + (size_t)(t + 2) * kstep;
            const char* a3 = a2 + kstep; const char* b3 = b2 + kstep;
            if (last && has_next) S.a_ready(nxt);
            const int strict = __builtin_amdgcn_readfirstlane(t | (ui == 0 ? 1 : 0));
            if constexpr (SP2) {
            PG8_LDB(B0, 0, 0); PG8_LDB(B1, 0, 1); PG8_SCHED; PG8_LDA(At, 0, 0); PG8_STAGE(PG8_SA(1, 1), a1 + hstepA, voffA);
            PG8_WAIT_REL(strict); PG8_WAIT_L(0); PG8_BAR; PG8_MMA(0, 0, At, B0); PG8_MMA(0, 1, At, B1); PG8_BAR; PG8_SCHED;
            PG8_LDA(At, 0, 1); PG8_STAGE(PG8_SB(0, 0), b2, voffB); PG8_STAGE(PG8_SB(0, 1), b2 + hstep, voffB); PG8_STAGE(PG8_SA(0, 0), a2, voffA);
            PG8_WAIT_REL(strict); PG8_WAIT_L(0); PG8_BAR; PG8_MMA(1, 0, At, B0); PG8_MMA(1, 1, At, B1); PG8_BAR; PG8_SCHED;
            PG8_LDB(B0, 1, 0); PG8_LDB(B1, 1, 1); PG8_SCHED; PG8_LDA(At, 1, 0); PG8_STAGE(PG8_SA(0, 1), a2 + hstepA, voffA);
            PG8_WAIT_V(8); PG8_WAIT_L(0); PG8_BAR; PG8_MMA(0, 0, At, B0); PG8_MMA(0, 1, At, B1); PG8_BAR; PG8_SCHED;
            PG8_LDA(At, 1, 1); PG8_STAGE(PG8_SB(1, 0), b3, voffB); PG8_STAGE(PG8_SB(1, 1), b3 + hstep, voffB); PG8_STAGE(PG8_SA(1, 0), a3, voffA);
            PG8_WAIT_V(8); PG8_WAIT_L(0); PG8_BAR; PG8_MMA(1, 0, At, B0); PG8_MMA(1, 1, At, B1); PG8_BAR; PG8_SCHED;
            if constexpr (Epi::MID_KT > 0) { if (t + 2 == Epi::MID_KT) { E.mid(acc, cur, wr, wc, fr, fq); PG8_SCHED; } }
            } else {
            PG8_LDB(B0, 0, 0); PG8_SCHED; PG8_LDA(At, 0, 0); PG8_STAGE(PG8_SA(1, 1), a1 + hstepA, voffA);
            PG8_WAIT_L(8); PG8_BAR; PG8_WAIT_L(0); PG8_MMA(0, 0, At, B0); PG8_BAR; PG8_SCHED;
            PG8_LDB(B1, 0, 1); PG8_STAGE(PG8_SB(0, 0), b2, voffB);
            PG8_BAR; PG8_WAIT_L(0); PG8_MMA(0, 1, At, B1); PG8_BAR;
            PG8_LDA(At, 0, 1); PG8_STAGE(PG8_SA(0, 0), a2, voffA);
            PG8_BAR; PG8_WAIT_L(0); PG8_MMA(1, 0, At, B0); PG8_BAR; PG8_SCHED;
            PG8_STAGE(PG8_SB(0, 1), b2 + hstep, voffB);
            PG8_WAIT_V(6); PG8_BAR; PG8_MMA(1, 1, At, B1); PG8_BAR;
            PG8_LDB(B0, 1, 0); PG8_SCHED; PG8_LDA(At, 1, 0); PG8_STAGE(PG8_SA(0, 1), a2 + hstepA, voffA);
            PG8_WAIT_L(8); PG8_BAR; PG8_WAIT_L(0); PG8_MMA(0, 0, At, B0); PG8_BAR; PG8_SCHED;
            PG8_LDB(B1, 1, 1); PG8_STAGE(PG8_SB(1, 0), b3, voffB);
            PG8_BAR; PG8_WAIT_L(0); PG8_MMA(0, 1, At, B1); PG8_BAR;
            PG8_LDA(At, 1, 1); PG8_STAGE(PG8_SA(1, 0), a3, voffA);
            PG8_BAR; PG8_WAIT_L(0); PG8_MMA(1, 0, At, B0); PG8_BAR; PG8_SCHED;
            PG8_STAGE(PG8_SB(1, 1), b3 + hstep, voffB);
            PG8_WAIT_V(6); PG8_BAR; PG8_MMA(1, 1, At, B1); PG8_BAR;
            }
        }
        if constexpr (ALIGN_EPI) { if (wr == 0) PG8_BAR; }
        if constexpr (!Epi::AFTER_DRAIN) { E(acc, cur, wr, wc, fr, fq); S.done(cur); }
        if (!has_next) break;
#pragma unroll
        for (int a = 0; a < 2; ++a)
#pragma unroll
            for (int b = 0; b < 2; ++b)
#pragma unroll
                for (int m = 0; m < 4; ++m)
#pragma unroll
                    for (int n = 0; n < 2; ++n) acc[a][b][m][n] = (f32x4){0.f, 0.f, 0.f, 0.f};
        cur = nxt; cA = nA; cB = nB; ++ui;
        if constexpr (ALIGN_EPI) { if (wr == 1) PG8_BAR; }
    }
    PG8_WAIT_V(0);
    if constexpr (!ALIGN_EPI) { if (wr == 0) PG8_BAR; }
    PG8_BAR;
    if constexpr (Epi::AFTER_DRAIN) { E.fused(acc, cur, wr, wc, fr, fq, lds, wid, lane); S.done(cur); }
#undef PG8_SA
#undef PG8_SB
#undef PG8_STAGE
#undef PG8_LDA
#undef PG8_LDB
#undef PG8_MMA
#undef PG8_WAIT_V
#undef PG8_WAIT_REL
#undef PG8_WAIT_L
#undef PG8_BAR
#undef PG8_SCHED
}
}
#define GAS __attribute__((address_space(1)))
#define LAS __attribute__((address_space(3)))
typedef unsigned short bf16;
typedef unsigned v4u __attribute__((ext_vector_type(4)));
typedef float f32x4 __attribute__((ext_vector_type(4)));
typedef short bf16x8 __attribute__((ext_vector_type(8)));
typedef GAS unsigned gu32;
typedef GAS unsigned long long gu64;
#define RLX_AGENT __ATOMIC_RELAXED, __HIP_MEMORY_SCOPE_AGENT
#define LDS_WAIT() asm volatile("s_waitcnt lgkmcnt(0)" ::: "memory")
#define VM_WAIT() asm volatile("s_waitcnt vmcnt(0)" ::: "memory")
__device__ __forceinline__ unsigned long long rt() { return __builtin_amdgcn_s_memrealtime(); }
__device__ __forceinline__ unsigned f2bf(float f) { unsigned u = __builtin_bit_cast(unsigned, f); return (u + 0x7fffu + ((u >> 16) & 1u)) >> 16; }
__device__ __forceinline__ unsigned pk2(float lo, float hi) { return f2bf(lo) | (f2bf(hi) << 16); }

#define XB_TMO      128
#define XB_XCNT(j)  (256  + 64 * (j))
#define XB_XSUB(j)  (1280 + 64 * (j))
#define XB_XGEN(j)  (2304 + 64 * (j))
#define XB_TOP      3328
#define XB_TOPGEN   3392
#define XCD_BAR_WORDS 3456
#define XB_SPIN_CAP (1u << 18)

__device__ __forceinline__ unsigned xb_ld(unsigned* p)              { return __hip_atomic_load(p, __ATOMIC_RELAXED, __HIP_MEMORY_SCOPE_AGENT); }
__device__ __forceinline__ unsigned xb_add(unsigned* p, unsigned v) { return __hip_atomic_fetch_add(p, v, __ATOMIC_RELAXED, __HIP_MEMORY_SCOPE_AGENT); }
__device__ __forceinline__ unsigned xb_xcc_id() { return (unsigned)__builtin_amdgcn_s_getreg((3 << 11) | 20) & 0xFu; }
#define XB_SPIN(cond, bar) do { unsigned _sp = 0; while (cond) { __builtin_amdgcn_s_sleep(1); \
    if ((++_sp & 255u) == 0u) { if (xb_ld(&(bar)[XB_TMO])) break; if (_sp > XB_SPIN_CAP) { atomicAdd(&(bar)[XB_TMO], 1u); break; } } } } while (0)

struct XcdBarrier {
    unsigned* bar; unsigned x;
    volatile LAS unsigned* st;
};

__device__ __forceinline__ XcdBarrier xcd_barrier_post(unsigned* bar, volatile LAS unsigned* st) {
    XcdBarrier b; b.bar = bar; b.x = xb_xcc_id(); b.st = st;
    if (threadIdx.x == 0) (void)xb_add(&bar[XB_XCNT(b.x)], 1u);
    return b;
}
__device__ __forceinline__ void xcd_barrier_complete(unsigned* bar, unsigned x, unsigned& nloc, unsigned& nx) {
    const unsigned G = gridDim.x * gridDim.y * gridDim.z;
    unsigned sum, cnt, mine, sp = 0u;
    for (;;) {
        sum = 0u; cnt = 0u; mine = 0u;
#pragma unroll
        for (unsigned j = 0; j < 16; ++j) { const unsigned c = xb_ld(&bar[XB_XCNT(j)]); sum += c; cnt += (c > 0u) ? 1u : 0u; mine = (j == x) ? c : mine; }
        if (sum == G) break;
        __builtin_amdgcn_s_sleep(1);
        if ((++sp & 255u) == 0u) { if (xb_ld(&bar[XB_TMO])) break; if (sp > XB_SPIN_CAP) { atomicAdd(&bar[XB_TMO], 1u); break; } }
    }
    nloc = mine > 0u ? mine : 1u; nx = cnt > 0u ? cnt : 1u;
}

__device__ __forceinline__ void xcd_barrier(const XcdBarrier& b, const bool thread0  ) {
    asm volatile("s_waitcnt vmcnt(0)" ::: "memory");
    __syncthreads();
    if (thread0) {
        unsigned* bar = b.bar;
        __builtin_amdgcn_s_waitcnt(0);
        unsigned nloc = b.st[0], nx = b.st[1];
        if (nloc == 0u) { xcd_barrier_complete(bar, b.x, nloc, nx); b.st[0] = nloc; b.st[1] = nx; }
        const unsigned old = xb_add(&bar[XB_XSUB(b.x)], 1u);
        const unsigned gen = old / nloc;
        if (old + 1u == (gen + 1u) * nloc) {
            __builtin_amdgcn_fence(__ATOMIC_RELEASE, "agent");
            asm volatile("s_waitcnt vmcnt(0)" ::: "memory");
            const unsigned og = xb_add(&bar[XB_TOP], 1u);
            const unsigned tg = og / nx;
            if (og + 1u == (tg + 1u) * nx) xb_add(&bar[XB_TOPGEN], 1u);
            else XB_SPIN(xb_ld(&bar[XB_TOPGEN]) == tg, bar);
            __builtin_amdgcn_fence(__ATOMIC_ACQUIRE, "agent");
            xb_add(&bar[XB_XGEN(b.x)], 1u);
            asm volatile("s_waitcnt vmcnt(0)" ::: "memory");
        } else {
            XB_SPIN(xb_ld(&bar[XB_XGEN(b.x)]) == gen, bar);
            __builtin_amdgcn_fence(__ATOMIC_ACQUIRE, "agent");
            asm volatile("s_waitcnt vmcnt(0)" ::: "memory");
        }
    }
    __syncthreads();
}

__device__ __forceinline__ void xcd_local_barrier(const XcdBarrier& b, const bool thread0) {
    asm volatile("s_waitcnt vmcnt(0)" ::: "memory");
    __syncthreads();
    if (thread0) {
        unsigned* bar = b.bar;
        __builtin_amdgcn_s_waitcnt(0);
        unsigned nloc = b.st[0]; if (nloc == 0u) nloc = 1u;
        const unsigned old = xb_add(&bar[XB_XSUB(b.x)], 1u);
        const unsigned gen = old / nloc;
        if (old + 1u == (gen + 1u) * nloc) xb_add(&bar[XB_XGEN(b.x)], 1u);
        else XB_SPIN(xb_ld(&bar[XB_XGEN(b.x)]) == gen, bar);
        __builtin_amdgcn_fence(__ATOMIC_ACQUIRE, "agent");
        asm volatile("s_waitcnt vmcnt(0)" ::: "memory");
    }
    __syncthreads();
}

#ifndef PH_MASK
#define PH_MASK 0x3ff
#endif
#define PH(n) ((PH_MASK >> (n)) & 1)
__device__ __forceinline__ int lane_now() { int l; asm volatile("v_mbcnt_lo_u32_b32 %0, -1, 0\n\tv_mbcnt_hi_u32_b32 %0, -1, %0" : "=v"(l)); return l; }
#define TID_NOW() (wave * 64 + lane_now())
#define GRID_BAR() do { XcdBarrier b2_ = bar; asm volatile("" : "+s"(b2_.x)); xcd_barrier(b2_, TID_NOW() == 0); } while (0)
#define LOCAL_BAR() do { XcdBarrier b2_ = bar; asm volatile("" : "+s"(b2_.x)); const unsigned mb_ = __builtin_amdgcn_readfirstlane(__hip_atomic_load(ctl + CW_MAP, RLX_AGENT)); \
    if (mb_ == 0u) xcd_local_barrier(b2_, TID_NOW() == 0); else xcd_barrier(b2_, TID_NOW() == 0); } while (0)
#define PHASE_IDS() int tid__ = TID_NOW(); asm volatile("" : "+v"(tid__)); const int tid = tid__, lane = tid & 63; (void)tid; (void)lane
#ifndef PROBE_DUP
#define PROBE_DUP 0
#endif
#ifndef P0SUB
#define P0SUB 7
#endif
constexpr int NWAVES = 8;
constexpr int BATCH = 16, SEQ = 4096, DM = 1024, M = BATCH * SEQ;
constexpr int INW = 9744;
constexpr int C_GQ = 4608, C_GLR = 7680, C_GA = 7696;
constexpr int NA = 4608, NB = 5120, NGLA = 3072, NGATE = 2048, FFH = 2816, NFF = 5632, AOW = 512;
constexpr float EPS = 1e-6f;
constexpr float QSCALE = 0.08838834764831845f * 1.4426950408889634f;
constexpr float GLA_QS = 0.08838834764831845f;

constexpr size_t MiB = 1u << 20;
constexpr size_t WS_CTL = 0, CTL_ZERO_BYTES = 1 * MiB;
constexpr int CW_TMO = 0, CW_MAP = 64, CW_BAR = 4096;
constexpr size_t WS_SSQ1 = 256 * 1024, WS_SSQ2 = 512 * 1024;
constexpr size_t WS_ROPE = 1 * MiB;
constexpr size_t WS_GLR = 2 * MiB;
constexpr size_t WS_WB = 6 * MiB, WS_WA = 16 * MiB, WS_WBA = 25 * MiB, WS_WBB = 26 * MiB, WS_WOUT = 28 * MiB, WS_WFF = 30 * MiB, WS_WDN = 41 * MiB;
constexpr size_t WS_H = 48 * MiB;
constexpr size_t WS_CAT = 176 * MiB;
constexpr size_t WS_BIG = 368 * MiB;
constexpr size_t WS_MIX = 368 * MiB, WS_X1B = 496 * MiB, WS_ACT = 624 * MiB;
constexpr size_t WS_OG01 = 48 * MiB, WS_OG2 = 944 * MiB, WS_ML = 1008 * MiB;
constexpr size_t WS_SLOC = 752 * MiB, WS_LOGD = 784 * MiB;
constexpr size_t WS_END = 1024 * MiB;
static_assert(WS_CAT + (size_t)M * 1536 * 2 <= WS_BIG && WS_BIG + (size_t)M * NA * 2 <= WS_OG2 && WS_ACT + (size_t)M * FFH * 2 <= WS_END && WS_BIG + (size_t)M * NGLA * 2 <= WS_SLOC, "ws map");

constexpr int RING_OFF = 0, RING_BYTES = 131072;
constexpr int LDSCTL_OFF = RING_BYTES, MISC_OFF = LDSCTL_OFF + 320;
constexpr int LDS_BYTES = 147456;

#define ST16_S(sbase, voff, data, IMM) asm volatile("global_store_dwordx4 %0, %1, %2 offset:" #IMM "\n\ts_nop 4" :: "v"(voff), "v"(data), "s"(sbase) : "memory")
__device__ __forceinline__ float bf2f(unsigned short b) { return __builtin_bit_cast(float, (unsigned)b << 16); }
__device__ __forceinline__ float bflo(unsigned w) { return __builtin_bit_cast(float, w << 16); }
__device__ __forceinline__ float bfhi(unsigned w) { return __builtin_bit_cast(float, w & 0xffff0000u); }
__device__ __forceinline__ float wave_sum(float v) {
#pragma unroll
    for (int o = 1; o < 64; o <<= 1) v += __shfl_xor(v, o);
    return v;
}
__device__ __forceinline__ float wave_max(float v) {
#pragma unroll
    for (int o = 1; o < 64; o <<= 1) v = fmaxf(v, __shfl_xor(v, o));
    return v;
}
#define WG_BAR() do { asm volatile("s_waitcnt lgkmcnt(0)" ::: "memory"); __builtin_amdgcn_s_barrier(); asm volatile("" ::: "memory"); } while (0)
__device__ __forceinline__ float sigmoidf_(float v) { return 1.0f / (1.0f + __expf(-v)); }

namespace pg8 {
struct EpiB {
    static constexpr bool PERM = true, AFTER_DRAIN = false; static constexpr int MID_KT = 0, EPI_VMEM = 16;
    bf16_t* __restrict__ G; bf16_t* __restrict__ GRp; bf16_t* __restrict__ GSp;
    __device__ __forceinline__ void operator()(const f32x4 (&acc)[2][2][4][2], const Unit& u, int wr, int wc, int fr, int fq) const {
        const int row0 = u.pm * BM + wr * 64 + fr; const int colt = u.pn * BM; constexpr float L2E = 1.4426950408889634f;
        if (colt >= 3072) {
            const int j0 = ((colt - 3072) >> 1) + wc * 32 + 8 * fq;
#pragma unroll
            for (int ai = 0; ai < 2; ++ai)
#pragma unroll
                for (int m = 0; m < 4; ++m) { const unsigned off = (unsigned)((row0 + ai * HALF + m * 16) * 1024 + j0) * 2u; float rv[8], sv[8];
#pragma unroll
                    for (int n = 0; n < 2; ++n)
#pragma unroll
                        for (int e = 0; e < 4; ++e) { const float ga = acc[ai][0][m][n][e], gb = fmaxf(acc[ai][1][m][n][e], -30.0f);
                            const float ea = __builtin_amdgcn_exp2f(-L2E * ga), eb = __builtin_amdgcn_exp2f(-L2E * gb);
                            sv[4 * n + e] = __builtin_amdgcn_rcpf(1.0f + eb); rv[4 * n + e] = (1.0f + eb) * __builtin_amdgcn_rcpf(1.0f + ea); }
                    u32x4 w; w.x = cvt_pk_bf16(rv[0], rv[1]); w.y = cvt_pk_bf16(rv[2], rv[3]); w.z = cvt_pk_bf16(rv[4], rv[5]); w.w = cvt_pk_bf16(rv[6], rv[7]); *(u32x4*)((char*)GRp + off) = w;
                    u32x4 w2; w2.x = cvt_pk_bf16(sv[0], sv[1]); w2.y = cvt_pk_bf16(sv[2], sv[3]); w2.z = cvt_pk_bf16(sv[4], sv[5]); w2.w = cvt_pk_bf16(sv[6], sv[7]); *(u32x4*)((char*)GSp + off) = w2; }
            return; }
        bf16_t* base = G + colt; const int col0 = wc * 32 + 8 * fq;
#pragma unroll
        for (int ai = 0; ai < 2; ++ai)
#pragma unroll
            for (int m = 0; m < 4; ++m) { const unsigned rowo = (unsigned)((row0 + ai * HALF + m * 16) * 3072 + col0) * 2u;
#pragma unroll
                for (int bj = 0; bj < 2; ++bj) { f32x4 v0 = acc[ai][bj][m][0], v1 = acc[ai][bj][m][1];
                    if (colt >= 2048) {
#pragma unroll
                        for (int e = 0; e < 4; ++e) { v0[e] = v0[e] * __builtin_amdgcn_rcpf(1.0f + __builtin_amdgcn_exp2f(-L2E * v0[e])); v1[e] = v1[e] * __builtin_amdgcn_rcpf(1.0f + __builtin_amdgcn_exp2f(-L2E * v1[e])); } }
                    else if (colt < 512) { v0 = v0 * GLA_QS; v1 = v1 * GLA_QS; }
                    u32x4 w; w.x = cvt_pk_bf16(v0[0], v0[1]); w.y = cvt_pk_bf16(v0[2], v0[3]); w.z = cvt_pk_bf16(v1[0], v1[1]); w.w = cvt_pk_bf16(v1[2], v1[3]);
                    *(u32x4*)((char*)base + (rowo + (unsigned)(bj * HALF * 2))) = w; } }
    }
};
struct EpiA {
    static constexpr bool PERM = true, AFTER_DRAIN = false; static constexpr int MID_KT = 0, EPI_VMEM = 16;
    bf16_t* __restrict__ O; const float* __restrict__ rope; float qsc;
    __device__ __forceinline__ void operator()(const f32x4 (&acc)[2][2][4][2], const Unit& u, int wr, int wc, int fr, int fq) const {
        const int row0 = u.pm * BM + wr * 64 + fr; const int colt = u.pn * BM;
        const int col0 = colt + wc * 32 + 8 * fq;
        const bool dorope = (colt < 3072) && (wc == 0);
        const float sc = (colt < 1536) ? qsc : 1.0f;
        f32x4 csv[2][4], snv[2][4];
        if (dorope) {
#pragma unroll
            for (int ai = 0; ai < 2; ++ai)
#pragma unroll
                for (int m = 0; m < 4; ++m) { const float* tp = rope + (size_t)((row0 + ai * HALF + m * 16) & (SEQ_MASK)) * 32 + 4 * fq; csv[ai][m] = *(const f32x4*)tp; snv[ai][m] = *(const f32x4*)(tp + 16); } }
#pragma unroll
        for (int ai = 0; ai < 2; ++ai)
#pragma unroll
            for (int m = 0; m < 4; ++m) { const int row = row0 + ai * HALF + m * 16; const unsigned rowo = (unsigned)(row * 4608 + col0) * 2u;
                f32x4 cs = {1.f, 1.f, 1.f, 1.f}, sn = {0.f, 0.f, 0.f, 0.f};
                if (dorope) { cs = csv[ai][m]; sn = snv[ai][m]; }
#pragma unroll
                for (int bj = 0; bj < 2; ++bj) { f32x4 v0 = acc[ai][bj][m][0], v1 = acc[ai][bj][m][1];
                    if (dorope) {
                        f32x4 a, b;
                        a[0] = v0[0] * cs[0] - v0[1] * sn[0]; a[1] = v0[1] * cs[0] + v0[0] * sn[0];
                        a[2] = v0[2] * cs[1] - v0[3] * sn[1]; a[3] = v0[3] * cs[1] + v0[2] * sn[1];
                        b[0] = v1[0] * cs[2] - v1[1] * sn[2]; b[1] = v1[1] * cs[2] + v1[0] * sn[2];
                        b[2] = v1[2] * cs[3] - v1[3] * sn[3]; b[3] = v1[3] * cs[3] + v1[2] * sn[3];
                        v0 = a; v1 = b; }
                    v0 = v0 * sc; v1 = v1 * sc;
                    u32x4 w; w.x = cvt_pk_bf16(v0[0], v0[1]); w.y = cvt_pk_bf16(v0[2], v0[3]); w.z = cvt_pk_bf16(v1[0], v1[1]); w.w = cvt_pk_bf16(v1[2], v1[3]);
                    *(u32x4*)((char*)O + (rowo + (unsigned)(bj * HALF * 2))) = w; } }
    }
    static constexpr int SEQ_MASK = 4095;
};
struct EpiMixF {
    static constexpr bool PERM = true, AFTER_DRAIN = false; static constexpr int MID_KT = 8, EPI_VMEM = 16;
    const bf16_t* __restrict__ GRp; const bf16_t* __restrict__ GSp; bf16_t* __restrict__ O;
    template <bool FINAL> __device__ __forceinline__ void run(f32x4 (&acc)[2][2][4][2], const Unit& u, int wr, int wc, int fr, int fq) const {
        const int row0 = u.pm * BM + wr * 64 + fr; const int col0 = u.pn * BM + wc * 32 + 8 * fq; const bf16_t* gp = FINAL ? GSp : GRp;
        constexpr int MB = FINAL ? 4 : 4;
#pragma unroll
        for (int ai = 0; ai < 2; ++ai)
#pragma unroll
        for (int mb = 0; mb < 4; mb += MB) {
            u32x4 gv[MB][2];
#pragma unroll
            for (int m = 0; m < MB; ++m)
#pragma unroll
                for (int bj = 0; bj < 2; ++bj) gv[m][bj] = __builtin_nontemporal_load((const u32x4*)((const char*)gp + (unsigned)((row0 + ai * HALF + (mb + m) * 16) * 1024 + col0 + bj * HALF) * 2u));
#pragma unroll
            for (int mm = 0; mm < MB; ++mm)
#pragma unroll
                for (int bj = 0; bj < 2; ++bj) { const int m = mb + mm; const u32x4 g = gv[mm][bj]; f32x4 v0 = acc[ai][bj][m][0], v1 = acc[ai][bj][m][1];
                    v0[0] *= __builtin_bit_cast(float, g.x << 16); v0[1] *= __builtin_bit_cast(float, g.x & 0xffff0000u);
                    v0[2] *= __builtin_bit_cast(float, g.y << 16); v0[3] *= __builtin_bit_cast(float, g.y & 0xffff0000u);
                    v1[0] *= __builtin_bit_cast(float, g.z << 16); v1[1] *= __builtin_bit_cast(float, g.z & 0xffff0000u);
                    v1[2] *= __builtin_bit_cast(float, g.w << 16); v1[3] *= __builtin_bit_cast(float, g.w & 0xffff0000u);
                    if (FINAL) { u32x4 w; w.x = cvt_pk_bf16(v0[0], v0[1]); w.y = cvt_pk_bf16(v0[2], v0[3]); w.z = cvt_pk_bf16(v1[0], v1[1]); w.w = cvt_pk_bf16(v1[2], v1[3]);
                        *(u32x4*)((char*)O + (unsigned)((row0 + ai * HALF + m * 16) * 1024 + col0 + bj * HALF) * 2u) = w; }
                    else { acc[ai][bj][m][0] = v0; acc[ai][bj][m][1] = v1; } } }
    }
    __device__ __forceinline__ void mid(f32x4 (&acc)[2][2][4][2], const Unit& u, int wr, int wc, int fr, int fq) const { int fr2 = fr, fq2 = fq; asm volatile("" : "+v"(fr2), "+v"(fq2));
        run<false>(acc, u, wr, wc, fr2, fq2); }
    __device__ __forceinline__ void operator()(const f32x4 (&acc)[2][2][4][2], const Unit& u, int wr, int wc, int fr, int fq) const { run<true>(const_cast<f32x4 (&)[2][2][4][2]>(acc), u, wr, wc, fr, fq); }
};
struct EpiX1 {
    static constexpr bool PERM = true, AFTER_DRAIN = false; static constexpr int MID_KT = 0, EPI_VMEM = 16;
    const float* __restrict__ base; bf16_t* __restrict__ ob; float* __restrict__ ssq;
    __device__ __forceinline__ void operator()(const f32x4 (&acc)[2][2][4][2], const Unit& u, int wr, int wc, int fr, int fq) const {
        const int row0 = u.pm * BM + wr * 64 + fr, col0 = u.pn * BM + wc * 32 + 8 * fq;
#pragma unroll
        for (int ai = 0; ai < 2; ++ai) {
            f32x4 bv[4][2][2];
#pragma unroll
            for (int m = 0; m < 4; ++m)
#pragma unroll
                for (int bj = 0; bj < 2; ++bj) { const unsigned off = (unsigned)((row0 + ai * HALF + m * 16) * 1024 + col0 + bj * HALF) * 4u; bv[m][bj][0] = __builtin_nontemporal_load((const f32x4*)((const char*)base + off)); bv[m][bj][1] = __builtin_nontemporal_load((const f32x4*)((const char*)base + (off + 16u))); }
#pragma unroll
            for (int m = 0; m < 4; ++m) { const int row = row0 + ai * HALF + m * 16; const unsigned off = (unsigned)(row * 4608 + col0) * 2u; float s = 0.f;
#pragma unroll
                for (int bj = 0; bj < 2; ++bj) { const f32x4 o0 = bv[m][bj][0] + acc[ai][bj][m][0], o1 = bv[m][bj][1] + acc[ai][bj][m][1];
                    s += (o0[0] * o0[0] + o0[1] * o0[1]) + (o0[2] * o0[2] + o0[3] * o0[3]) + (o1[0] * o1[0] + o1[1] * o1[1]) + (o1[2] * o1[2] + o1[3] * o1[3]);
                    u32x4 w; w.x = cvt_pk_bf16(o0[0], o0[1]); w.y = cvt_pk_bf16(o0[2], o0[3]); w.z = cvt_pk_bf16(o1[0], o1[1]); w.w = cvt_pk_bf16(o1[2], o1[3]);
                    *(u32x4*)((char*)ob + (off + (unsigned)(bj * HALF * 2))) = w; }
                s += __shfl_xor(s, 16); s += __shfl_xor(s, 32);
                if (fq == 0) __hip_atomic_fetch_add(ssq + row, s, __ATOMIC_RELAXED, __HIP_MEMORY_SCOPE_AGENT); } }
    }
};
struct EpiX2 {
    static constexpr bool PERM = true, AFTER_DRAIN = false; static constexpr int MID_KT = 0, EPI_VMEM = 16;
    const bf16_t* __restrict__ base; bf16_t* __restrict__ ob; float* __restrict__ ssq;
    __device__ __forceinline__ void operator()(const f32x4 (&acc)[2][2][4][2], const Unit& u, int wr, int wc, int fr, int fq) const {
        const int row0 = u.pm * BM + wr * 64 + fr, col0 = u.pn * BM + wc * 32 + 8 * fq;
#pragma unroll
        for (int ai = 0; ai < 2; ++ai) {
            u32x4 tv[4][2];
#pragma unroll
            for (int m = 0; m < 4; ++m)
#pragma unroll
                for (int bj = 0; bj < 2; ++bj) tv[m][bj] = *(const u32x4*)((const char*)base + (unsigned)((row0 + ai * HALF + m * 16) * 4608 + col0 + bj * HALF) * 2u);
#pragma unroll
            for (int m = 0; m < 4; ++m) { const int row = row0 + ai * HALF + m * 16; const unsigned off = (unsigned)(row * 1024 + col0) * 2u; float s = 0.f;
#pragma unroll
                for (int bj = 0; bj < 2; ++bj) { const u32x4 t = tv[m][bj];
                    f32x4 o0 = acc[ai][bj][m][0], o1 = acc[ai][bj][m][1];
                    o0[0] += __builtin_bit_cast(float, t.x << 16); o0[1] += __builtin_bit_cast(float, t.x & 0xffff0000u); o0[2] += __builtin_bit_cast(float, t.y << 16); o0[3] += __builtin_bit_cast(float, t.y & 0xffff0000u);
                    o1[0] += __builtin_bit_cast(float, t.z << 16); o1[1] += __builtin_bit_cast(float, t.z & 0xffff0000u); o1[2] += __builtin_bit_cast(float, t.w << 16); o1[3] += __builtin_bit_cast(float, t.w & 0xffff0000u);
                    s += (o0[0] * o0[0] + o0[1] * o0[1]) + (o0[2] * o0[2] + o0[3] * o0[3]) + (o1[0] * o1[0] + o1[1] * o1[1]) + (o1[2] * o1[2] + o1[3] * o1[3]);
                    u32x4 w; w.x = cvt_pk_bf16(o0[0], o0[1]); w.y = cvt_pk_bf16(o0[2], o0[3]); w.z = cvt_pk_bf16(o1[0], o1[1]); w.w = cvt_pk_bf16(o1[2], o1[3]);
                    *(u32x4*)((char*)ob + (off + (unsigned)(bj * HALF * 2))) = w; }
                s += __shfl_xor(s, 16); s += __shfl_xor(s, 32);
                if (fq == 0) __hip_atomic_fetch_add(ssq + row, s, __ATOMIC_RELAXED, __HIP_MEMORY_SCOPE_AGENT); } }
    }
};
struct EpiSwi {
    static constexpr bool PERM = true, AFTER_DRAIN = false; static constexpr int MID_KT = 0, EPI_VMEM = 8;
    bf16_t* __restrict__ O; const float* __restrict__ ssq;
    __device__ __forceinline__ void operator()(const f32x4 (&acc)[2][2][4][2], const Unit& u, int wr, int wc, int fr, int fq) const {
        const int row0 = u.pm * BM + wr * 64 + fr; const int col0 = u.pn * HALF + wc * 32 + 8 * fq;
        float sv[2][4];
#pragma unroll
        for (int ai = 0; ai < 2; ++ai)
#pragma unroll
            for (int m = 0; m < 4; ++m) sv[ai][m] = ssq[row0 + ai * HALF + m * 16];
#pragma unroll
        for (int ai = 0; ai < 2; ++ai)
#pragma unroll
            for (int m = 0; m < 4; ++m) { const int row = row0 + ai * HALF + m * 16; const float r = __builtin_amdgcn_rsqf(sv[ai][m] * (1.0f / 1024.0f) + EPS);
                f32x4 o[2];
#pragma unroll
                for (int n = 0; n < 2; ++n)
#pragma unroll
                    for (int e = 0; e < 4; ++e) { const float g = acc[ai][0][m][n][e] * r, uu = acc[ai][1][m][n][e] * r; o[n][e] = g * __builtin_amdgcn_rcpf(1.0f + __builtin_amdgcn_exp2f(-1.4426950408889634f * g)) * uu; }
                u32x4 w; w.x = cvt_pk_bf16(o[0][0], o[0][1]); w.y = cvt_pk_bf16(o[0][2], o[0][3]); w.z = cvt_pk_bf16(o[1][0], o[1][1]); w.w = cvt_pk_bf16(o[1][2], o[1][3]);
                *(u32x4*)((char*)O + (unsigned)(row * 4608 + col0) * 2u) = w; }
    }
};
struct EpiNull { static constexpr bool PERM = true, AFTER_DRAIN = false; static constexpr int MID_KT = 0, EPI_VMEM = 0;
    __device__ __forceinline__ void operator()(const f32x4 (&acc)[2][2][4][2], const Unit& u, int wr, int wc, int fr, int fq) const {
#pragma unroll
        for (int ai = 0; ai < 2; ++ai)
#pragma unroll
            for (int bj = 0; bj < 2; ++bj)
#pragma unroll
                for (int m = 0; m < 4; ++m) asm volatile("" :: "v"(acc[ai][bj][m][0]), "v"(acc[ai][bj][m][1])); } };
}

__device__ __forceinline__ void tr_item(const float* W, int ldw, int K, bf16* WT, int n0, int scb, bool rope, const float* kscale, int k0, LAS float* scr, int lane, int KD = 0, int koff = 0) {
    if (KD == 0) KD = K;
    float tv[32];
#pragma unroll
    for (int i = 0; i < 32; ++i) { const int kk = 2 * i + (lane >> 5); tv[i] = __builtin_nontemporal_load(&W[(size_t)(k0 + kk) * ldw + scb + (lane & 31)]); }
    if (kscale) {
#pragma unroll
        for (int i = 0; i < 32; ++i) tv[i] *= kscale[k0 + 2 * i + (lane >> 5)]; }
#pragma unroll
    for (int i = 0; i < 32; ++i) { const int kk = 2 * i + (lane >> 5); scr[kk * 33 + (lane & 31)] = tv[i]; }
    LDS_WAIT(); asm volatile("" ::: "memory");
    const int c = lane & 7;
#pragma unroll
    for (int j = 0; j < 4; ++j) { const int n = (lane >> 3) + 8 * j; const int sn = rope ? ((n >> 1) + 16 * (n & 1)) : n; const LAS float* s = scr + (8 * c) * 33 + sn;
        v4u o; o.x = pk2(s[0 * 33], s[1 * 33]); o.y = pk2(s[2 * 33], s[3 * 33]); o.z = pk2(s[4 * 33], s[5 * 33]); o.w = pk2(s[6 * 33], s[7 * 33]);
        *(GAS v4u*)(WT + (size_t)(n0 + n) * KD + koff + k0 + 8 * c) = o; }
    LDS_WAIT(); asm volatile("" ::: "memory");
}


typedef float f32x16 __attribute__((ext_vector_type(16)));
typedef short s16x4 __attribute__((ext_vector_type(4)));
typedef short v4i16_t __attribute__((ext_vector_type(4)));
__device__ __forceinline__ unsigned img_off(unsigned row, unsigned ch) { return 256u * row + 16u * (ch ^ (((row & 3u) << 2) | ((row >> 2) & 3u))); }
__device__ __forceinline__ unsigned img_tr_off(unsigned lane, unsigned R0, unsigned c) { const unsigned blk = (lane >> 4) & 1u, q = (lane & 15u) >> 2, p = lane & 3u; return img_off(R0 + q, 4u * c + 2u * blk + (p >> 1)) + 8u * (p & 1u); }
__device__ __forceinline__ s16x4 img_tr_read(const LAS unsigned char* p) { return __builtin_bit_cast(s16x4, __builtin_amdgcn_ds_read_tr16_b64_v4i16((LAS v4i16_t*)p)); }
constexpr int ALDS_BUF = 32768, ALDS_BYTES = 3 * ALDS_BUF;
static_assert(ALDS_BYTES <= RING_BYTES, "attention lds");
__device__ __forceinline__ unsigned cvtpk2(float lo, float hi) { unsigned r; asm volatile("v_cvt_pk_bf16_f32 %0, %1, %2" : "=v"(r) : "v"(lo), "v"(hi)); return r; }
typedef unsigned u32x2t __attribute__((ext_vector_type(2)));
__device__ __forceinline__ v4u widen_pair(u32x2t a, u32x2t b) {
    const auto r0 = __builtin_amdgcn_permlane32_swap(a.x, b.x, false, false); const auto r1 = __builtin_amdgcn_permlane32_swap(a.y, b.y, false, false);
    v4u w; w.x = r0[0]; w.y = r1[0]; w.z = r0[1]; w.w = r1[1]; return w; }
__device__ __forceinline__ void unwiden_pair(v4u L, u32x2t& a, u32x2t& b) {
    const auto r0 = __builtin_amdgcn_permlane32_swap(L.x, L.z, false, false); const auto r1 = __builtin_amdgcn_permlane32_swap(L.y, L.w, false, false);
    a.x = r0[0]; a.y = r1[0]; b.x = r0[1]; b.y = r1[1]; }
template <bool MERGE>
__device__ __forceinline__ void attn_stream(LAS unsigned char* lds, const bf16* PA, bf16* OG01, bf16* OG2, float* MLbase, bf16* CATp, int b, int h, int c, int i0, int nq, int tid, int lane, int wave) {
    typedef unsigned u32x2v __attribute__((ext_vector_type(2)));
    const int g = h >> 2, j = h & 3, r = 1 << (2 * g);
    const size_t rowb = (size_t)b * SEQ;
    const int l31 = lane & 31, hi = lane >> 5;
    const int nkb = nq >> 8;
    const int T = (nq >> 6) + 2, tt0 = (i0 == 0) ? 2 : 0;
    bf16* ogb = ((g == 2) ? OG2 : OG01) + j * 128; const int ogs = (g == 2) ? AOW : 2 * AOW;
    float* mlb = MLbase + (size_t)g * M * 8 + j * 2;
    v4u qf[8], qn[8]; f32x16 o[4]; float mrun = -1e30f, lrun = 0.f;
    int iq = i0 + 32 * wave + l31;
#pragma unroll
    for (int s = 0; s < 8; ++s) qf[s] = *(const v4u*)(PA + (rowb + (size_t)iq * r + c) * NA + h * 128 + 16 * s + 8 * hi);
#pragma unroll
    for (int d = 0; d < 4; ++d)
#pragma unroll
        for (int e = 0; e < 16; ++e) o[d][e] = 0.f;
    int koff[2];
    { const int q4 = lane >> 4, slot = lane & 15;
#pragma unroll
      for (int i = 0; i < 2; ++i) { const int row = 8 * wave + 4 * i + q4; const int ch = slot ^ (((row & 3) << 2) | ((row >> 2) & 3)); koff[i] = row * r * NA + ch * 8; } }
#define ATT_DMA(TILE, BUF) do { const bf16* kt_ = PA + (rowb + (size_t)((i0 - 128 + 64 * (TILE)) * r) + c) * NA + 1536 + h * 128; \
        _Pragma("unroll") for (int i_ = 0; i_ < 2; ++i_) { \
            __builtin_amdgcn_global_load_lds((const unsigned*)(kt_ + koff[i_]), (LAS unsigned*)(lds + (BUF) * ALDS_BUF + 256 * (8 * wave + 4 * i_)), 16, 0, 0); \
            __builtin_amdgcn_global_load_lds((const unsigned*)(kt_ + 1536 + koff[i_]), (LAS unsigned*)(lds + (BUF) * ALDS_BUF + 16384 + 256 * (8 * wave + 4 * i_)), 16, 0, 0); } } while (0)
    WG_BAR();
    ATT_DMA(tt0, 0);
    if (tt0 + 1 < T) ATT_DMA(tt0 + 1, 1);
    asm volatile("" :: "v"(qf[0]), "v"(qf[1]), "v"(qf[2]), "v"(qf[3]), "v"(qf[4]), "v"(qf[5]), "v"(qf[6]), "v"(qf[7]) : "memory");
    asm volatile("s_waitcnt vmcnt(0)" ::: "memory");
    WG_BAR();
    int cur = 0; bool pending = false;
#define ATT_FINAL() do { int hi_ = hi; asm volatile("" : "+v"(hi_));     \
        const float ltot_ = lrun + __shfl_xor(lrun, 32); const size_t qrow_ = rowb + (size_t)iq * r + c; \
        if constexpr (!MERGE) { const float il_ = __builtin_amdgcn_rcpf(ltot_); bf16* orow_ = ogb + qrow_ * ogs + 8 * hi_; \
            _Pragma("unroll") for (int d_ = 0; d_ < 4; ++d_) _Pragma("unroll") for (int p_ = 0; p_ < 2; ++p_) { u32x2t a_, b_; \
                a_.x = cvtpk2(o[d_][8 * p_] * il_, o[d_][8 * p_ + 1] * il_); a_.y = cvtpk2(o[d_][8 * p_ + 2] * il_, o[d_][8 * p_ + 3] * il_); \
                b_.x = cvtpk2(o[d_][8 * p_ + 4] * il_, o[d_][8 * p_ + 5] * il_); b_.y = cvtpk2(o[d_][8 * p_ + 6] * il_, o[d_][8 * p_ + 7] * il_); \
                *(v4u*)(orow_ + d_ * 32 + 16 * p_) = widen_pair(a_, b_); } \
            if (hi_ == 0) { typedef float f32x2v_ __attribute__((ext_vector_type(2))); *(f32x2v_*)(mlb + qrow_ * 8) = (f32x2v_){mrun, ltot_}; } } \
        else { typedef float f32x2v_ __attribute__((ext_vector_type(2))); \
            const f32x2v_ ml1_ = *(const f32x2v_*)(MLbase + ((size_t)1 * M + qrow_) * 8 + j * 2), ml2_ = *(const f32x2v_*)(MLbase + ((size_t)2 * M + qrow_) * 8 + j * 2); \
            const bf16* o1p_ = OG01 + qrow_ * (2 * AOW) + j * 128 + 8 * hi_; const bf16* o2p_ = OG2 + qrow_ * AOW + j * 128 + 8 * hi_; \
            v4u g1_[4][2], g2_[4][2]; \
            _Pragma("unroll") for (int d_ = 0; d_ < 4; ++d_) _Pragma("unroll") for (int p_ = 0; p_ < 2; ++p_) { g1_[d_][p_] = *(const v4u*)(o1p_ + d_ * 32 + 16 * p_); g2_[d_][p_] = *(const v4u*)(o2p_ + d_ * 32 + 16 * p_); } \
            const float mm_ = fmaxf(mrun, fmaxf(ml1_.x, ml2_.x)); const float a0_ = __builtin_amdgcn_exp2f(mrun - mm_), w1_ = ml1_.y * __builtin_amdgcn_exp2f(ml1_.x - mm_), w2_ = ml2_.y * __builtin_amdgcn_exp2f(ml2_.x - mm_); \
            const float inv_ = __builtin_amdgcn_rcpf(ltot_ * a0_ + w1_ + w2_); const float s0_ = a0_ * inv_, s1_ = w1_ * inv_, s2_ = w2_ * inv_; \
            bf16* crow_ = CATp + qrow_ * 1536 + j * 128 + 8 * hi_; \
            _Pragma("unroll") for (int d_ = 0; d_ < 4; ++d_) _Pragma("unroll") for (int p_ = 0; p_ < 2; ++p_) { u32x2t a1_, b1_, a2_, b2_; unwiden_pair(g1_[d_][p_], a1_, b1_); unwiden_pair(g2_[d_][p_], a2_, b2_); u32x2t ya_, yb_; \
                ya_.x = cvtpk2(o[d_][8 * p_] * s0_ + bflo(a1_.x) * s1_ + bflo(a2_.x) * s2_, o[d_][8 * p_ + 1] * s0_ + bfhi(a1_.x) * s1_ + bfhi(a2_.x) * s2_); \
                ya_.y = cvtpk2(o[d_][8 * p_ + 2] * s0_ + bflo(a1_.y) * s1_ + bflo(a2_.y) * s2_, o[d_][8 * p_ + 3] * s0_ + bfhi(a1_.y) * s1_ + bfhi(a2_.y) * s2_); \
                yb_.x = cvtpk2(o[d_][8 * p_ + 4] * s0_ + bflo(b1_.x) * s1_ + bflo(b2_.x) * s2_, o[d_][8 * p_ + 5] * s0_ + bfhi(b1_.x) * s1_ + bfhi(b2_.x) * s2_); \
                yb_.y = cvtpk2(o[d_][8 * p_ + 6] * s0_ + bflo(b1_.y) * s1_ + bflo(b2_.y) * s2_, o[d_][8 * p_ + 7] * s0_ + bfhi(b1_.y) * s1_ + bfhi(b2_.y) * s2_); \
                *(v4u*)(crow_ + d_ * 32 + 16 * p_) = widen_pair(ya_, yb_); } } } while (0)
#pragma unroll 1
    for (int tt = tt0; tt < T; ++tt) {
        const LAS unsigned char* Kb = lds + cur * ALDS_BUF; const LAS unsigned char* Vb = Kb + 16384;
        const int rel = tt - (wave >> 1), kb_ = rel >> 2, ph = rel & 3;
        const bool fin = (rel >= 0 && kb_ < nkb && ph == 3 && pending), nxq = fin && (kb_ + 1 < nkb), dma = (tt + 2 < T);
        const bool qpre = (rel >= 0 && kb_ + 1 < nkb && ph == 2);
        if (qpre) {
            int hq_ = hi; asm volatile("" : "+v"(hq_));
#pragma unroll
            for (int s = 0; s < 8; ++s) qn[s] = *(const v4u*)(PA + (rowb + (size_t)(iq + 256) * r + c) * NA + h * 128 + 16 * s + 8 * hq_); }
        if (fin) {
            ATT_FINAL(); pending = false;
            if (nxq) { iq += 256;
#pragma unroll
                for (int s = 0; s < 8; ++s) qf[s] = qn[s];
#pragma unroll
                for (int d = 0; d < 4; ++d)
#pragma unroll
                    for (int e = 0; e < 16; ++e) o[d][e] = 0.f;
                mrun = -1e30f; lrun = 0.f; } }
        asm volatile("" ::: "memory");
        if (dma) ATT_DMA(tt + 2, cur >= 1 ? cur - 1 : 2);
        asm volatile("" ::: "memory");
        if (rel >= 0 && kb_ < nkb && ph < 3) {
            const bool do0 = !((wave & 1) && ph == 0), do1 = !(!(wave & 1) && ph == 2);
            f32x16 s0, s1;
#pragma unroll
            for (int e = 0; e < 16; ++e) { s0[e] = 0.f; s1[e] = 0.f; }
            if (do0) {
#pragma unroll
                for (int s = 0; s < 8; ++s) { const bf16x8 a0 = *(const LAS bf16x8*)(Kb + img_off(l31, 2 * s + hi)); s0 = __builtin_amdgcn_mfma_f32_32x32x16_bf16(a0, __builtin_bit_cast(bf16x8, qf[s]), s0, 0, 0, 0); } }
            if (do1) {
#pragma unroll
                for (int s = 0; s < 8; ++s) { const bf16x8 a1 = *(const LAS bf16x8*)(Kb + img_off(32 + l31, 2 * s + hi)); s1 = __builtin_amdgcn_mfma_f32_32x32x16_bf16(a1, __builtin_bit_cast(bf16x8, qf[s]), s1, 0, 0, 0); } }
            const int dq = iq - (i0 - 128 + 64 * tt) - 4 * hi;
            float mx = -__builtin_inff();
            if (ph != 1) {
#pragma unroll
                for (int e = 0; e < 16; ++e) { const int ko = (e & 3) + 8 * (e >> 2);
                    if ((unsigned)(dq - ko) > 128u) s0[e] = -__builtin_inff();
                    if ((unsigned)(dq - ko - 32) > 128u) s1[e] = -__builtin_inff(); } }
            if (do0) {
#pragma unroll
                for (int e = 0; e < 16; ++e) mx = fmaxf(mx, s0[e]); }
            if (do1) {
#pragma unroll
                for (int e = 0; e < 16; ++e) mx = fmaxf(mx, s1[e]); }
            mx = fmaxf(mx, __shfl_xor(mx, 32));
            const float mnew = fmaxf(mrun, mx), alpha = __builtin_amdgcn_exp2f(mrun - mnew); mrun = mnew;
            float ps = 0.f;
            if (do0) {
#pragma unroll
                for (int e = 0; e < 16; ++e) { s0[e] = __builtin_amdgcn_exp2f(s0[e] - mnew); ps += s0[e]; } }
            if (do1) {
#pragma unroll
                for (int e = 0; e < 16; ++e) { s1[e] = __builtin_amdgcn_exp2f(s1[e] - mnew); ps += s1[e]; } }
            lrun = lrun * alpha + ps;
            if (__any(alpha != 1.0f)) {
#pragma unroll
            for (int d = 0; d < 4; ++d)
#pragma unroll
                for (int e = 0; e < 16; ++e) o[d][e] *= alpha; }
#pragma unroll
            for (int hf = 0; hf < 2; ++hf) { if (hf == 0 ? !do0 : !do1) continue;
                bf16x8 pb[2];
#pragma unroll
                for (int k2 = 0; k2 < 2; ++k2) { v4u w;
                    if (hf == 0) { w.x = cvtpk2(s0[8 * k2], s0[8 * k2 + 1]); w.y = cvtpk2(s0[8 * k2 + 2], s0[8 * k2 + 3]); w.z = cvtpk2(s0[8 * k2 + 4], s0[8 * k2 + 5]); w.w = cvtpk2(s0[8 * k2 + 6], s0[8 * k2 + 7]); }
                    else { w.x = cvtpk2(s1[8 * k2], s1[8 * k2 + 1]); w.y = cvtpk2(s1[8 * k2 + 2], s1[8 * k2 + 3]); w.z = cvtpk2(s1[8 * k2 + 4], s1[8 * k2 + 5]); w.w = cvtpk2(s1[8 * k2 + 6], s1[8 * k2 + 7]); }
                    pb[k2] = __builtin_bit_cast(bf16x8, w); }
#pragma unroll
                for (int dp = 0; dp < 2; ++dp) { s16x4 vlo[2][2], vhh[2][2];
#pragma unroll
                    for (int d2 = 0; d2 < 2; ++d2)
#pragma unroll
                        for (int k2 = 0; k2 < 2; ++k2) { const int ks = 2 * hf + k2, d = 2 * dp + d2;
                            const unsigned a0_ = (unsigned)(size_t)(Vb + img_tr_off(lane, 16 * ks + 4 * hi, d)), a1_ = (unsigned)(size_t)(Vb + img_tr_off(lane, 16 * ks + 4 * hi + 8, d));
                            asm volatile("ds_read_b64_tr_b16 %0, %1" : "=v"(vlo[d2][k2]) : "v"(a0_)); asm volatile("ds_read_b64_tr_b16 %0, %1" : "=v"(vhh[d2][k2]) : "v"(a1_)); }
                    asm volatile("s_waitcnt lgkmcnt(0)" : "+v"(vlo[0][0]), "+v"(vlo[0][1]), "+v"(vlo[1][0]), "+v"(vlo[1][1]), "+v"(vhh[0][0]), "+v"(vhh[0][1]), "+v"(vhh[1][0]), "+v"(vhh[1][1]));
#pragma unroll
                    for (int d2 = 0; d2 < 2; ++d2)
#pragma unroll
                        for (int k2 = 0; k2 < 2; ++k2) { const s16x4 lo = vlo[d2][k2], hh = vhh[d2][k2]; const int d = 2 * dp + d2;
                            const bf16x8 a = (bf16x8){lo[0], lo[1], lo[2], lo[3], hh[0], hh[1], hh[2], hh[3]};
                            o[d] = __builtin_amdgcn_mfma_f32_32x32x16_bf16(a, pb[k2], o[d], 0, 0, 0); } } }
            if (ph == 2) pending = true;
        }
        { const int ny = (fin ? 8 : 0) + (qpre ? 8 : 0) + (dma ? 4 : 0);
          if (ny >= 20) asm volatile("s_waitcnt vmcnt(20)" ::: "memory"); else if (ny >= 16) asm volatile("s_waitcnt vmcnt(16)" ::: "memory"); else if (ny >= 12) asm volatile("s_waitcnt vmcnt(12)" ::: "memory");
          else if (ny >= 8) asm volatile("s_waitcnt vmcnt(8)" ::: "memory"); else if (ny >= 4) asm volatile("s_waitcnt vmcnt(4)" ::: "memory"); else asm volatile("s_waitcnt vmcnt(0)" ::: "memory"); }
        WG_BAR();
        cur = cur == 2 ? 0 : cur + 1;
    }
    if (pending) ATT_FINAL();
#undef ATT_FINAL
#undef ATT_DMA
}

constexpr int GAS_ = 72;
constexpr int G_QRAW = 0, G_Q1P = 16384, G_K1 = 32768, G_V0 = 49152, G_AM = 81920, G_TOT0 = G_AM + 64 * GAS_ * 2, G_F2 = G_TOT0 + 512, G_TOT1 = G_F2 + 512,
              G_EB = G_TOT1 + 512, G_EBL = G_EB + 512, G_LDS = G_EBL + 512, G_SSQ = G_LDS + 512, G_GLR = G_SSQ + 2048, G_GNL = G_GLR + 8192, G_END = G_GNL + 1024;
static_assert(G_END <= RING_BYTES, "gla lds");
__device__ __forceinline__ v4u split_hi4(const float* x, v4u& lo) {
    v4u h; unsigned hw[4], lw[4];
#pragma unroll
    for (int i = 0; i < 4; ++i) { hw[i] = cvtpk2(x[2 * i], x[2 * i + 1]); const float r0 = x[2 * i] - bflo(hw[i]), r1 = x[2 * i + 1] - bfhi(hw[i]); lw[i] = cvtpk2(r0, r1); }
    h.x = hw[0]; h.y = hw[1]; h.z = hw[2]; h.w = hw[3]; lo.x = lw[0]; lo.y = lw[1]; lo.z = lw[2]; lo.w = lw[3]; return h;
}
template <bool FULL>
__device__ __forceinline__ void gla_seg(LAS unsigned char* lds, const bf16* GB, const float* GLR, const float* w_gate_lr, const float* b_gate, const float* gla_norm_g, bf16* GLAOUT,
                                        float* SLOC, float* LOGD, int b, int h, int sg, int tid_in0, int lane_in0, int wave) {
    typedef unsigned u32x2w __attribute__((ext_vector_type(2)));
    int tid_in = tid_in0, lane_in = lane_in0; asm volatile("" : "+v"(tid_in), "+v"(lane_in));
    LAS unsigned char* QRAW = lds + G_QRAW; LAS unsigned char* Q1P = lds + G_Q1P; LAS unsigned char* K1 = lds + G_K1; LAS unsigned char* VI = lds + G_V0; LAS bf16* AM = (LAS bf16*)(lds + G_AM);
    LAS float* TOT0 = (LAS float*)(lds + G_TOT0); LAS float* F2 = (LAS float*)(lds + G_F2); LAS float* TOT1 = (LAS float*)(lds + G_TOT1); LAS float* EB = (LAS float*)(lds + G_EB);
    LAS float* EBL = (LAS float*)(lds + G_EBL); LAS float* LDSUM = (LAS float*)(lds + G_LDS); LAS float* SSQP = (LAS float*)(lds + G_SSQ); LAS float* GLRS = (LAS float*)(lds + G_GLR); LAS float* GNL = (LAS float*)(lds + G_GNL);
    const int it = wave >> 2, dt = wave & 3;
    constexpr float LOG2E = 1.4426950408889634f, LN2 = 0.6931471805599453f;
    f32x16 sacc[4];
#pragma unroll
    for (int db = 0; db < 4; ++db)
#pragma unroll
        for (int e = 0; e < 16; ++e) sacc[db][e] = 0.f;
    const size_t rowb = (size_t)b * SEQ + (size_t)sg * 1024;
    const int bh3 = (b * 4 + h) * 3;
    if constexpr (FULL) {
        for (int sp = 0; sp < sg; ++sp) {
            int ln1 = lane_in, t1 = tid_in; asm volatile("" : "+v"(ln1), "+v"(t1) :: "memory");
            const int hii = ln1 >> 5;
            const f32x4* sl = (const f32x4*)(SLOC + (size_t)(bh3 + sp) * 32768) + (wave * 64 + ln1);
            f32x4 s4[16];
#pragma unroll
            for (int q = 0; q < 16; ++q) s4[q] = sl[q * 512];
            if (t1 < 128) EB[t1] = __builtin_amdgcn_exp2f(LOG2E * LOGD[(bh3 + sp) * 128 + t1]);
            WG_BAR();
#pragma unroll
            for (int db = 0; db < 4; ++db)
#pragma unroll
                for (int gq = 0; gq < 4; ++gq) { const int d0 = db * 32 + 8 * gq + 4 * hii; const f32x4 e4 = *(const LAS f32x4*)(EB + d0); const f32x4 v4 = s4[db * 4 + gq];
#pragma unroll
                    for (int c = 0; c < 4; ++c) sacc[db][4 * gq + c] = sacc[db][4 * gq + c] * e4[c] + v4[c]; }
            WG_BAR(); }
    }
    v4u wgh, wgl; float biasv;
    { int ln0 = lane_in; asm volatile("" : "+v"(ln0));
      const int l31i = ln0 & 31, hii = ln0 >> 5, dd = h * 128 + dt * 32 + l31i; float wv[8];
#pragma unroll
      for (int j = 0; j < 8; ++j) wv[j] = w_gate_lr[(8 * hii + j) * 512 + dd];
      wgh = split_hi4(wv, wgl); biasv = b_gate[dd]; }
    { const float2 g2 = *(const float2*)(GLR + rowb * 16 + tid_in * 2); GLRS[tid_in * 2] = g2.x; GLRS[tid_in * 2 + 1] = g2.y; }
    if (tid_in < 256) GNL[tid_in] = gla_norm_g[tid_in];
    if (tid_in < 128) { EBL[tid_in] = 0.f; LDSUM[tid_in] = 0.f; }
    v4u kraw0, kraw1, qraw0, qraw1, vraw[4]; float2 glrq = {0.f, 0.f};
#define GLA_REQ(ROWC, T) do { const bf16* qp_ = GB + ((ROWC) + ((T) >> 3)) * 3072 + h * 128 + ((T) & 7) * 8; kraw0 = *(const v4u*)(qp_ + 512); kraw1 = *(const v4u*)(qp_ + 576); \
        if constexpr (FULL) { qraw0 = *(const v4u*)qp_; qraw1 = *(const v4u*)(qp_ + 64); } \
        _Pragma("unroll") for (int c4_ = 0; c4_ < 4; ++c4_) vraw[c4_] = *(const v4u*)(qp_ + 1024 + 128 * h + 64 * c4_); } while (0)
    { int t3 = tid_in; asm volatile("" : "+v"(t3) :: "memory"); GLA_REQ(rowb, t3); }
    __syncthreads();
    { int t4 = tid_in; asm volatile("" : "+v"(t4) :: "memory"); glrq = *(const float2*)(GLR + (rowb + 64) * 16 + t4 * 2); asm volatile("" ::: "memory"); }
#pragma unroll 1
    for (int n = 0; n < 16; ++n) {
        const size_t rowc = rowb + (size_t)n * 64;
        int tid_ = tid_in; asm volatile("" : "+v"(tid_));
        const int tid = tid_, lane = tid & 63, l31 = lane & 31, hi = lane >> 5;
        asm volatile("" ::: "memory");
        const int srow = tid >> 3, sc8 = tid & 7;
        v4u grl[2][2];
        if constexpr (FULL) {
#pragma unroll
            for (int i2 = 0; i2 < 2; ++i2)
#pragma unroll
                for (int pp = 0; pp < 2; ++pp) grl[i2][pp] = *(const v4u*)(GB + (rowc + i2 * 32 + l31) * 3072 + 2048 + h * 256 + 32 * wave + 16 * pp + 8 * hi); }
        asm volatile("" ::: "memory");
        f32x16 yv;
        { float gx[8]; { const LAS float* gsrc = GLRS + (n & 1) * 1024 + (it * 32 + l31) * 16 + 8 * hi; const f32x4 g0 = *(const LAS f32x4*)gsrc, g1 = *(const LAS f32x4*)(gsrc + 4);
              gx[0] = g0.x; gx[1] = g0.y; gx[2] = g0.z; gx[3] = g0.w; gx[4] = g1.x; gx[5] = g1.y; gx[6] = g1.z; gx[7] = g1.w; }
          v4u al; const v4u ah = split_hi4(gx, al);
          f32x16 z;
#pragma unroll
          for (int e = 0; e < 16; ++e) z[e] = biasv;
          z = __builtin_amdgcn_mfma_f32_32x32x16_bf16(__builtin_bit_cast(bf16x8, al), __builtin_bit_cast(bf16x8, wgh), z, 0, 0, 0);
          z = __builtin_amdgcn_mfma_f32_32x32x16_bf16(__builtin_bit_cast(bf16x8, ah), __builtin_bit_cast(bf16x8, wgl), z, 0, 0, 0);
          z = __builtin_amdgcn_mfma_f32_32x32x16_bf16(__builtin_bit_cast(bf16x8, ah), __builtin_bit_cast(bf16x8, wgh), z, 0, 0, 0);
          float la[16];
#pragma unroll
          for (int e = 0; e < 16; ++e) la[e] = (fminf(z[e], 0.f) - LN2 * __builtin_amdgcn_logf(1.0f + __builtin_amdgcn_exp2f(-LOG2E * fabsf(z[e])))) * (1.0f / 16.0f);
#pragma unroll
          for (int e = 0; e < 16; ++e) yv[e] = 0.f;
#pragma unroll
          for (int s2 = 0; s2 < 2; ++s2) { v4u ll; const v4u lh = split_hi4(la + 8 * s2, ll);
              unsigned uw[4];
#pragma unroll
              for (int i2 = 0; i2 < 4; ++i2) { const int j0 = 2 * i2, j1 = 2 * i2 + 1; const int t0 = 16 * s2 + 8 * (j0 >> 2) + 4 * hi + (j0 & 3), t1 = 16 * s2 + 8 * (j1 >> 2) + 4 * hi + (j1 & 3);
                  uw[i2] = (t0 <= l31 ? 0x3f80u : 0u) | (t1 <= l31 ? 0x3f800000u : 0u); }
              v4u ut; ut.x = uw[0]; ut.y = uw[1]; ut.z = uw[2]; ut.w = uw[3];
              yv = __builtin_amdgcn_mfma_f32_32x32x16_bf16(__builtin_bit_cast(bf16x8, ll), __builtin_bit_cast(bf16x8, ut), yv, 0, 0, 0);
              yv = __builtin_amdgcn_mfma_f32_32x32x16_bf16(__builtin_bit_cast(bf16x8, lh), __builtin_bit_cast(bf16x8, ut), yv, 0, 0, 0); } }
        if (l31 == 31) { LAS float* tp = (it ? TOT1 : TOT0) + 32 * dt + 4 * hi;
#pragma unroll
            for (int gq = 0; gq < 4; ++gq) *(LAS f32x4*)(tp + 8 * gq) = (f32x4){yv[4 * gq], yv[4 * gq + 1], yv[4 * gq + 2], yv[4 * gq + 3]}; }
        if (l31 == 0 && it == 1) { LAS float* tp = F2 + 32 * dt + 4 * hi;
#pragma unroll
            for (int gq = 0; gq < 4; ++gq) *(LAS f32x4*)(tp + 8 * gq) = (f32x4){yv[4 * gq], yv[4 * gq + 1], yv[4 * gq + 2], yv[4 * gq + 3]}; }
        { const unsigned o0 = img_off(srow, sc8), o1 = img_off(srow, sc8 + 8);
          if constexpr (FULL) { *(LAS v4u*)(QRAW + o0) = qraw0; *(LAS v4u*)(QRAW + o1) = qraw1; }
          *(LAS v4u*)(K1 + o0) = kraw0; *(LAS v4u*)(K1 + o1) = kraw1;
          *(LAS v4u*)(VI + o0) = vraw[0]; *(LAS v4u*)(VI + o1) = vraw[1]; *(LAS v4u*)(VI + 16384 + o0) = vraw[2]; *(LAS v4u*)(VI + 16384 + o1) = vraw[3]; }
        WG_BAR();
        {
#pragma unroll
            for (int gq = 0; gq < 4; ++gq) { const int d0 = 32 * dt + 8 * gq + 4 * hi;
                const f32x4 t0 = *(const LAS f32x4*)(TOT0 + d0), f2 = *(const LAS f32x4*)(F2 + d0);
                if (it == 0 && l31 == 0) { const f32x4 t1 = *(const LAS f32x4*)(TOT1 + d0), el = *(const LAS f32x4*)(EBL + d0), lsm = *(const LAS f32x4*)(LDSUM + d0); f32x4 eb, nl, ns;
#pragma unroll
                    for (int c = 0; c < 4; ++c) { const float bref = t0[c] + f2[c], blast = t0[c] + t1[c]; eb[c] = __builtin_amdgcn_exp2f(LOG2E * (el[c] + bref)); nl[c] = blast - bref; ns[c] = lsm[c] + blast; }
                    *(LAS f32x4*)(EB + d0) = eb; *(LAS f32x4*)(EBL + d0) = nl; *(LAS f32x4*)(LDSUM + d0) = ns; }
                const unsigned ao = img_off(it * 32 + l31, 4 * dt + gq) + 8 * hi;
                const u32x2w kr = *(const LAS u32x2w*)(K1 + ao); u32x2w qr = {0u, 0u};
                if constexpr (FULL) qr = *(const LAS u32x2w*)(QRAW + ao);
                float e1[4], e2[4];
#pragma unroll
                for (int c = 0; c < 4; ++c) { const float rel = LOG2E * (yv[4 * gq + c] - (it ? f2[c] : t0[c] + f2[c])); e1[c] = __builtin_amdgcn_exp2f(rel); e2[c] = __builtin_amdgcn_exp2f(-rel); }
                u32x2w kw; kw.x = cvtpk2(bflo(kr.x) * e2[0], bfhi(kr.x) * e2[1]); kw.y = cvtpk2(bflo(kr.y) * e2[2], bfhi(kr.y) * e2[3]);
                *(LAS u32x2w*)(K1 + ao) = kw;
                if constexpr (FULL) { u32x2w qw; qw.x = cvtpk2(bflo(qr.x) * e1[0], bfhi(qr.x) * e1[1]); qw.y = cvtpk2(bflo(qr.y) * e1[2], bfhi(qr.y) * e1[3]);
                    *(LAS u32x2w*)(Q1P + img_off(it * 32 + l31, 4 * dt + 2 * (gq >> 1) + hi) + 8 * (gq & 1)) = qw; } }
        }
        WG_BAR();
        if (n + 1 < 16) { LAS float* gd = GLRS + ((n + 1) & 1) * 1024 + tid * 2; gd[0] = glrq.x; gd[1] = glrq.y; }
        asm volatile("" ::: "memory");
        { const size_t rn1 = rowb + (size_t)(n + 1 < 16 ? n + 1 : 15) * 64, rn2 = rowb + (size_t)(n + 2 < 16 ? n + 2 : 15) * 64;
          GLA_REQ(rn1, tid); glrq = *(const float2*)(GLR + rn2 * 16 + tid * 2); }
        asm volatile("" ::: "memory");
#pragma unroll
        for (int db = 0; db < 4; ++db)
#pragma unroll
            for (int gq = 0; gq < 4; ++gq) { const f32x4 e4 = *(const LAS f32x4*)(EB + db * 32 + 8 * gq + 4 * hi);
                sacc[db][4 * gq] *= e4.x; sacc[db][4 * gq + 1] *= e4.y; sacc[db][4 * gq + 2] *= e4.z; sacc[db][4 * gq + 3] *= e4.w; }
        f32x16 oacc[2];
#pragma unroll
        for (int i2 = 0; i2 < 2; ++i2)
#pragma unroll
            for (int e = 0; e < 16; ++e) oacc[i2][e] = 0.f;
        if constexpr (FULL) {
        if (wave < 3) { const int ia = wave > 0 ? 1 : 0, ja = wave == 2 ? 1 : 0; f32x16 a16;
#pragma unroll
            for (int e = 0; e < 16; ++e) a16[e] = 0.f;
#pragma unroll
            for (int ks = 0; ks < 8; ++ks) { const unsigned ka = img_off(ja * 32 + l31, 2 * ks) + 8 * hi, kb2 = img_off(ja * 32 + l31, 2 * ks + 1) + 8 * hi;
                const s16x4 lo = *(const LAS s16x4*)(K1 + ka), hh = *(const LAS s16x4*)(K1 + kb2);
                const bf16x8 af = (bf16x8){lo[0], lo[1], lo[2], lo[3], hh[0], hh[1], hh[2], hh[3]};
                const bf16x8 bfr = *(const LAS bf16x8*)(Q1P + img_off(ia * 32 + l31, 2 * ks + hi));
                a16 = __builtin_amdgcn_mfma_f32_32x32x16_bf16(af, bfr, a16, 0, 0, 0); }
#pragma unroll
            for (int gq = 0; gq < 4; ++gq) { const int i = ia * 32 + l31, j0 = ja * 32 + 8 * gq + 4 * hi; u32x2w w;
                w.x = cvtpk2(j0 <= i ? a16[4 * gq] : 0.f, j0 + 1 <= i ? a16[4 * gq + 1] : 0.f); w.y = cvtpk2(j0 + 2 <= i ? a16[4 * gq + 2] : 0.f, j0 + 3 <= i ? a16[4 * gq + 3] : 0.f);
                *(LAS u32x2w*)(AM + i * GAS_ + j0) = w; } }
#pragma unroll
        for (int db = 0; db < 4; ++db)
#pragma unroll
            for (int s2 = 0; s2 < 2; ++s2) { v4u w; w.x = cvtpk2(sacc[db][8 * s2], sacc[db][8 * s2 + 1]); w.y = cvtpk2(sacc[db][8 * s2 + 2], sacc[db][8 * s2 + 3]);
                w.z = cvtpk2(sacc[db][8 * s2 + 4], sacc[db][8 * s2 + 5]); w.w = cvtpk2(sacc[db][8 * s2 + 6], sacc[db][8 * s2 + 7]); const bf16x8 af = __builtin_bit_cast(bf16x8, w);
#pragma unroll
                for (int i2 = 0; i2 < 2; ++i2) { const bf16x8 bfr = *(const LAS bf16x8*)(Q1P + img_off(i2 * 32 + l31, 4 * db + 2 * s2 + hi));
                    oacc[i2] = __builtin_amdgcn_mfma_f32_32x32x16_bf16(af, bfr, oacc[i2], 0, 0, 0); } }
        WG_BAR();
        }
        bf16x8 vf[4];
        { const LAS unsigned char* vim = VI + (wave >> 2) * 16384;
#pragma unroll
          for (int ks = 0; ks < 4; ++ks) { const s16x4 lo = img_tr_read(vim + img_tr_off(lane, 16 * ks + 8 * hi, wave & 3)), hh = img_tr_read(vim + img_tr_off(lane, 16 * ks + 8 * hi + 4, wave & 3));
              vf[ks] = (bf16x8){lo[0], lo[1], lo[2], lo[3], hh[0], hh[1], hh[2], hh[3]}; } }
        if constexpr (FULL) {
#pragma unroll
        for (int i2 = 0; i2 < 2; ++i2)
#pragma unroll
            for (int ks = 0; ks < 4; ++ks) { if (i2 == 0 && ks >= 2) continue;
                const bf16x8 bfr = *(const LAS bf16x8*)(AM + (i2 * 32 + l31) * GAS_ + 16 * ks + 8 * hi);
                oacc[i2] = __builtin_amdgcn_mfma_f32_32x32x16_bf16(vf[ks], bfr, oacc[i2], 0, 0, 0); }
        }
#pragma unroll
        for (int db = 0; db < 4; ++db)
#pragma unroll
            for (int ks = 0; ks < 4; ++ks) { const s16x4 lo = img_tr_read(K1 + img_tr_off(lane, 16 * ks + 8 * hi, db)), hh = img_tr_read(K1 + img_tr_off(lane, 16 * ks + 8 * hi + 4, db));
                const bf16x8 af = (bf16x8){lo[0], lo[1], lo[2], lo[3], hh[0], hh[1], hh[2], hh[3]};
                sacc[db] = __builtin_amdgcn_mfma_f32_32x32x16_bf16(af, vf[ks], sacc[db], 0, 0, 0); }
        if constexpr (FULL) {
#pragma unroll
        for (int i2 = 0; i2 < 2; ++i2) { float sq = 0.f;
#pragma unroll
            for (int e = 0; e < 16; ++e) sq += oacc[i2][e] * oacc[i2][e];
            sq += __shfl_xor(sq, 32);
            if (hi == 0) SSQP[(i2 * 32 + l31) * 8 + wave] = sq; }
        }
        WG_BAR();
        if constexpr (FULL) {
#pragma unroll
        for (int i2 = 0; i2 < 2; ++i2) { const int tok = i2 * 32 + l31; const f32x4 p0 = *(const LAS f32x4*)(SSQP + tok * 8), p1 = *(const LAS f32x4*)(SSQP + tok * 8 + 4);
            const float rstd = __builtin_amdgcn_rsqf(((p0.x + p0.y) + (p0.z + p0.w) + (p1.x + p1.y) + (p1.z + p1.w)) * (1.0f / 256.0f) + EPS);
            const size_t row = rowc + tok;
#pragma unroll
            for (int pp = 0; pp < 2; ++pp) { u32x2t ga_, gb_; unwiden_pair(grl[i2][pp], ga_, gb_); u32x2t ya, yb;
#pragma unroll
                for (int q2 = 0; q2 < 2; ++q2) { const int gq = 2 * pp + q2; const int v0 = 32 * wave + 8 * gq + 4 * hi; const u32x2t g2 = q2 ? gb_ : ga_;
                    const f32x4 gnv = *(const LAS f32x4*)(GNL + v0);
                    const float y0 = oacc[i2][4 * gq] * rstd * gnv.x * bflo(g2.x), y1 = oacc[i2][4 * gq + 1] * rstd * gnv.y * bfhi(g2.x);
                    const float y2 = oacc[i2][4 * gq + 2] * rstd * gnv.z * bflo(g2.y), y3 = oacc[i2][4 * gq + 3] * rstd * gnv.w * bfhi(g2.y);
                    u32x2t w; w.x = cvtpk2(y0, y1); w.y = cvtpk2(y2, y3); if (q2) yb = w; else ya = w; }
                *(v4u*)(GLAOUT + row * 1536 + 512 + h * 256 + 32 * wave + 16 * pp + 8 * hi) = widen_pair(ya, yb);     } }
        }
    }
#undef GLA_REQ
    if constexpr (!FULL) {
        int ln2 = lane_in; asm volatile("" : "+v"(ln2) :: "memory");
        const int hii = ln2 >> 5;
        f32x4* sl = (f32x4*)(SLOC + (size_t)(bh3 + sg) * 32768) + (wave * 64 + ln2);
#pragma unroll
        for (int db = 0; db < 4; ++db)
#pragma unroll
            for (int gq = 0; gq < 4; ++gq) { const int d0 = db * 32 + 8 * gq + 4 * hii; const f32x4 el = *(const LAS f32x4*)(EBL + d0);
                { f32x4 o4;
#pragma unroll
                for (int c = 0; c < 4; ++c) o4[c] = sacc[db][4 * gq + c] * __builtin_amdgcn_exp2f(LOG2E * el[c]);
                sl[(db * 4 + gq) * 512] = o4; } }
        if (tid_in < 128) LOGD[(bh3 + sg) * 128 + tid_in] = LDSUM[tid_in];
    }
}


__device__ __forceinline__ void gla_loc(LAS unsigned char* lds, const bf16* GB, const float* GLR, const float* w_gate_lr, const float* b_gate,
                                        float* SLOC, float* LOGD, int b, int h, int sg, int tid_in0, int lane_in0, int wave) {
    typedef unsigned u32x2w __attribute__((ext_vector_type(2)));
    int tid_in = tid_in0, lane_in = lane_in0; asm volatile("" : "+v"(tid_in), "+v"(lane_in));
    constexpr int P_K1 = 0, P_V = 32768, P_TOT0 = 98304, P_TOT1 = P_TOT0 + 512, P_CARRY = P_TOT1 + 512, P_GLRS = P_CARRY + 1024, P_END = P_GLRS + 8192;
    static_assert(P_END <= RING_BYTES, "gla_loc lds");
    LAS float* TOT0 = (LAS float*)(lds + P_TOT0); LAS float* TOT1 = (LAS float*)(lds + P_TOT1); LAS float* CARRY = (LAS float*)(lds + P_CARRY); LAS float* GLRS = (LAS float*)(lds + P_GLRS);
    const int it = wave >> 2, dt = wave & 3;
    constexpr float LOG2E = 1.4426950408889634f, LN2 = 0.6931471805599453f;
    f32x16 sacc[4];
#pragma unroll
    for (int db = 0; db < 4; ++db)
#pragma unroll
        for (int e = 0; e < 16; ++e) sacc[db][e] = 0.f;
    const size_t rowb = (size_t)b * SEQ + (size_t)sg * 1024;
    const int bh3 = (b * 4 + h) * 3;
    v4u wgh, wgl; float biasv;
    { int ln0 = lane_in; asm volatile("" : "+v"(ln0));
      const int l31i = ln0 & 31, hii = ln0 >> 5, dd = h * 128 + dt * 32 + l31i; float wv[8];
#pragma unroll
      for (int j = 0; j < 8; ++j) wv[j] = w_gate_lr[(8 * hii + j) * 512 + dd];
      wgh = split_hi4(wv, wgl); biasv = b_gate[dd]; }
    { const float2 g2 = *(const float2*)(GLR + (rowb + 15 * 64) * 16 + tid_in * 2); GLRS[tid_in * 2] = g2.x; GLRS[tid_in * 2 + 1] = g2.y; }
    if (tid_in < 128) CARRY[tid_in] = 0.f;
    v4u kraw0, kraw1, vraw[4]; float2 glrq = {0.f, 0.f};
#define GLL_REQ(ROWC, T) do { const bf16* qp_ = GB + ((ROWC) + ((T) >> 3)) * 3072 + h * 128 + ((T) & 7) * 8; kraw0 = *(const v4u*)(qp_ + 512); kraw1 = *(const v4u*)(qp_ + 576); \
        _Pragma("unroll") for (int c4_ = 0; c4_ < 4; ++c4_) vraw[c4_] = *(const v4u*)(qp_ + 1024 + 128 * h + 64 * c4_); } while (0)
    { int t3 = tid_in; asm volatile("" : "+v"(t3) :: "memory"); GLL_REQ(rowb + 15 * 64, t3); }
    __syncthreads();
    { int t4 = tid_in; asm volatile("" : "+v"(t4) :: "memory"); glrq = *(const float2*)(GLR + (rowb + 14 * 64) * 16 + t4 * 2); asm volatile("" ::: "memory"); }
    f32x16 yv;
#pragma unroll
    for (int e = 0; e < 16; ++e) yv[e] = 0.f;
#pragma unroll 1
    for (int i = 0; i <= 16; ++i) {
        int tid_ = tid_in; asm volatile("" : "+v"(tid_));
        const int tid = tid_, lane = tid & 63, l31 = lane & 31, hi = lane >> 5;
        asm volatile("" ::: "memory");
        auto gates = [&]() __attribute__((always_inline)) {
            { float gx[8]; { const LAS float* gsrc = GLRS + (i & 1) * 1024 + (it * 32 + l31) * 16 + 8 * hi; const f32x4 g0 = *(const LAS f32x4*)gsrc, g1 = *(const LAS f32x4*)(gsrc + 4);
                  gx[0] = g0.x; gx[1] = g0.y; gx[2] = g0.z; gx[3] = g0.w; gx[4] = g1.x; gx[5] = g1.y; gx[6] = g1.z; gx[7] = g1.w; }
              v4u al; const v4u ah = split_hi4(gx, al);
              f32x16 z;
#pragma unroll
              for (int e = 0; e < 16; ++e) z[e] = biasv;
              z = __builtin_amdgcn_mfma_f32_32x32x16_bf16(__builtin_bit_cast(bf16x8, al), __builtin_bit_cast(bf16x8, wgh), z, 0, 0, 0);
              z = __builtin_amdgcn_mfma_f32_32x32x16_bf16(__builtin_bit_cast(bf16x8, ah), __builtin_bit_cast(bf16x8, wgl), z, 0, 0, 0);
              z = __builtin_amdgcn_mfma_f32_32x32x16_bf16(__builtin_bit_cast(bf16x8, ah), __builtin_bit_cast(bf16x8, wgh), z, 0, 0, 0);
              float la[16];
#pragma unroll
              for (int e = 0; e < 16; ++e) la[e] = (fminf(z[e], 0.f) - LN2 * __builtin_amdgcn_logf(1.0f + __builtin_amdgcn_exp2f(-LOG2E * fabsf(z[e])))) * (1.0f / 16.0f);
#pragma unroll
              for (int e = 0; e < 16; ++e) yv[e] = 0.f;
#pragma unroll
              for (int s2 = 0; s2 < 2; ++s2) { v4u ll; const v4u lh = split_hi4(la + 8 * s2, ll);
                  unsigned uw[4];
#pragma unroll
                  for (int i2 = 0; i2 < 4; ++i2) { const int j0 = 2 * i2, j1 = 2 * i2 + 1; const int t0 = 16 * s2 + 8 * (j0 >> 2) + 4 * hi + (j0 & 3), t1 = 16 * s2 + 8 * (j1 >> 2) + 4 * hi + (j1 & 3);
                      uw[i2] = (t0 <= l31 ? 0x3f80u : 0u) | (t1 <= l31 ? 0x3f800000u : 0u); }
                  v4u ut; ut.x = uw[0]; ut.y = uw[1]; ut.z = uw[2]; ut.w = uw[3];
                  yv = __builtin_amdgcn_mfma_f32_32x32x16_bf16(__builtin_bit_cast(bf16x8, ll), __builtin_bit_cast(bf16x8, ut), yv, 0, 0, 0);
                  yv = __builtin_amdgcn_mfma_f32_32x32x16_bf16(__builtin_bit_cast(bf16x8, lh), __builtin_bit_cast(bf16x8, ut), yv, 0, 0, 0); } }
            if (l31 == 31) { LAS float* tp = (it ? TOT1 : TOT0) + 32 * dt + 4 * hi;
#pragma unroll
                for (int gq = 0; gq < 4; ++gq) *(LAS f32x4*)(tp + 8 * gq) = (f32x4){yv[4 * gq], yv[4 * gq + 1], yv[4 * gq + 2], yv[4 * gq + 3]}; }
            { const int srow = tid >> 3, sc8 = tid & 7; const unsigned o0 = img_off(srow, sc8), o1 = img_off(srow, sc8 + 8);
              LAS unsigned char* K1 = lds + P_K1 + (i & 1) * 16384; LAS unsigned char* VI = lds + P_V + (i & 1) * 32768;
              *(LAS v4u*)(K1 + o0) = kraw0; *(LAS v4u*)(K1 + o1) = kraw1;
              *(LAS v4u*)(VI + o0) = vraw[0]; *(LAS v4u*)(VI + o1) = vraw[1]; *(LAS v4u*)(VI + 16384 + o0) = vraw[2]; *(LAS v4u*)(VI + 16384 + o1) = vraw[3]; }
            if (i + 1 < 16) { LAS float* gd = GLRS + ((i + 1) & 1) * 1024 + tid * 2; gd[0] = glrq.x; gd[1] = glrq.y; }
            asm volatile("" ::: "memory");
            { const size_t rn1 = rowb + (size_t)(14 - i > 0 ? 14 - i : 0) * 64, rn2 = rowb + (size_t)(13 - i > 0 ? 13 - i : 0) * 64;
              GLL_REQ(rn1, tid); glrq = *(const float2*)(GLR + rn2 * 16 + tid * 2); }
            asm volatile("" ::: "memory");
        };
        auto update = [&]() __attribute__((always_inline)) {
            const LAS unsigned char* K1 = lds + P_K1 + ((i - 1) & 1) * 16384; const LAS unsigned char* vim = lds + P_V + ((i - 1) & 1) * 32768 + (wave >> 2) * 16384;
            bf16x8 vf[4];
#pragma unroll
            for (int ks = 0; ks < 4; ++ks) { const s16x4 lo = img_tr_read(vim + img_tr_off(lane, 16 * ks + 8 * hi, wave & 3)), hh = img_tr_read(vim + img_tr_off(lane, 16 * ks + 8 * hi + 4, wave & 3));
                vf[ks] = (bf16x8){lo[0], lo[1], lo[2], lo[3], hh[0], hh[1], hh[2], hh[3]}; }
#pragma unroll
            for (int db = 0; db < 4; ++db)
#pragma unroll
                for (int ks = 0; ks < 4; ++ks) { const s16x4 lo = img_tr_read(K1 + img_tr_off(lane, 16 * ks + 8 * hi, db)), hh = img_tr_read(K1 + img_tr_off(lane, 16 * ks + 8 * hi + 4, db));
                    const bf16x8 af = (bf16x8){lo[0], lo[1], lo[2], lo[3], hh[0], hh[1], hh[2], hh[3]};
                    sacc[db] = __builtin_amdgcn_mfma_f32_32x32x16_bf16(af, vf[ks], sacc[db], 0, 0, 0); }
        };
        if (wave >= 4 && i > 0) update();
        if (i < 16) gates();
        if (wave < 4 && i > 0) update();
        WG_BAR();
        if (i < 16) {
            LAS unsigned char* K1 = lds + P_K1 + (i & 1) * 16384; const LAS float* cyb = CARRY + (i & 1) * 128; LAS float* cyn = CARRY + ((i + 1) & 1) * 128;
#pragma unroll
            for (int gq = 0; gq < 4; ++gq) { const int d0 = 32 * dt + 8 * gq + 4 * hi;
                const f32x4 t0 = *(const LAS f32x4*)(TOT0 + d0), t1 = *(const LAS f32x4*)(TOT1 + d0), cy = *(const LAS f32x4*)(cyb + d0);
                if (it == 0 && l31 == 0) { f32x4 nc;
#pragma unroll
                    for (int c = 0; c < 4; ++c) nc[c] = cy[c] + (t0[c] + t1[c]);
                    *(LAS f32x4*)(cyn + d0) = nc; }
                const unsigned ao = img_off(it * 32 + l31, 4 * dt + gq) + 8 * hi;
                const u32x2w kr = *(const LAS u32x2w*)(K1 + ao);
                float e2[4];
#pragma unroll
                for (int c = 0; c < 4; ++c) { const float sa = ((it ? t1[c] : t0[c] + t1[c]) - yv[4 * gq + c]) + cy[c]; e2[c] = __builtin_amdgcn_exp2f(LOG2E * sa); }
                u32x2w kw; kw.x = cvtpk2(bflo(kr.x) * e2[0], bfhi(kr.x) * e2[1]); kw.y = cvtpk2(bflo(kr.y) * e2[2], bfhi(kr.y) * e2[3]);
                *(LAS u32x2w*)(K1 + ao) = kw; }
        }
        WG_BAR();
    }
#undef GLL_REQ
    { int ln2 = lane_in; asm volatile("" : "+v"(ln2) :: "memory");
      f32x4* sl = (f32x4*)(SLOC + (size_t)(bh3 + sg) * 32768) + (wave * 64 + ln2);
#pragma unroll
      for (int db = 0; db < 4; ++db)
#pragma unroll
          for (int gq = 0; gq < 4; ++gq) sl[(db * 4 + gq) * 512] = (f32x4){sacc[db][4 * gq], sacc[db][4 * gq + 1], sacc[db][4 * gq + 2], sacc[db][4 * gq + 3]};
      if (tid_in < 128) LOGD[(bh3 + sg) * 128 + tid_in] = CARRY[tid_in]; }
}

struct Args { const float* in[13]; float* out; unsigned char* ws; };

__global__ void __launch_bounds__(NWAVES * 64, 2) hyb_fwd(Args args) {
    extern __shared__ __attribute__((aligned(16))) unsigned char lds[];
    LAS unsigned char* L = (LAS unsigned char*)lds;
    volatile LAS unsigned* MISC = (volatile LAS unsigned*)(L + MISC_OFF);
    const int tid = threadIdx.x, lane = tid & 63, wave = __builtin_amdgcn_readfirstlane(tid >> 6);
    const int G = gridDim.x; const int bx = blockIdx.x; const int vcu = (G % 8 == 0) ? (bx % 8) * (G / 8) + bx / 8 : bx;
    unsigned char* ws = args.ws;
    gu32* ctl = (gu32*)(ws + WS_CTL);
    const float* x = args.in[0]; const float* norm1_g = args.in[1]; const float* w_in = args.in[2]; const float* w_gate_lr = args.in[3]; const float* b_gate = args.in[4];
    const float* gla_norm_g = args.in[5]; const float* w_branch_a = args.in[6]; const float* w_branch_b = args.in[7]; const float* w_out = args.in[8]; const float* norm2_g = args.in[9];
    const float* w_ffn_in = args.in[10]; const float* w_ffn_down = args.in[11]; const float* norm_f_g = args.in[12];
    float* out = args.out;
    bf16* WB_t = (bf16*)(ws + WS_WB); bf16* WA_t = (bf16*)(ws + WS_WA); bf16* WCAT_t = (bf16*)(ws + WS_WBA);
    bf16* WOUT_t = (bf16*)(ws + WS_WOUT); bf16* WFF_t = (bf16*)(ws + WS_WFF); bf16* WDN_t = (bf16*)(ws + WS_WDN);
    bf16* H = (bf16*)(ws + WS_H); bf16* CAT = (bf16*)(ws + WS_CAT); bf16* GB = (bf16*)(ws + WS_BIG); bf16* PA = (bf16*)(ws + WS_BIG);
    bf16* MIX = (bf16*)(ws + WS_H); bf16* X2B = (bf16*)(ws + WS_H); bf16* X1B = (bf16*)(ws + WS_BIG); bf16* ACT = (bf16*)(ws + WS_BIG) + 1024;
    bf16* GR = (bf16*)out; bf16* GS = GR + (size_t)M * 1024;
    float* ROPE = (float*)(ws + WS_ROPE); float* GLR = (float*)(ws + WS_GLR); float* SSQ1 = (float*)(ws + WS_SSQ1); float* SSQ2 = (float*)(ws + WS_SSQ2);

    for (int u = tid; u < (LDS_BYTES - LDSCTL_OFF) / 4; u += NWAVES * 64) ((LAS unsigned*)(L + LDSCTL_OFF))[u] = 0u;
    __syncthreads();
    XcdBarrier bar = xcd_barrier_post((unsigned*)(ctl + CW_BAR), MISC + 8);
    if (threadIdx.x == 0 && (G != 256 || bar.x != (unsigned)(bx & 7))) (void)__hip_atomic_fetch_or(ctl + CW_MAP, 1u, RLX_AGENT);
    const int gw = vcu * NWAVES + wave, NGW = G * NWAVES;

#if PH(0)
    for (int rep_ = 0; rep_ < ((PROBE_DUP & 4) ? 2 : 1); ++rep_)
    {
        if (rep_) __syncthreads();
        PHASE_IDS();
        LAS float* WL = (LAS float*)(L + RING_OFF);
        { float wt[32];
#pragma unroll
          for (int it = 0; it < 32; ++it) { const int i = tid + 512 * it; const int q = i & 3, ln = (i >> 2) & 63, p = (i >> 8) & 3, e = (i >> 10) & 3, j = i >> 12; const int k = 4 * (ln + 64 * j) + e;
              wt[it] = w_in[(size_t)k * INW + C_GLR + 4 * p + q]; }
#pragma unroll
          for (int it = 0; it < 32; ++it) WL[tid + 512 * it] = wt[it]; }
        __syncthreads();
        if (wave >= 6) {
            LAS float* scr = (LAS float*)(L + RING_OFF + 65536 + (wave - 6) * 8704);
            constexpr int I_B = 16 * (NB / 32), I_A = 16 * (NA / 32), I_BA = 8 * 32, I_BB = 16 * 32, I_O = 16 * 32, I_FF = 16 * (NFF / 32), I_DN = 44 * 32;
            constexpr int NITEMS = I_B + I_A + I_BA + I_BB + I_O + I_FF + I_DN;
            for (int it = vcu * 2 + (wave - 6); it < NITEMS; it += G * 2) {
                int r = it;
                if (r < I_B) { const int nb = r % (NB / 32), kb = r / (NB / 32), n0 = nb * 32; const int g0_ = n0 - 3072; const int scb = (n0 < 3072) ? C_GQ + n0 : (((g0_ >> 7) & 1) ? C_GA + 1024 : C_GA) + (g0_ >> 8) * 128 + (g0_ & 127);
                    tr_item(w_in, INW, 1024, WB_t, n0, scb, false, nullptr, kb * 64, scr, lane); continue; } r -= I_B;
                if (r < I_A) { const int nb = r % (NA / 32), kb = r / (NA / 32), n0 = nb * 32; const bool rope = (n0 < 3072) && ((n0 & 127) == 0);
                    tr_item(w_in, INW, 1024, WA_t, n0, n0, rope, nullptr, kb * 64, scr, lane); continue; } r -= I_A;
                if (r < I_BA) { const int nb = r % 32, kb = r / 32; tr_item(w_branch_a, 1024, 512, WCAT_t, nb * 32, nb * 32, false, nullptr, kb * 64, scr, lane, 1536, 0); continue; } r -= I_BA;
                if (r < I_BB) { const int nb = r % 32, kb = r / 32; tr_item(w_branch_b, 1024, 1024, WCAT_t, nb * 32, nb * 32, false, nullptr, kb * 64, scr, lane, 1536, 512); continue; } r -= I_BB;
                if (r < I_O) { const int nb = r % 32, kb = r / 32; tr_item(w_out, 1024, 1024, WOUT_t, nb * 32, nb * 32, false, nullptr, kb * 64, scr, lane); continue; } r -= I_O;
                if (r < I_FF) { const int nb = r % (NFF / 32), kb = r / (NFF / 32), n0 = nb * 32; const int t = n0 >> 8, half = (n0 >> 7) & 1; const int scb = (half ? FFH : 0) + t * 128 + (n0 & 127);
                    tr_item(w_ffn_in, NFF, 1024, WFF_t, n0, scb, false, norm2_g, kb * 64, scr, lane); continue; } r -= I_FF;
                { const int nb = r % 32, kb = r / 32; tr_item(w_ffn_down, 1024, FFH, WDN_t, nb * 32, nb * 32, false, nullptr, kb * 64, scr, lane); }
            }
            for (int i = bx * 128 + (tid - 384); i < SEQ * 16; i += G * 128) { const int pos = i >> 4, f = i & 15;
                const float inv = exp2f(-(float)f * (18.931568569324174f / 16.0f)); const float ang = (float)pos * inv;
                const double rev = (double)ang * 0.15915494309189535; const float fr = (float)(rev - __builtin_rint(rev));
                ROPE[pos * 32 + f] = __builtin_amdgcn_cosf(fr); ROPE[pos * 32 + 16 + f] = __builtin_amdgcn_sinf(fr); }
        } else {
        f32x4 g1[4];
#pragma unroll
        for (int j = 0; j < 4; ++j) g1[j] = ((const f32x4*)norm1_g)[lane + 64 * j];
        f32x4 xn[2][4];
        { const int mf = (vcu * 6 + wave) * 2;
#pragma unroll
          for (int rr = 0; rr < 2; ++rr) { const GAS f32x4* xr = (const GAS f32x4*)(x + (size_t)(mf + rr) * DM) + lane;
#pragma unroll
              for (int j = 0; j < 4; ++j) xn[rr][j] = __builtin_nontemporal_load(xr + 64 * j); }     }
#pragma unroll 1
        for (int m0 = (vcu * 6 + wave) * 2; m0 < M; m0 += G * 12) {
            asm volatile("" ::: "memory");
            float hx[2][16];
#pragma unroll
            for (int rr = 0; rr < 2; ++rr)
#pragma unroll
                for (int j = 0; j < 4; ++j) { const f32x4 t = xn[rr][j]; hx[rr][4 * j] = t.x; hx[rr][4 * j + 1] = t.y; hx[rr][4 * j + 2] = t.z; hx[rr][4 * j + 3] = t.w; }
            if (m0 + G * 12 < M) {
#pragma unroll
                for (int rr = 0; rr < 2; ++rr) { const GAS f32x4* xr = (const GAS f32x4*)(x + (size_t)(m0 + G * 12 + rr) * DM) + lane;
#pragma unroll
                    for (int j = 0; j < 4; ++j) xn[rr][j] = __builtin_nontemporal_load(xr + 64 * j); }     }
            asm volatile("" ::: "memory");
#pragma unroll
            for (int rr = 0; rr < 2; ++rr) { float s = 0.f;
#pragma unroll
                for (int i = 0; i < 16; ++i) s += hx[rr][i] * hx[rr][i];
                const float rs = __builtin_amdgcn_rsqf(wave_sum(s) * (1.0f / DM) + EPS);
#pragma unroll
                for (int j = 0; j < 4; ++j) { hx[rr][4 * j] *= rs * g1[j].x; hx[rr][4 * j + 1] *= rs * g1[j].y; hx[rr][4 * j + 2] *= rs * g1[j].z; hx[rr][4 * j + 3] *= rs * g1[j].w; }
#pragma unroll
                for (int jj = 0; jj < 2; ++jj) { const int j0 = 2 * jj, j1 = 2 * jj + 1; const bool odd = (lane & 1) != 0;
                    const unsigned a0 = pk2(hx[rr][4 * j0], hx[rr][4 * j0 + 1]), a1 = pk2(hx[rr][4 * j0 + 2], hx[rr][4 * j0 + 3]), b0 = pk2(hx[rr][4 * j1], hx[rr][4 * j1 + 1]), b1 = pk2(hx[rr][4 * j1 + 2], hx[rr][4 * j1 + 3]);
                    const unsigned r0 = (unsigned)__builtin_amdgcn_mov_dpp((int)(odd ? a0 : b0), 0xB1, 0xF, 0xF, true), r1 = (unsigned)__builtin_amdgcn_mov_dpp((int)(odd ? a1 : b1), 0xB1, 0xF, 0xF, true);
                    v4u w; if (odd) { w.x = r0; w.y = r1; w.z = b0; w.w = b1; } else { w.x = a0; w.y = a1; w.z = r0; w.w = r1; }
                    { const bf16* hrow_ = H + (size_t)(m0 + rr) * DM; const unsigned ho_ = (unsigned)(8 * ((lane & ~1) + 64 * (odd ? j1 : j0))); ST16_S(hrow_, ho_, w, 0); } } }
#pragma unroll
            for (int rr = 0; rr < 2; ++rr) asm volatile("" : "+v"(hx[rr][0]), "+v"(hx[rr][1]), "+v"(hx[rr][2]), "+v"(hx[rr][3]), "+v"(hx[rr][4]), "+v"(hx[rr][5]), "+v"(hx[rr][6]), "+v"(hx[rr][7]),
                                                                "+v"(hx[rr][8]), "+v"(hx[rr][9]), "+v"(hx[rr][10]), "+v"(hx[rr][11]), "+v"(hx[rr][12]), "+v"(hx[rr][13]), "+v"(hx[rr][14]), "+v"(hx[rr][15]));
            __builtin_amdgcn_sched_barrier(0);
            float a[2][16];
#pragma unroll
            for (int rr = 0; rr < 2; ++rr)
#pragma unroll
                for (int i = 0; i < 16; ++i) a[rr][i] = 0.f;
#pragma unroll
            for (int je = 0; je < 16; ++je) {
#pragma unroll
                for (int p = 0; p < 4; ++p) { const f32x4 w4 = ((const LAS f32x4*)WL)[(je * 4 + p) * 64 + lane];
#pragma unroll
                    for (int rr = 0; rr < 2; ++rr) { const float xv = hx[rr][je]; a[rr][4 * p] += w4.x * xv; a[rr][4 * p + 1] += w4.y * xv; a[rr][4 * p + 2] += w4.z * xv; a[rr][4 * p + 3] += w4.w * xv; } }

#pragma unroll
                for (int rr = 0; rr < 2; ++rr) asm volatile("" : "+v"(a[rr][0]), "+v"(a[rr][1]), "+v"(a[rr][2]), "+v"(a[rr][3]), "+v"(a[rr][4]), "+v"(a[rr][5]), "+v"(a[rr][6]), "+v"(a[rr][7]),
                                                                    "+v"(a[rr][8]), "+v"(a[rr][9]), "+v"(a[rr][10]), "+v"(a[rr][11]), "+v"(a[rr][12]), "+v"(a[rr][13]), "+v"(a[rr][14]), "+v"(a[rr][15]) :: "memory"); }
#pragma unroll
            for (int rr = 0; rr < 2; ++rr) {
            float b8[8], c4[4], d2[2];
#pragma unroll
            for (int i = 0; i < 8; ++i) { const bool hi = (lane & 32) != 0; const float mine = hi ? a[rr][i + 8] : a[rr][i], oth = hi ? a[rr][i] : a[rr][i + 8]; b8[i] = mine + __shfl_xor(oth, 32); }
#pragma unroll
            for (int i = 0; i < 4; ++i) { const bool hi = (lane & 16) != 0; const float mine = hi ? b8[i + 4] : b8[i], oth = hi ? b8[i] : b8[i + 4]; c4[i] = mine + __shfl_xor(oth, 16); }
#pragma unroll
            for (int i = 0; i < 2; ++i) { const bool hi = (lane & 8) != 0; const float mine = hi ? c4[i + 2] : c4[i], oth = hi ? c4[i] : c4[i + 2]; d2[i] = mine + __shfl_xor(oth, 8); }
            float f1; { const bool hi = (lane & 4) != 0; const float mine = hi ? d2[1] : d2[0], oth = hi ? d2[0] : d2[1]; f1 = mine + __shfl_xor(oth, 4); }
            f1 += __shfl_xor(f1, 2); f1 += __shfl_xor(f1, 1);
            if ((lane & 3) == 0) GLR[(size_t)(m0 + rr) * 16 + ((lane >> 2) & 15)] = f1; }
        }
        }
    }
#endif
    GRID_BAR();

#if PH(1)
    for (int rep_ = 0; rep_ < ((PROBE_DUP & 8) ? 2 : 1); ++rep_)
    { pg8::Gemm g{H, WB_t, M, NB, 1024}; pg8::StaticOrder S; S.init(M, NB, G, bx); pg8::EpiB E{GB, GR, GS};
      pg8::gemm_phase<pg8::EpiB, pg8::StaticOrder, true, true>(L + RING_OFF, g, S, E, wave); }
#endif
    LOCAL_BAR();

#if PH(2)
    for (int rep_ = 0; rep_ < ((PROBE_DUP & 1) ? 2 : 1); ++rep_)
    {
        if (rep_) GRID_BAR();
        float* SLOC = (float*)(ws + WS_SLOC); float* LOGD = (float*)(ws + WS_LOGD);
        {
        for (int prep_ = 0; prep_ < ((PROBE_DUP & 512) ? 2 : 1); ++prep_)
        for (int unit = (G == 256) ? ((vcu & 31) < 24 ? (vcu >> 5) * 24 + (vcu & 31) : 192) : vcu; unit < 192; unit += G) { const int bh = unit / 3, sg = unit % 3; PHASE_IDS();
            gla_loc(L + RING_OFF, GB, GLR, w_gate_lr, b_gate, SLOC, LOGD, bh >> 2, bh & 3, sg, tid, lane, wave); __syncthreads(); } }
        LOCAL_BAR();
        {
        for (int unit = vcu; unit < 256; unit += G) { const int bh = unit >> 2, sg = unit & 3; PHASE_IDS();
            gla_seg<true>(L + RING_OFF, GB, GLR, w_gate_lr, b_gate, gla_norm_g, CAT, SLOC, LOGD, bh >> 2, bh & 3, sg, tid, lane, wave); __syncthreads(); } }
    }
#endif
    GRID_BAR();

#if PH(3)
    for (int rep_ = 0; rep_ < ((PROBE_DUP & 16) ? 2 : 1); ++rep_)
    { pg8::Gemm g{H, WA_t, M, NA, 1024}; pg8::StaticOrder S; S.init(M, NA, G, bx); pg8::EpiA E{PA, ROPE, QSCALE};
      pg8::gemm_phase<pg8::EpiA, pg8::StaticOrder, true, true>(L + RING_OFF, g, S, E, wave); }
#endif
    LOCAL_BAR();

#if PH(4)
    {
        bf16* OG01 = (bf16*)(ws + WS_OG01); bf16* OG2 = (bf16*)(ws + WS_OG2); float* ML = (float*)(ws + WS_ML);
        { PHASE_IDS();
        for (int v = vcu; v < 256; v += G) { const int b = v >> 4, j = (v >> 2) & 3, q = v & 3;
            attn_stream<false>(L + RING_OFF, PA, OG01, OG2, ML, CAT, b, 4 + j, q, 0, 1024, tid, lane, wave);
#pragma unroll 1
            for (int i = 0; i < 4; ++i) attn_stream<false>(L + RING_OFF, PA, OG01, OG2, ML, CAT, b, 8 + j, 4 * q + i, 0, 256, tid, lane, wave); } }
        LOCAL_BAR();
        { PHASE_IDS();
        for (int v = vcu; v < 256; v += G) { const int b = v >> 4, j = (v >> 2) & 3, q = v & 3;
            attn_stream<true>(L + RING_OFF, PA, OG01, OG2, ML, CAT, b, j, 0, 1024 * q, 1024, tid, lane, wave); } }
    }
#endif
    LOCAL_BAR();

#if PH(5)
    for (int rep_ = 0; rep_ < ((PROBE_DUP & 32) ? 2 : 1); ++rep_) {
    { pg8::Gemm g{CAT, WCAT_t, M, 1024, 1536}; pg8::StaticOrder S; S.init(M, 1024, G, bx); pg8::EpiMixF E{GR, GS, MIX};
      pg8::gemm_phase<pg8::EpiMixF, pg8::StaticOrder, true, true>(L + RING_OFF, g, S, E, wave); }
    __syncthreads(); }
#endif
    LOCAL_BAR();

#if PH(6)
    { pg8::Gemm g{MIX, WOUT_t, M, 1024, 1024}; pg8::StaticOrder S; S.init(M, 1024, G, bx); pg8::EpiX1 E{x, X1B, SSQ1};
      pg8::gemm_phase<pg8::EpiX1, pg8::StaticOrder, true, true>(L + RING_OFF, g, S, E, wave); }
#endif
    LOCAL_BAR();

#if PH(7)
    for (int rep_ = 0; rep_ < ((PROBE_DUP & 64) ? 2 : 1); ++rep_)
    { pg8::Gemm g{X1B, WFF_t, M, NFF, 1024, 4608}; pg8::StaticOrder S; S.init(M, NFF, G, bx); pg8::EpiSwi E{ACT, SSQ1};
      pg8::gemm_phase<pg8::EpiSwi, pg8::StaticOrder, true, true>(L + RING_OFF, g, S, E, wave); }
    if (PROBE_DUP & 256) { pg8::Gemm g{X1B, WFF_t, M, NFF, 1024, 4608}; pg8::StaticOrder S; S.init(M, NFF, G, bx); pg8::EpiNull E{};
      pg8::gemm_phase<pg8::EpiNull, pg8::StaticOrder, true, true>(L + RING_OFF, g, S, E, wave); }
#endif
    LOCAL_BAR();

#if PH(8)
    { pg8::Gemm g{ACT, WDN_t, M, 1024, FFH, 4608}; pg8::StaticOrder S; S.init(M, 1024, G, bx); pg8::EpiX2 E{X1B, X2B, SSQ2};
      pg8::gemm_phase<pg8::EpiX2, pg8::StaticOrder, true, true>(L + RING_OFF, g, S, E, wave); }
#endif
    GRID_BAR();

#if PH(9)
    {
        PHASE_IDS();
        const bool bad = (__hip_atomic_load(ctl + CW_BAR + XB_TMO, RLX_AGENT) != 0u);
        f32x4 gfv[2][2];
#pragma unroll
        for (int hf = 0; hf < 2; ++hf) { gfv[hf][0] = ((const f32x4*)norm_f_g)[(hf * 512 + lane * 8) >> 2]; gfv[hf][1] = ((const f32x4*)norm_f_g)[((hf * 512 + lane * 8) >> 2) + 1]; }
        for (int m0 = gw * 4; m0 < M; m0 += NGW * 4) {
            v4u tv[4][2]; float sq[4];
#pragma unroll
            for (int rr = 0; rr < 4; ++rr) { sq[rr] = SSQ2[m0 + rr];
#pragma unroll
                for (int hf = 0; hf < 2; ++hf) tv[rr][hf] = *(const v4u*)(X2B + (size_t)(m0 + rr) * DM + hf * 512 + lane * 8); }
#pragma unroll
            for (int rr = 0; rr < 4; ++rr) { const int row = m0 + rr; float rs = __builtin_amdgcn_rsqf(sq[rr] * (1.0f / DM) + EPS); if (bad) rs = __builtin_nanf("");
#pragma unroll
                for (int hf = 0; hf < 2; ++hf) { const int c0 = hf * 512 + lane * 8; const v4u t = tv[rr][hf]; const f32x4 g0 = gfv[hf][0], g1 = gfv[hf][1];
                    f32x4 o0, o1; o0[0] = bflo(t.x) * rs * g0[0]; o0[1] = bfhi(t.x) * rs * g0[1]; o0[2] = bflo(t.y) * rs * g0[2]; o0[3] = bfhi(t.y) * rs * g0[3];
                    o1[0] = bflo(t.z) * rs * g1[0]; o1[1] = bfhi(t.z) * rs * g1[1]; o1[2] = bflo(t.w) * rs * g1[2]; o1[3] = bfhi(t.w) * rs * g1[3];
                    const float* orow = out + (size_t)row * DM; const unsigned lo_ = (unsigned)(lane * 32);
                    if (hf == 0) { ST16_S(orow, lo_, o0, 0); ST16_S(orow, lo_, o1, 16); } else { ST16_S(orow, lo_, o0, 2048); ST16_S(orow, lo_, o1, 2064); } } } }
    }
#endif
}

extern "C" void kernel_launch(void* const* d_in, const int* in_sizes, int n_in, void* d_out, int out_size, void* d_ws, size_t ws_size, hipStream_t stream) {
    static int grid = 0;
    if (grid == 0) {
        if (n_in != 13 || in_sizes[0] != M * DM || out_size != M * DM || ws_size < WS_END) { fprintf(stderr, "kernel_launch: unexpected shapes (n_in %d, in0 %d, out %d, ws %zu)\n", n_in, n_in > 0 ? in_sizes[0] : -1, out_size, ws_size); grid = -1; return; }
        int dev = 0, cus = 0, per_cu = 0;
        if (hipGetDevice(&dev) != hipSuccess || hipDeviceGetAttribute(&cus, hipDeviceAttributeMultiprocessorCount, dev) != hipSuccess) { grid = -1; return; }
        if (hipFuncSetAttribute((const void*)hyb_fwd, hipFuncAttributeMaxDynamicSharedMemorySize, LDS_BYTES) != hipSuccess) { grid = -1; return; }
        if (hipOccupancyMaxActiveBlocksPerMultiprocessor(&per_cu, (const void*)hyb_fwd, NWAVES * 64, LDS_BYTES) != hipSuccess || per_cu < 1) { fprintf(stderr, "kernel_launch: occupancy query says %d\n", per_cu); }
        (void)hipGetLastError();
        grid = cus;
    }
    if (grid < 0) return;
    if (hipMemsetAsync((char*)d_ws + WS_CTL, 0, CTL_ZERO_BYTES, stream) != hipSuccess) return;
    Args a{};
    for (int i = 0; i < 13; ++i) a.in[i] = (const float*)d_in[i];
    a.out = (float*)d_out; a.ws = (unsigned char*)d_ws;
    hipLaunchKernelGGL(hyb_fwd, dim3(grid), dim3(NWAVES * 64), LDS_BYTES, stream, a);
}
```
